# Optimizing an MI355X kernel written in HIP

```python
import math
import jax
import jax.numpy as jnp
from jax import lax
import numpy as np

D_MODEL = 2048
BATCH = 4
SEQ = 4096
DEPTH = 2

SWA_HEADS = 8
SWA_KV_HEADS = 2
SWA_HEAD_DIM = 64
WINDOW = 128
HG_HEADS = 8
HG_DK = 128
HG_DV = 128
HG_CHUNK = 64
MLA_HEADS = 4
MLA_Q_RANK = 512
MLA_KV_RANK = 256
MLA_NOPE = 128
MLA_ROPE = 64
MLA_QK = MLA_NOPE + MLA_ROPE
MLA_V = 128
Q_BLOCK = 128
ROPE_THETA = 10000.0
REL_BUCKETS = 32
REL_MAX_DIST = 128
MEM_LEN = 256
MEM_HEADS = 4
MEM_HEAD_DIM = 128
MEM_WIDTH = MEM_HEADS * MEM_HEAD_DIM
N_GROUPS = 8
EXPERTS_PER_GROUP = 8
N_EXPERTS = N_GROUPS * EXPERTS_PER_GROUP
TOP_K = 2
D_EXPERT = 512
MOE_BLOCK = 128

EPS = 1e-6
NEG_INF = -1e30
F32 = jnp.float32

SWA_WIDTH = SWA_HEADS * SWA_HEAD_DIM
HG_WIDTH = HG_HEADS * HG_DV
MLA_WIDTH = MLA_HEADS * MLA_V
MIX_WIDTH = SWA_WIDTH + HG_WIDTH + MLA_WIDTH
IN_SIZES = (SWA_HEADS * SWA_HEAD_DIM, SWA_KV_HEADS * SWA_HEAD_DIM, SWA_KV_HEADS * SWA_HEAD_DIM,
            HG_HEADS * HG_DK, HG_HEADS * HG_DK, HG_HEADS * HG_DV, HG_HEADS * HG_DV,
            MLA_Q_RANK, MLA_KV_RANK, MLA_ROPE)
IN_WIDTH = sum(IN_SIZES)

kernel_name = 'hybrid_parallel_heads_hier_moe'


def rmsnorm(x, gain):
    xf = x.astype(F32)
    y = xf * lax.rsqrt(jnp.mean(xf * xf, axis=-1, keepdims=True) + EPS)
    return (y * gain.astype(F32)).astype(x.dtype)


def split_columns(t, sizes):
    outs, off = [], 0
    for n in sizes:
        outs.append(t[..., off:off + n])
        off += n
    return outs


def apply_rope(x, positions):
    half = x.shape[-1] // 2
    inv_freq = ROPE_THETA ** (-jnp.arange(half, dtype=F32) / half)
    ang = positions.astype(F32)[:, None] * inv_freq[None, :]
    cos = jnp.cos(ang)[None, :, None, :]
    sin = jnp.sin(ang)[None, :, None, :]
    xf = x.astype(F32)
    x1, x2 = xf[..., :half], xf[..., half:]
    return jnp.concatenate([x1 * cos - x2 * sin, x1 * sin + x2 * cos], axis=-1).astype(x.dtype)


def t5_bucket(n):
    max_exact = REL_BUCKETS // 2
    nf = jnp.maximum(n, 1).astype(F32)
    large = max_exact + (jnp.log(nf / max_exact) / math.log(REL_MAX_DIST / max_exact)
                         * (REL_BUCKETS - max_exact)).astype(jnp.int32)
    large = jnp.minimum(large, REL_BUCKETS - 1)
    return jnp.where(n < max_exact, n, large)


def band_relative_bias(table):
    qi = jnp.arange(WINDOW)[:, None]
    kj = jnp.arange(2 * WINDOW)[None, :]
    dist = jnp.maximum(qi + WINDOW - kj, 0)
    return jnp.transpose(table[t5_bucket(dist)], (2, 0, 1))


def swa_gqa_sinks(q, k, v, sinks, rel_bias):
    b, s = q.shape[:2]
    nb = s // WINDOW
    grp = SWA_HEADS // SWA_KV_HEADS
    qb = q.reshape(b, nb, WINDOW, SWA_KV_HEADS, grp, SWA_HEAD_DIM)

    def band(t):
        tp = jnp.pad(t, ((0, 0), (WINDOW, 0), (0, 0), (0, 0)))
        tp = tp.reshape(b, nb + 1, WINDOW, SWA_KV_HEADS, SWA_HEAD_DIM)
        return jnp.concatenate([tp[:, :-1], tp[:, 1:]], axis=2)

    kb, vb = band(k), band(v)
    scores = jnp.einsum('bnqhgd,bnkhd->bnhgqk', qb, kb, preferred_element_type=F32) * (SWA_HEAD_DIM ** -0.5)
    scores = scores + rel_bias.reshape(SWA_KV_HEADS, grp, WINDOW, 2 * WINDOW).astype(F32)
    qi = jnp.arange(WINDOW)[:, None]
    kj = jnp.arange(2 * WINDOW)[None, :]
    dist = qi + WINDOW - kj
    in_window = (dist >= 0) & (dist < WINDOW)
    key_pos = jnp.arange(nb)[:, None, None] * WINDOW + kj[None] - WINDOW
    valid = in_window[None] & (key_pos >= 0)
    scores = jnp.where(valid[None, :, None, None], scores, NEG_INF)
    sink = jnp.broadcast_to(sinks.reshape(SWA_KV_HEADS, grp, 1, 1).astype(F32), scores.shape[:-1] + (1,))
    probs = jax.nn.softmax(jnp.concatenate([scores, sink], axis=-1), axis=-1)[..., :-1]
    out = jnp.einsum('bnhgqk,bnkhd->bnqhgd', probs.astype(v.dtype), vb)
    return out.reshape(b, s, SWA_WIDTH)


def hgrn2_chunkwise(q, k, log_f, v):
    b, s = q.shape[:2]
    nc = s // HG_CHUNK

    def chunks(t):
        return t.reshape(b, nc, HG_CHUNK, HG_HEADS, t.shape[-1]).transpose(1, 0, 3, 2, 4)

    causal = jnp.tril(jnp.ones((HG_CHUNK, HG_CHUNK), dtype=bool))

    def step(state, inp):
        qc, kc, gc, vc = inp
        bcum = jnp.cumsum(gc, axis=2)
        btot = bcum[:, :, -1:]
        inter = jnp.einsum('bhtk,bhkv->bhtv', qc * jnp.exp(bcum), state)
        diff = jnp.where(causal[:, :, None], bcum[:, :, :, None, :] - bcum[:, :, None, :, :], -jnp.inf)
        attn = jnp.einsum('bhtk,bhsk,bhtsk->bhts', qc, kc, jnp.exp(diff))
        intra = jnp.einsum('bhts,bhsv->bhtv', attn, vc)
        new_state = state * jnp.exp(btot[:, :, 0])[..., None] + \
            jnp.einsum('bhsk,bhsv->bhkv', kc * jnp.exp(btot - bcum), vc)
        return new_state, inter + intra

    state0 = jnp.zeros((b, HG_HEADS, HG_DK, HG_DV), F32)
    _, out = lax.scan(step, state0, (chunks(q), chunks(k), chunks(log_f), chunks(v)))
    return out.transpose(1, 0, 3, 2, 4).reshape(b, s, HG_HEADS, HG_DV)


def mla_causal_attention(q, k, v):
    b, s = q.shape[:2]
    nb = s // Q_BLOCK
    qb = q.reshape(b, nb, Q_BLOCK, MLA_HEADS, MLA_QK).transpose(1, 0, 2, 3, 4)
    key_pos = jnp.arange(s)
    scale = MLA_QK ** -0.5

    def one_block(args):
        qblk, i = args
        sc = jnp.einsum('bqhd,bkhd->bhqk', qblk, k, preferred_element_type=F32) * scale
        qpos = i * Q_BLOCK + jnp.arange(Q_BLOCK)
        sc = jnp.where(key_pos[None, :] <= qpos[:, None], sc, NEG_INF)
        p = jax.nn.softmax(sc, axis=-1)
        return jnp.einsum('bhqk,bkhd->bqhd', p.astype(v.dtype), v)

    out = lax.map(one_block, (qb, jnp.arange(nb)))
    return out.transpose(1, 0, 2, 3, 4).reshape(b, s, MLA_WIDTH)


def memory_cross_attention(hn, mem, g_mem_kv, w_mq, w_mkv, mem_gq, mem_gk, w_mo):
    b, s, _ = hn.shape
    m = mem.shape[1]
    q = rmsnorm((hn @ w_mq).reshape(b, s, MEM_HEADS, MEM_HEAD_DIM), mem_gq)
    kv = rmsnorm(mem, g_mem_kv) @ w_mkv
    k, v = kv[..., :MEM_WIDTH], kv[..., MEM_WIDTH:]
    k = rmsnorm(k.reshape(b, m, MEM_HEADS, MEM_HEAD_DIM), mem_gk)
    v = v.reshape(b, m, MEM_HEADS, MEM_HEAD_DIM)
    sc = jnp.einsum('bshd,bmhd->bhsm', q, k, preferred_element_type=F32) * (MEM_HEAD_DIM ** -0.5)
    p = jax.nn.softmax(sc, axis=-1)
    o = jnp.einsum('bhsm,bmhd->bshd', p.astype(v.dtype), v).reshape(b, s, MEM_WIDTH)
    return o @ w_mo


def hierarchical_moe(hn, w_gr, b_gr, w_er, b_er, w_gate, w_up, w_down):
    b, s, d = hn.shape
    n = b * s
    ht = hn.reshape(n, d)
    hf = ht.astype(F32)
    g_prob = jax.nn.softmax(hf @ w_gr.astype(F32) + b_gr.astype(F32), axis=-1)
    grp = jnp.argmax(g_prob, axis=-1)
    p_grp = jnp.take_along_axis(g_prob, grp[:, None], axis=-1)
    e_logits = (hf @ w_er.astype(F32) + b_er.astype(F32)).reshape(n, N_GROUPS, EXPERTS_PER_GROUP)
    e_logits = jnp.take_along_axis(e_logits, grp[:, None, None], axis=1)[:, 0]
    top_p, top_i = lax.top_k(jax.nn.softmax(e_logits, axis=-1), TOP_K)
    gates = p_grp * top_p / jnp.sum(top_p, axis=-1, keepdims=True)
    expert_id = grp[:, None] * EXPERTS_PER_GROUP + top_i

    a = n * TOP_K
    flat_e = expert_id.reshape(a)
    order = jnp.argsort(flat_e)
    e_sorted = flat_e[order]
    tok_sorted = order // TOP_K
    gate_sorted = gates.reshape(a)[order]
    counts = jnp.bincount(flat_e, length=N_EXPERTS)
    padded = (counts + MOE_BLOCK - 1) // MOE_BLOCK * MOE_BLOCK
    padded_end = jnp.cumsum(padded)
    start = jnp.cumsum(counts) - counts
    dest = (padded_end - padded)[e_sorted] + jnp.arange(a) - start[e_sorted]
    n_blocks = -(-a // MOE_BLOCK) + N_EXPERTS
    slot_tok = jnp.full((n_blocks * MOE_BLOCK,), n, jnp.int32).at[dest].set(tok_sorted)
    h_pad = jnp.concatenate([ht, jnp.zeros((1, d), ht.dtype)], axis=0)
    xin = h_pad[slot_tok].reshape(n_blocks, MOE_BLOCK, d)
    block_expert = jnp.minimum(
        jnp.searchsorted(padded_end, jnp.arange(n_blocks) * MOE_BLOCK, side='right'), N_EXPERTS - 1)

    def run_block(args):
        xb, e = args
        return (jax.nn.silu(xb @ w_gate[e]) * (xb @ w_up[e])) @ w_down[e]

    y = lax.map(run_block, (xin, block_expert)).reshape(n_blocks * MOE_BLOCK, d)
    y_assign = y[dest] * gate_sorted[:, None].astype(y.dtype)
    out = jax.ops.segment_sum(y_assign, tok_sorted, num_segments=n)
    return out.reshape(b, s, d)


def setup_inputs(seed: int = 0) -> dict:
    key = jax.random.key(seed)
    keys = iter(jax.random.split(key, 40))

    def normal(shape, scale):
        return jax.random.normal(next(keys), shape, F32) * scale

    def gain(shape):
        return 1.0 + normal(shape, 0.02)

    L, D = DEPTH, D_MODEL
    return {
        'x': normal((BATCH, SEQ, D), 1.0),
        'mem': normal((BATCH, MEM_LEN, D), 1.0),
        'rel_bias_table': normal((REL_BUCKETS, SWA_HEADS), 0.5),
        'hg_lb_logits': normal((L, HG_HEADS * HG_DK), 0.5),
        'g_mix': gain((L, D)),
        'w_in': normal((L, D, IN_WIDTH), D ** -0.5),
        'swa_gq': gain((L, SWA_HEAD_DIM)),
        'swa_gk': gain((L, SWA_HEAD_DIM)),
        'swa_sinks': normal((L, SWA_HEADS), 0.5),
        'hg_g_out': gain((L, HG_DV)),
        'mla_g_cq': gain((L, MLA_Q_RANK)),
        'mla_g_ckv': gain((L, MLA_KV_RANK)),
        'mla_w_uq': normal((L, MLA_Q_RANK, MLA_HEADS * MLA_QK), MLA_Q_RANK ** -0.5),
        'mla_w_ukv': normal((L, MLA_KV_RANK, MLA_HEADS * (MLA_NOPE + MLA_V)), MLA_KV_RANK ** -0.5),
        'mla_gq': gain((L, MLA_QK)),
        'mla_gk': gain((L, MLA_QK)),
        'w_out': normal((L, MIX_WIDTH, D), MIX_WIDTH ** -0.5),
        'g_mem_q': gain((L, D)),
        'g_mem_kv': gain((L, D)),
        'w_mq': normal((L, D, MEM_WIDTH), D ** -0.5),
        'w_mkv': normal((L, D, 2 * MEM_WIDTH), D ** -0.5),
        'mem_gq': gain((L, MEM_HEAD_DIM)),
        'mem_gk': gain((L, MEM_HEAD_DIM)),
        'w_mo': normal((L, MEM_WIDTH, D), MEM_WIDTH ** -0.5),
        'g_ffn': gain((L, D)),
        'w_group_router': normal((L, D, N_GROUPS), D ** -0.5),
        'b_group_router': normal((L, N_GROUPS), 0.01),
        'w_expert_router': normal((L, D, N_EXPERTS), D ** -0.5),
        'b_expert_router': normal((L, N_EXPERTS), 0.01),
        'w_gate': normal((L, N_EXPERTS, D, D_EXPERT), D ** -0.5),
        'w_up': normal((L, N_EXPERTS, D, D_EXPERT), D ** -0.5),
        'w_down': normal((L, N_EXPERTS, D_EXPERT, D), D_EXPERT ** -0.5),
    }


def reference(x, mem, rel_bias_table, hg_lb_logits, g_mix, w_in, swa_gq, swa_gk, swa_sinks,
              hg_g_out, mla_g_cq, mla_g_ckv, mla_w_uq, mla_w_ukv, mla_gq, mla_gk, w_out,
              g_mem_q, g_mem_kv, w_mq, w_mkv, mem_gq, mem_gk, w_mo,
              g_ffn, w_group_router, b_group_router, w_expert_router, b_expert_router,
              w_gate, w_up, w_down):
    b, s, _ = x.shape
    positions = jnp.arange(s, dtype=jnp.int32)
    rel_bias = band_relative_bias(rel_bias_table)
    lb_all = jnp.cumsum(jax.nn.softmax(hg_lb_logits.astype(F32), axis=0), axis=0)
    lb_all = lb_all - lb_all[:1]

    for l in range(DEPTH):
        hn = rmsnorm(x, g_mix[l])
        u = hn @ w_in[l]
        sq, sk, sv, hq, hf, hi, hg, cq, ckv, kr = split_columns(u, IN_SIZES)

        sq = rmsnorm(sq.reshape(b, s, SWA_HEADS, SWA_HEAD_DIM), swa_gq[l])
        sk = rmsnorm(sk.reshape(b, s, SWA_KV_HEADS, SWA_HEAD_DIM), swa_gk[l])
        sv = sv.reshape(b, s, SWA_KV_HEADS, SWA_HEAD_DIM)
        out_a = swa_gqa_sinks(sq, sk, sv, swa_sinks[l], rel_bias)

        lb = lb_all[l].reshape(HG_HEADS, HG_DK)
        f_pre = hf.reshape(b, s, HG_HEADS, HG_DK).astype(F32)
        log_f = jnp.logaddexp(jnp.log(lb), jnp.log1p(-lb) + jax.nn.log_sigmoid(f_pre))
        k_in = (1.0 - lb) * jax.nn.sigmoid(-f_pre)
        o_b = hgrn2_chunkwise(hq.reshape(b, s, HG_HEADS, HG_DK).astype(F32), k_in, log_f,
                              hi.reshape(b, s, HG_HEADS, HG_DV).astype(F32))
        out_b = (rmsnorm(o_b, hg_g_out[l]) * jax.nn.silu(hg.reshape(b, s, HG_HEADS, HG_DV).astype(F32)))
        out_b = out_b.astype(x.dtype).reshape(b, s, HG_WIDTH)

        cq = rmsnorm(cq, mla_g_cq[l])
        ckv = rmsnorm(ckv, mla_g_ckv[l])
        qm = (cq @ mla_w_uq[l]).reshape(b, s, MLA_HEADS, MLA_QK)
        kvm = (ckv @ mla_w_ukv[l]).reshape(b, s, MLA_HEADS, MLA_NOPE + MLA_V)
        k_nope, vm = kvm[..., :MLA_NOPE], kvm[..., MLA_NOPE:]
        k_rope = jnp.broadcast_to(kr[:, :, None, :], (b, s, MLA_HEADS, MLA_ROPE))
        km = jnp.concatenate([k_nope, k_rope], axis=-1)
        qm = rmsnorm(qm, mla_gq[l])
        km = rmsnorm(km, mla_gk[l])
        qm = jnp.concatenate([qm[..., :MLA_NOPE], apply_rope(qm[..., MLA_NOPE:], positions)], axis=-1)
        km = jnp.concatenate([km[..., :MLA_NOPE], apply_rope(km[..., MLA_NOPE:], positions)], axis=-1)
        out_c = mla_causal_attention(qm, km, vm)

        x = x + jnp.concatenate([out_a, out_b, out_c], axis=-1) @ w_out[l]

        x = x + memory_cross_attention(rmsnorm(x, g_mem_q[l]), mem, g_mem_kv[l], w_mq[l], w_mkv[l],
                                       mem_gq[l], mem_gk[l], w_mo[l])

        x = x + hierarchical_moe(rmsnorm(x, g_ffn[l]), w_group_router[l], b_group_router[l],
                                 w_expert_router[l], b_expert_router[l], w_gate[l], w_up[l], w_down[l])
    return x
```

```cpp
#include <hip/hip_runtime.h>
#include <cstdio>
#include <cstdint>

#ifndef MK_DEBUG
#define MK_DEBUG 0
#endif
#ifndef MK_SANITIZE
#define MK_SANITIZE 1
#endif
#ifndef MK_ONE_LAUNCH
#define MK_ONE_LAUNCH 0
#endif

#define GAS __attribute__((address_space(1)))
#define LAS __attribute__((address_space(3)))
typedef unsigned short bf16;
typedef short bf16x8 __attribute__((ext_vector_type(8)));
typedef float f32x4 __attribute__((ext_vector_type(4)));
typedef float f32x16 __attribute__((ext_vector_type(16)));
typedef unsigned u32x4 __attribute__((ext_vector_type(4)));
typedef unsigned u32x2 __attribute__((ext_vector_type(2)));

constexpr int D = 2048, NB = 4, SEQ = 4096, NTOK = NB * SEQ, DEPTH = 2;
constexpr int UW = 5888;
constexpr int C_SQ = 0, C_SK = 512, C_SV = 640, C_HQ = 768, C_HF = 1792, C_HI = 2816, C_HG = 3840, C_CQ = 4864, C_CKV = 5376, C_KR = 5632, INW = 5696;
constexpr int NEXP = 64, DEXP = 512, MAXROWS = 49152;
constexpr float EPS = 1e-6f;
constexpr float LOG2E = 1.4426950408889634f;

constexpr size_t MiB = 1u << 20;
constexpr size_t WS_CTL = 0, CTL_BYTES = 1 * MiB;
constexpr size_t SZ_WIN = (size_t)UW * D * 2, SZ_WUQ = 768 * 512 * 2, SZ_WUKV = 1024 * 256 * 2, SZ_WOUT = (size_t)D * D * 2, SZ_WMQ = 512 * (size_t)D * 2,
                 SZ_WMKV = 1024 * (size_t)D * 2, SZ_WMO = (size_t)D * 512 * 2, SZ_WGU = (size_t)NEXP * 1024 * D * 2, SZ_WD = (size_t)NEXP * D * 512 * 2;
constexpr size_t WL_WIN = 0, WL_WUQ = WL_WIN + SZ_WIN, WL_WUKV = WL_WUQ + SZ_WUQ, WL_WOUT = WL_WUKV + SZ_WUKV, WL_WMQ = WL_WOUT + SZ_WOUT, WL_WMKV = WL_WMQ + SZ_WMQ,
                 WL_WMO = WL_WMKV + SZ_WMKV, WL_WGU = WL_WMO + SZ_WMO, WL_WD = WL_WGU + SZ_WGU, WL_END = WL_WD + SZ_WD;
constexpr size_t WS_W = 1 * MiB;
constexpr size_t WS_PERS = WS_W + 2 * WL_END;
constexpr size_t WS_HN = WS_PERS;
constexpr size_t WS_MEMN = WS_HN + (size_t)NTOK * D * 2;
constexpr size_t WS_MKV = WS_MEMN + 2 * 1024 * (size_t)D * 2;
constexpr size_t WS_MK = WS_MKV + 2 * 1024 * 1024 * 2;
constexpr size_t WS_MVT = WS_MK + 2 * 1024 * 512 * 2;
constexpr size_t WS_ROPE = WS_MVT + 2 * 1024 * 512 * 2;
constexpr size_t WS_MQ = WS_ROPE + 4096 * 32 * 8;
constexpr size_t WS_MO = WS_MQ + (size_t)NTOK * 512 * 2;
constexpr size_t WS_SMALL = WS_MO + (size_t)NTOK * 512 * 2;
constexpr size_t SM_RSTDCQ = 0, SM_RSTDCKV = SM_RSTDCQ + NTOK * 4, SM_RSTDFFN = SM_RSTDCKV + NTOK * 4, SM_EIDX = SM_RSTDFFN + NTOK * 4, SM_GATE = SM_EIDX + NTOK * 8,
                 SM_SLOT = SM_GATE + NTOK * 8, SM_AROW = SM_SLOT + NTOK * 8, SM_LB = SM_AROW + NTOK * 8, SM_END = SM_LB + 2 * 1024 * 4;
constexpr size_t WS_OVL = (WS_SMALL + SM_END + 4095) / 4096 * 4096;
constexpr size_t OV_U = 0;
constexpr size_t OV_QM = OV_U + (size_t)NTOK * UW * 2;
constexpr size_t OV_KVM = OV_QM + (size_t)NTOK * 768 * 2;
constexpr size_t OV_QF = OV_KVM + (size_t)NTOK * 1024 * 2;
constexpr size_t OV_KF = OV_QF + (size_t)NTOK * 768 * 2;
constexpr size_t OV_VT = OV_KF + (size_t)NTOK * 768 * 2;
constexpr size_t OV_SVT = OV_VT + (size_t)NTOK * 512 * 2;
constexpr size_t OV_QT = OV_SVT + (size_t)NTOK * 128 * 2;
constexpr size_t OV_INTRA = OV_QT + (size_t)NTOK * 1024 * 2;
constexpr size_t OV_UT = OV_INTRA + (size_t)NTOK * 1024 * 2;
constexpr size_t OV_DEC = OV_UT + (size_t)2048 * 128 * 128 * 2;
constexpr size_t OV_MIX = OV_DEC + 2048 * 128 * 4;
constexpr size_t OV_MIXEND = OV_MIX + (size_t)NTOK * D * 2;
constexpr size_t OV_XG = 0;
constexpr size_t OV_HMID = OV_XG + (size_t)MAXROWS * D * 2;
constexpr size_t OV_YB = OV_HMID + (size_t)MAXROWS * 512 * 2;
constexpr size_t OV_MOEEND = OV_YB + (size_t)MAXROWS * D * 2;
constexpr size_t WS_END = WS_OVL + (OV_MIXEND > OV_MOEEND ? OV_MIXEND : OV_MOEEND);
static_assert(WS_END <= (size_t)2048 * MiB, "workspace map must fit 2 GiB");
constexpr int CW_BAR = 4096;
constexpr int CW_CNT = 8192;
constexpr int CW_NMT = 8192 + 128;
constexpr int CW_MTE = 8192 + 256;
constexpr int CW_MTR = 8192 + 768;

constexpr int LDS_WORK = 131072;
constexpr int MISC_OFF = LDS_WORK;
constexpr int LDS_BYTES = 147456;
constexpr int NWAVES = 8, NTHR = 512;

#define LDS_WAIT() asm volatile("s_waitcnt lgkmcnt(0)" ::: "memory")
#define VM_WAIT() asm volatile("s_waitcnt vmcnt(0)" ::: "memory")
#define SBAR() __builtin_amdgcn_sched_barrier(0)
__device__ __forceinline__ unsigned f2bf(float f) { unsigned u = __builtin_bit_cast(unsigned, f); return (u + 0x7fffu + ((u >> 16) & 1u)) >> 16; }
__device__ __forceinline__ unsigned pk2(float lo, float hi) { return f2bf(lo) | (f2bf(hi) << 16); }
__device__ __forceinline__ float bf2f(unsigned b) { return __builtin_bit_cast(float, b << 16); }
__device__ __forceinline__ float bflo(unsigned w) { return __builtin_bit_cast(float, w << 16); }
__device__ __forceinline__ float bfhi(unsigned w) { return __builtin_bit_cast(float, w & 0xffff0000u); }
__device__ __forceinline__ unsigned cvtpk(float lo, float hi) { unsigned r; asm volatile("v_cvt_pk_bf16_f32 %0, %1, %2" : "=v"(r) : "v"(lo), "v"(hi)); return r; }
__device__ __forceinline__ float ex2(float x) { return __builtin_amdgcn_exp2f(x); }
__device__ __forceinline__ float fexp(float x) { return __builtin_amdgcn_exp2f(x * LOG2E); }
__device__ __forceinline__ float flog(float x) { return __builtin_amdgcn_logf(x) * 0.6931471805599453f; }
__device__ __forceinline__ float wave_sum(float v) {
#pragma unroll
    for (int o = 1; o < 64; o <<= 1) v += __shfl_xor(v, o);
    return v;
}
__device__ __forceinline__ int crow(int r, int hi) { return (r & 3) + 8 * (r >> 2) + 4 * hi; }
#define PK4(P, B_, OUT) do { unsigned a0_ = cvtpk(P[B_ + 0], P[B_ + 1]), a1_ = cvtpk(P[B_ + 2], P[B_ + 3]), b0_ = cvtpk(P[B_ + 4], P[B_ + 5]), b1_ = cvtpk(P[B_ + 6], P[B_ + 7]); \
        auto r0_ = __builtin_amdgcn_permlane32_swap(a0_, b0_, false, false); auto r1_ = __builtin_amdgcn_permlane32_swap(a1_, b1_, false, false); \
        u32x4 w_ = {r0_[0], r1_[0], r0_[1], r1_[1]}; OUT = __builtin_bit_cast(bf16x8, w_); } while (0)
__device__ __forceinline__ float swap_max(float v) { return fmaxf(v, __shfl_xor(v, 32)); }
__device__ __forceinline__ float swap_sum(float v) { return v + __shfl_xor(v, 32); }

#define XB_TMO      128
#define XB_XCNT(j)  (256  + 64 * (j))
#define XB_XSUB(j)  (1280 + 64 * (j))
#define XB_XGEN(j)  (2304 + 64 * (j))
#define XB_TOP      3328
#define XB_TOPGEN   3392
#define XCD_BAR_WORDS 3456
#define XB_SPIN_CAP (1u << 22)
__device__ __forceinline__ unsigned xb_ld(unsigned* p)              { return __hip_atomic_load(p, __ATOMIC_RELAXED, __HIP_MEMORY_SCOPE_AGENT); }
__device__ __forceinline__ unsigned xb_add(unsigned* p, unsigned v) { return __hip_atomic_fetch_add(p, v, __ATOMIC_RELAXED, __HIP_MEMORY_SCOPE_AGENT); }
__device__ __forceinline__ unsigned xb_xcc_id() { return (unsigned)__builtin_amdgcn_s_getreg((3 << 11) | 20) & 0xFu; }
#define XB_SPIN(cond, bar) do { unsigned _sp = 0; while (cond) { __builtin_amdgcn_s_sleep(1); \
    if ((++_sp & 255u) == 0u) { if (xb_ld(&(bar)[XB_TMO])) break; if (_sp > XB_SPIN_CAP) { atomicAdd(&(bar)[XB_TMO], 1u); break; } } } } while (0)
struct XcdBarrier { unsigned* bar; unsigned x; volatile LAS unsigned* st; };
__device__ __forceinline__ XcdBarrier xcd_barrier_post(unsigned* bar, volatile LAS unsigned* st) {
    XcdBarrier b; b.bar = bar; b.x = xb_xcc_id(); b.st = st;
    if (threadIdx.x == 0) (void)xb_add(&bar[XB_XCNT(b.x)], 1u);
    return b;
}
__device__ __forceinline__ void xcd_barrier_complete(unsigned* bar, unsigned x, unsigned& nloc, unsigned& nx) {
    const unsigned G = gridDim.x * gridDim.y * gridDim.z;
    unsigned sum, cnt, mine, sp = 0u;
    for (;;) {
        sum = 0u; cnt = 0u; mine = 0u;
#pragma unroll
        for (unsigned j = 0; j < 16; ++j) { const unsigned c = xb_ld(&bar[XB_XCNT(j)]); sum += c; cnt += (c > 0u) ? 1u : 0u; mine = (j == x) ? c : mine; }
        if (sum == G) break;
        __builtin_amdgcn_s_sleep(1);
        if ((++sp & 255u) == 0u) { if (xb_ld(&bar[XB_TMO])) break; if (sp > XB_SPIN_CAP) { atomicAdd(&bar[XB_TMO], 1u); break; } }
    }
    nloc = mine > 0u ? mine : 1u; nx = cnt > 0u ? cnt : 1u;
}
__device__ __forceinline__ void xcd_barrier(const XcdBarrier& b, const bool leader) {
    asm volatile("s_waitcnt vmcnt(0)" ::: "memory");
    __syncthreads();
    if (leader) {
        unsigned* bar = b.bar;
        __builtin_amdgcn_s_waitcnt(0);
        unsigned nloc = b.st[0], nx = b.st[1];
        if (nloc == 0u) { xcd_barrier_complete(bar, b.x, nloc, nx); b.st[0] = nloc; b.st[1] = nx; }
        const unsigned old = xb_add(&bar[XB_XSUB(b.x)], 1u);
        const unsigned gen = old / nloc;
        if (old + 1u == (gen + 1u) * nloc) {
            __builtin_amdgcn_fence(__ATOMIC_RELEASE, "agent");
            asm volatile("s_waitcnt vmcnt(0)" ::: "memory");
            const unsigned og = xb_add(&bar[XB_TOP], 1u);
            const unsigned tg = og / nx;
            if (og + 1u == (tg + 1u) * nx) xb_add(&bar[XB_TOPGEN], 1u);
            else XB_SPIN(xb_ld(&bar[XB_TOPGEN]) == tg, bar);
            __builtin_amdgcn_fence(__ATOMIC_ACQUIRE, "agent");
            xb_add(&bar[XB_XGEN(b.x)], 1u);
            asm volatile("s_waitcnt vmcnt(0)" ::: "memory");
        } else {
            XB_SPIN(xb_ld(&bar[XB_XGEN(b.x)]) == gen, bar);
            __builtin_amdgcn_fence(__ATOMIC_ACQUIRE, "agent");
            asm volatile("s_waitcnt vmcnt(0)" ::: "memory");
        }
    }
    __syncthreads();
}

namespace pg8 {
constexpr int BM = 256, BK = 64, HALF = 128, HTB = HALF * BK * 2, STAGE_BYTES = 8 * HTB, NXCD = 8, WGM = 8;
__host__ __device__ __forceinline__ int lds_byte(int r, int c) { const int st = (r >> 4) * 2 + (c >> 5), rr = r & 15, cc = c & 31, ob = rr * 64 + cc * 2; return st * 1024 + (ob ^ (((ob >> 9) & 1) << 5)); }
__host__ __device__ __forceinline__ void stage_rc(int b, int& R, int& C) { const int st = b / 1024, sb = b % 1024, swz = sb ^ (((sb >> 9) & 1) << 5); R = (st >> 1) * 16 + swz / 64; C = (st & 1) * 32 + (swz % 64) / 2; }
__host__ __device__ __forceinline__ int perm32(int rho) { const int n = rho >> 4, i = rho & 15; return 8 * (i >> 2) + 4 * n + (i & 3); }

struct Unit { int pm, pn; size_t aoff, boff; };
struct Gemm { const bf16* A; const bf16* Bt; int lda, K; };

struct StaticOrder {
    int nM, nN, nwg, G, c, lda, K;
    __device__ void init(int M, int N, int lda_, int K_, int G_, int c_) { nM = M / BM; nN = N / BM; nwg = nM * nN; G = G_; c = c_; lda = lda_; K = K_; }
    __device__ bool next(int i, Unit& u) const {
        const long L = (long)i * G + c; if (L >= nwg) return false;
        int wgid = (int)L; { const int q = nwg / NXCD, r = nwg % NXCD, xcd = wgid % NXCD, off = wgid / NXCD; wgid = (xcd < r ? xcd * (q + 1) : r * (q + 1) + (xcd - r) * q) + off; }
        const int nig = WGM * nN, gid = wgid / nig, fm = gid * WGM, gsz = (nM - fm) < WGM ? (nM - fm) : WGM;
        u.pm = fm + ((wgid % nig) % gsz); u.pn = (wgid % nig) / gsz;
        u.aoff = (size_t)u.pm * BM * lda * 2; u.boff = (size_t)u.pn * BM * K * 2; return true;
    }
};
struct GroupedOrder {
    const unsigned* mte; const unsigned* mtr; int nmt, nN, G, c, lda, K; size_t bstride;
    __device__ bool next(int i, Unit& u) const {
        const long L = (long)i * G + c; if (L >= (long)nmt * nN) return false;
        const int mt = (int)(L / nN); u.pn = (int)(L % nN);
        const unsigned e = __builtin_amdgcn_readfirstlane(mte[mt]), r0 = __builtin_amdgcn_readfirstlane(mtr[mt]);
        u.pm = (int)(r0 >> 8); u.aoff = (size_t)r0 * lda * 2; u.boff = (size_t)e * bstride + (size_t)u.pn * BM * K * 2; return true;
    }
};

struct EpiBf16 {
    static constexpr bool PERM = true;
    bf16* O; int ldc;
    __device__ __forceinline__ void operator()(const f32x4 (&acc)[2][2][4][2], const Unit& u, int wr, int wc, int fr, int fq) const {
        const int row0 = u.pm * BM + wr * 64 + fr, col0 = u.pn * BM + wc * 32 + 8 * fq;
#pragma unroll
        for (int ai = 0; ai < 2; ++ai)
#pragma unroll
            for (int m = 0; m < 4; ++m) { bf16* rowp = O + (size_t)(row0 + ai * HALF + m * 16) * ldc + col0;
#pragma unroll
                for (int bj = 0; bj < 2; ++bj) { const f32x4 v0 = acc[ai][bj][m][0], v1 = acc[ai][bj][m][1];
                    u32x4 w; w.x = cvtpk(v0[0], v0[1]); w.y = cvtpk(v0[2], v0[3]); w.z = cvtpk(v1[0], v1[1]); w.w = cvtpk(v1[2], v1[3]);
                    *(u32x4*)(rowp + bj * HALF) = w; } }
    }
};
struct EpiResid {
    static constexpr bool PERM = false;
    float* X; int ldc;
    __device__ __forceinline__ void operator()(const f32x4 (&acc)[2][2][4][2], const Unit& u, int wr, int wc, int fr, int fq) const {
        const int row0 = u.pm * BM + wr * 64 + fr, col0 = u.pn * BM + wc * 32 + 4 * fq;
#pragma unroll
        for (int ai = 0; ai < 2; ++ai)
#pragma unroll
            for (int m = 0; m < 4; ++m) { float* rowp = X + (size_t)(row0 + ai * HALF + m * 16) * ldc + col0;
                f32x4 b[2][2];
#pragma unroll
                for (int bj = 0; bj < 2; ++bj)
#pragma unroll
                    for (int n = 0; n < 2; ++n) b[bj][n] = *(const f32x4*)(rowp + bj * HALF + n * 16);
#pragma unroll
                for (int bj = 0; bj < 2; ++bj)
#pragma unroll
                    for (int n = 0; n < 2; ++n) *(f32x4*)(rowp + bj * HALF + n * 16) = b[bj][n] + acc[ai][bj][m][n];
                asm volatile("" ::: "memory"); }
    }
};
struct EpiGateUp {
    static constexpr bool PERM = true;
    bf16* H; int ldc;
    __device__ __forceinline__ void operator()(const f32x4 (&acc)[2][2][4][2], const Unit& u, int wr, int wc, int fr, int fq) const {
        const int row0 = u.pm * BM + wr * 64 + fr, col0 = u.pn * HALF + wc * 32 + 8 * fq;
#pragma unroll
        for (int ai = 0; ai < 2; ++ai)
#pragma unroll
            for (int m = 0; m < 4; ++m) { bf16* rowp = H + (size_t)(row0 + ai * HALF + m * 16) * ldc + col0;
                float h[8];
#pragma unroll
                for (int n = 0; n < 2; ++n)
#pragma unroll
                    for (int j = 0; j < 4; ++j) { const float g = acc[ai][0][m][n][j], up = acc[ai][1][m][n][j]; h[n * 4 + j] = g * __builtin_amdgcn_rcpf(1.f + fexp(-g)) * up; }
                u32x4 w; w.x = cvtpk(h[0], h[1]); w.y = cvtpk(h[2], h[3]); w.z = cvtpk(h[4], h[5]); w.w = cvtpk(h[6], h[7]);
                *(u32x4*)rowp = w; }
    }
};

template <class Epi, class Sched>
__device__ __forceinline__ void gemm_phase(LAS unsigned char* lds, const int tid, const Gemm g, const Sched& S, const Epi& E) {
    const int wid = __builtin_amdgcn_readfirstlane(tid >> 6), lane = tid & 63, wr = wid >> 2, wc = wid & 3, fr = lane & 15, fq = lane >> 4;
    const int K = g.K, nt = K / BK, lda = g.lda;
    unsigned voffA[2], voffB[2];
#pragma unroll
    for (int i = 0; i < 2; ++i) { int R, C; stage_rc(tid * 16 + i * 8192, R, C); const int Rb = Epi::PERM ? ((R & ~31) + perm32(R & 31)) : R;
        voffA[i] = (unsigned)(R * lda + C) * 2u; voffB[i] = (unsigned)(Rb * K + C) * 2u; }
    const size_t kstep = (size_t)(BK * 2);
    const size_t hstepA = (size_t)HALF * lda * 2, hstepB = (size_t)HALF * K * 2;
    const unsigned ldsw = (unsigned)wid * 1024u;
    const int aoff = lds_byte(wr * 64 + fr, fq * 8), boff = lds_byte(wc * 32 + fr, fq * 8);
#define PG8_SA(b, h) (((b) * 2 + (h)) * HTB)
#define PG8_SB(b, h) ((4 + (b) * 2 + (h)) * HTB)
#define PG8_STAGE(bufoff, gbase, voff) do { _Pragma("unroll") for (int _i = 0; _i < 2; ++_i) \
        __builtin_amdgcn_global_load_lds((const unsigned*)((const char*)(gbase) + (voff)[_i]), (LAS unsigned*)(lds + (bufoff) + ldsw + _i * 8192), 16, 0, 0); } while (0)
#define PG8_LDA(dst, b, h) do { _Pragma("unroll") for (int m = 0; m < 4; ++m) _Pragma("unroll") for (int k = 0; k < 2; ++k) dst[m][k] = *(const LAS bf16x8*)(lds + PG8_SA(b, h) + aoff + m * 2048 + k * 1024); } while (0)
#define PG8_LDB(dst, b, h) do { _Pragma("unroll") for (int n = 0; n < 2; ++n) _Pragma("unroll") for (int k = 0; k < 2; ++k) dst[n][k] = *(const LAS bf16x8*)(lds + PG8_SB(b, h) + boff + n * 2048 + k * 1024); } while (0)
#define PG8_MMA(ai, bj, At, Bt) do { __builtin_amdgcn_s_setprio(1); _Pragma("unroll") for (int m = 0; m < 4; ++m) _Pragma("unroll") for (int n = 0; n < 2; ++n) _Pragma("unroll") for (int k = 0; k < 2; ++k) \
        acc[ai][bj][m][n] = __builtin_amdgcn_mfma_f32_16x16x32_bf16(Bt[n][k], At[m][k], acc[ai][bj][m][n], 0, 0, 0); __builtin_amdgcn_s_setprio(0); } while (0)
#define PG8_WAIT_V(n) asm volatile("s_waitcnt vmcnt(" #n ")" ::: "memory")
#define PG8_WAIT_L(n) asm volatile("s_waitcnt lgkmcnt(" #n ")" ::: "memory")
#define PG8_BAR __builtin_amdgcn_s_barrier()
#define PG8_SCHED __builtin_amdgcn_sched_barrier(0)
    Unit cur, nxt; int ui = 0;
    if (!S.next(0, cur)) return;
    f32x4 acc[2][2][4][2];
#pragma unroll
    for (int a = 0; a < 2; ++a)
#pragma unroll
        for (int b = 0; b < 2; ++b)
#pragma unroll
            for (int m = 0; m < 4; ++m)
#pragma unroll
                for (int n = 0; n < 2; ++n) acc[a][b][m][n] = (f32x4){0.f, 0.f, 0.f, 0.f};
    bf16x8 At[4][2], B0[2][2], B1[2][2];
    const char* cA = (const char*)g.A + cur.aoff; const char* cB = (const char*)g.Bt + cur.boff;
    PG8_STAGE(PG8_SB(0, 0), cB, voffB); PG8_STAGE(PG8_SB(0, 1), cB + hstepB, voffB); PG8_STAGE(PG8_SA(0, 0), cA, voffA); PG8_STAGE(PG8_SA(0, 1), cA + hstepA, voffA);
    if (wr == 1) PG8_BAR;
    PG8_WAIT_V(2); PG8_BAR;
    PG8_STAGE(PG8_SB(1, 0), cB + kstep, voffB); PG8_STAGE(PG8_SA(1, 0), cA + kstep, voffA); PG8_STAGE(PG8_SB(1, 1), cB + hstepB + kstep, voffB);
    PG8_WAIT_V(6); PG8_BAR;
    for (;;) {
        const bool has_next = S.next(ui + 1, nxt);
        const char* nA = has_next ? (const char*)g.A + nxt.aoff : cA; const char* nB = has_next ? (const char*)g.Bt + nxt.boff : cB;
#pragma nounroll
        for (int t = 0; t < nt; t += 2) {
            const bool last = (t == nt - 2);
            const char* a1 = cA + (size_t)(t + 1) * kstep;
            const char* a2 = last ? nA : cA + (size_t)(t + 2) * kstep; const char* b2 = last ? nB : cB + (size_t)(t + 2) * kstep;
            const char* a3 = a2 + kstep; const char* b3 = b2 + kstep;
            PG8_LDB(B0, 0, 0); PG8_LDB(B1, 0, 1); PG8_SCHED; PG8_LDA(At, 0, 0); PG8_STAGE(PG8_SA(1, 1), a1 + hstepA, voffA);
            PG8_WAIT_V(8); PG8_WAIT_L(0); PG8_BAR; PG8_MMA(0, 0, At, B0); PG8_MMA(0, 1, At, B1); PG8_BAR; PG8_SCHED;
            PG8_LDA(At, 0, 1); PG8_STAGE(PG8_SB(0, 0), b2, voffB); PG8_STAGE(PG8_SB(0, 1), b2 + hstepB, voffB); PG8_STAGE(PG8_SA(0, 0), a2, voffA);
            PG8_WAIT_V(8); PG8_WAIT_L(0); PG8_BAR; PG8_MMA(1, 0, At, B0); PG8_MMA(1, 1, At, B1); PG8_BAR; PG8_SCHED;
            PG8_LDB(B0, 1, 0); PG8_LDB(B1, 1, 1); PG8_SCHED; PG8_LDA(At, 1, 0); PG8_STAGE(PG8_SA(0, 1), a2 + hstepA, voffA);
            PG8_WAIT_V(8); PG8_WAIT_L(0); PG8_BAR; PG8_MMA(0, 0, At, B0); PG8_MMA(0, 1, At, B1); PG8_BAR; PG8_SCHED;
            PG8_LDA(At, 1, 1); PG8_STAGE(PG8_SB(1, 0), b3, voffB); PG8_STAGE(PG8_SB(1, 1), b3 + hstepB, voffB); PG8_STAGE(PG8_SA(1, 0), a3, voffA);
            PG8_WAIT_V(8); PG8_WAIT_L(0); PG8_BAR; PG8_MMA(1, 0, At, B0); PG8_MMA(1, 1, At, B1); PG8_BAR; PG8_SCHED;
        }
        if (wr == 0) PG8_BAR;
        E(acc, cur, wr, wc, fr, fq);
        if (!has_next) break;
#pragma unroll
        for (int a = 0; a < 2; ++a)
#pragma unroll
            for (int b = 0; b < 2; ++b)
#pragma unroll
                for (int m = 0; m < 4; ++m)
#pragma unroll
                    for (int n = 0; n < 2; ++n) acc[a][b][m][n] = (f32x4){0.f, 0.f, 0.f, 0.f};
        cur = nxt; cA = nA; cB = nB; ++ui;
        if (wr == 1) PG8_BAR;
    }
    PG8_WAIT_V(0);
    PG8_BAR;
#undef PG8_SA
#undef PG8_SB
#undef PG8_STAGE
#undef PG8_LDA
#undef PG8_LDB
#undef PG8_MMA
#undef PG8_WAIT_V
#undef PG8_WAIT_L
#undef PG8_BAR
#undef PG8_SCHED
}
}

struct Args { const float* in[32]; float* out; unsigned char* ws; int ph_lo, ph_hi; };
struct Frame {
    LAS unsigned char* lds; int tid, lane, wave, G, bid;
    unsigned char* ws; unsigned* ctl; const float* const* in; float* out;
};

__device__ __forceinline__ void transpose_item(const float* W, int K, int N, bf16* WT, int dst_row0, const float* gain, LAS float* scr, int kb, int nb, int lane) {
    const int k0 = 64 * kb, n0 = 32 * nb;
#pragma unroll 8
    for (int i = 0; i < 32; ++i) { const int kk = 2 * i + (lane >> 5); float v = W[(size_t)(k0 + kk) * N + n0 + (lane & 31)]; if (gain) v *= gain[k0 + kk]; scr[kk * 33 + (lane & 31)] = v; }
    LDS_WAIT(); asm volatile("" ::: "memory");
    const int c = lane & 7;
#pragma unroll
    for (int j = 0; j < 4; ++j) { const int n = (lane >> 3) + 8 * j; const LAS float* s = scr + (8 * c) * 33 + n;
        u32x4 o; o.x = pk2(s[0 * 33], s[1 * 33]); o.y = pk2(s[2 * 33], s[3 * 33]); o.z = pk2(s[4 * 33], s[5 * 33]); o.w = pk2(s[6 * 33], s[7 * 33]);
        *(u32x4*)(WT + (size_t)(dst_row0 + n) * K + k0 + 8 * c) = o; }
    LDS_WAIT(); asm volatile("" ::: "memory");
}
struct ConvMat { const float* W; bf16* WT; const float* gain; int K, N, kind; };
__device__ __forceinline__ void convert_matrix(Frame& F, const ConvMat& m, int& base, int gw, int NGW, LAS float* scr) {
    const int nnb = m.N / 32, nkb = m.K / 64, items = nnb * nkb;
    int first = (gw - base % NGW + NGW) % NGW;
    for (int it = first; it < items; it += NGW) {
        const int kb = it / nnb, nb = it % nnb, n0 = nb * 32;
        int r0 = n0; if (m.kind == 1) r0 = (n0 >> 7) * 256 + (n0 & 127); else if (m.kind == 2) r0 = (n0 >> 7) * 256 + 128 + (n0 & 127);
        transpose_item(m.W, m.K, m.N, m.WT, r0 - 0, m.gain, scr, kb, nb, F.lane);
        (void)n0;
    }
    base += items;
}
__device__ __forceinline__ void p_convert(Frame& F) {
    LAS float* scr = (LAS float*)(F.lds + F.wave * 16384);
    const int gw = F.bid * NWAVES + F.wave, NGW = F.G * NWAVES;
    int base = 0;
    for (int l = 0; l < DEPTH; ++l) {
        unsigned char* wl = F.ws + WS_W + (size_t)l * WL_END;
        { ConvMat m{F.in[5] + (size_t)l * D * INW, (bf16*)(wl + WL_WIN), nullptr, D, INW, 0}; convert_matrix(F, m, base, gw, NGW, scr); }
        { ConvMat m{F.in[12] + (size_t)l * 512 * 768, (bf16*)(wl + WL_WUQ), F.in[10] + l * 512, 512, 768, 0}; convert_matrix(F, m, base, gw, NGW, scr); }
        { ConvMat m{F.in[13] + (size_t)l * 256 * 1024, (bf16*)(wl + WL_WUKV), F.in[11] + l * 256, 256, 1024, 0}; convert_matrix(F, m, base, gw, NGW, scr); }
        { ConvMat m{F.in[16] + (size_t)l * D * D, (bf16*)(wl + WL_WOUT), nullptr, D, D, 0}; convert_matrix(F, m, base, gw, NGW, scr); }
        { ConvMat m{F.in[19] + (size_t)l * D * 512, (bf16*)(wl + WL_WMQ), nullptr, D, 512, 0}; convert_matrix(F, m, base, gw, NGW, scr); }
        { ConvMat m{F.in[20] + (size_t)l * D * 1024, (bf16*)(wl + WL_WMKV), nullptr, D, 1024, 0}; convert_matrix(F, m, base, gw, NGW, scr); }
        { ConvMat m{F.in[23] + (size_t)l * 512 * D, (bf16*)(wl + WL_WMO), nullptr, 512, D, 0}; convert_matrix(F, m, base, gw, NGW, scr); }
        for (int e = 0; e < NEXP; ++e) {
            bf16* gu = (bf16*)(wl + WL_WGU) + (size_t)e * 1024 * D;
            { ConvMat m{F.in[29] + ((size_t)l * NEXP + e) * D * DEXP, gu, nullptr, D, DEXP, 1}; convert_matrix(F, m, base, gw, NGW, scr); }
            { ConvMat m{F.in[30] + ((size_t)l * NEXP + e) * D * DEXP, gu, nullptr, D, DEXP, 2}; convert_matrix(F, m, base, gw, NGW, scr); }
            { ConvMat m{F.in[31] + ((size_t)l * NEXP + e) * DEXP * D, (bf16*)(wl + WL_WD) + (size_t)e * D * DEXP, nullptr, DEXP, D, 0}; convert_matrix(F, m, base, gw, NGW, scr); }
        }
        { u32x4* z = (u32x4*)((bf16*)(wl + WL_WIN) + (size_t)INW * D); const int n16 = (UW - INW) * D * 2 / 16;
          for (int i = F.bid * NTHR + F.tid; i < n16; i += F.G * NTHR) z[i] = (u32x4){0u, 0u, 0u, 0u}; }
    }
    for (int i = F.bid * NTHR + F.tid; i < 4096 * 32; i += F.G * NTHR) {
        const int pos = i >> 5, j = i & 31;
        const float inv = ex2(-(float)j * (13.287712379549449f / 32.0f));
        const float ang = (float)pos * inv;
        const double rev = (double)ang * 0.15915494309189535; const float fr = (float)(rev - floor(rev));
        float* rp = (float*)(F.ws + WS_ROPE) + 2 * i; rp[0] = __builtin_amdgcn_cosf(fr); rp[1] = __builtin_amdgcn_sinf(fr);
    }
    for (int i = F.bid * NTHR + F.tid; i < 1024; i += F.G * NTHR) {
        float* lb = (float*)(F.ws + WS_SMALL + SM_LB); const float a0 = F.in[3][i], a1 = F.in[3][1024 + i];
        const float mx = fmaxf(a0, a1), e0 = expf(a0 - mx), e1 = expf(a1 - mx), p0 = e0 / (e0 + e1), p1 = e1 / (e0 + e1);
        lb[i] = p0 - p0; lb[1024 + i] = (p0 + p1) - p0;
    }
}

__device__ __forceinline__ void norm_row(const float* xin, float* xout, bf16* hn, const float* gain, const bf16* y0, const bf16* y1, float g0, float g1, int lane) {
    f32x4 v[8]; float ss = 0.f;
#pragma unroll
    for (int j = 0; j < 8; ++j) { v[j] = *((const f32x4*)xin + lane + 64 * j);
        if (y0) { const u32x2 a = *((const u32x2*)y0 + lane + 64 * j), b = *((const u32x2*)y1 + lane + 64 * j);
            v[j][0] += g0 * bflo(a.x) + g1 * bflo(b.x); v[j][1] += g0 * bfhi(a.x) + g1 * bfhi(b.x); v[j][2] += g0 * bflo(a.y) + g1 * bflo(b.y); v[j][3] += g0 * bfhi(a.y) + g1 * bfhi(b.y); }
        ss += (v[j][0] * v[j][0] + v[j][1] * v[j][1]) + (v[j][2] * v[j][2] + v[j][3] * v[j][3]); }
    if (xout) {
#pragma unroll
        for (int j = 0; j < 8; ++j) *((f32x4*)xout + lane + 64 * j) = v[j]; }
    if (hn) {
        const float rstd = __builtin_amdgcn_rsqf(wave_sum(ss) * (1.f / D) + EPS);
#pragma unroll
        for (int j = 0; j < 8; ++j) { const f32x4 gv = *((const f32x4*)gain + lane + 64 * j);
            u32x2 o; o.x = pk2(v[j][0] * rstd * gv[0], v[j][1] * rstd * gv[1]); o.y = pk2(v[j][2] * rstd * gv[2], v[j][3] * rstd * gv[3]);
            *((u32x2*)hn + lane + 64 * j) = o; }
    }
}

struct AttnU { const bf16* Q; const bf16* K; const bf16* VT; bf16* O; int qs, ks, vts, os, q0, t_lo, t_hi; float* dbg; };
constexpr int AT_ML = 98304;
template <int DQK, int DV, int MODE, bool QNORM>
__device__ __forceinline__ void attn_unit(LAS unsigned char* lds, const int tid, const AttnU u, const float scl2, const float* qgain, const float sink2, const LAS float* biasT) {
    constexpr int KROW = DQK * 2, VROW = 128, KBUF = 64 * KROW, VBUF = DV * VROW, KOFF = 0, VOFF = 2 * KBUF;
    constexpr int KCH = DQK / 8, NKC = 64 * KCH / 512, NVC = DV * 8 / 512, ND0 = DQK / 16, NDB = DV / 32;
    static_assert(2 * KBUF + 2 * VBUF <= AT_ML && 4 * 32 * DV * 4 <= AT_ML, "attention LDS map");
#define AT_KSWZ(row) (KCH == 16 ? ((row) & 15) : (((row) >> 1) & 7))
    const int wid = __builtin_amdgcn_readfirstlane(tid >> 6), lane = tid & 63, r32 = lane & 31, hi = lane >> 5, g = wid & 3, kh = wid >> 2;
    LAS float* Ms = (LAS float*)(lds + AT_ML);
    LAS float* Ls = Ms + 256;
    LAS float* Al = Ls + 256 + wid * 32;
    LAS float* OM = (LAS float*)lds;
    bf16x8 qr[ND0];
    { const bf16* qp = u.Q + (size_t)(32 * g + r32) * u.qs + 8 * hi;
#pragma unroll
      for (int d0 = 0; d0 < ND0; ++d0) qr[d0] = *(const bf16x8*)(qp + 16 * d0);
      if constexpr (QNORM) {
          float ss = 0.f;
#pragma unroll
          for (int d0 = 0; d0 < ND0; ++d0)
#pragma unroll
              for (int j = 0; j < 8; ++j) { const float v = bf2f((unsigned short)qr[d0][j]); ss += v * v; }
          ss = swap_sum(ss);
          const float rstd = __builtin_amdgcn_rsqf(ss * (1.f / DQK) + EPS);
#pragma unroll
          for (int d0 = 0; d0 < ND0; ++d0) { const f32x4 g0 = *(const f32x4*)(qgain + 16 * d0 + 8 * hi), g1 = *(const f32x4*)(qgain + 16 * d0 + 8 * hi + 4);
              u32x4 w; w.x = pk2(bf2f((unsigned short)qr[d0][0]) * rstd * g0[0], bf2f((unsigned short)qr[d0][1]) * rstd * g0[1]); w.y = pk2(bf2f((unsigned short)qr[d0][2]) * rstd * g0[2], bf2f((unsigned short)qr[d0][3]) * rstd * g0[3]);
              w.z = pk2(bf2f((unsigned short)qr[d0][4]) * rstd * g1[0], bf2f((unsigned short)qr[d0][5]) * rstd * g1[1]); w.w = pk2(bf2f((unsigned short)qr[d0][6]) * rstd * g1[2], bf2f((unsigned short)qr[d0][7]) * rstd * g1[3]);
              qr[d0] = __builtin_bit_cast(bf16x8, w); }
      } }
    unsigned kvo[NKC], vvo[NVC];
#pragma unroll
    for (int i = 0; i < NKC; ++i) { const int p = tid + 512 * i, row = p / KCH, cp = p % KCH; kvo[i] = (unsigned)(row * u.ks + ((cp ^ AT_KSWZ(row)) << 3)); }
#pragma unroll
    for (int i = 0; i < NVC; ++i) { const int p = tid + 512 * i, d = p >> 3, cp = p & 7; vvo[i] = (unsigned)(d * u.vts + ((cp ^ ((d >> 1) & 7)) << 3)); }
#define AT_STAGE(t, bf) do { const bf16* kt_ = u.K + (size_t)(64 * (t)) * u.ks; const bf16* vt_ = u.VT + 64 * (t); \
        _Pragma("unroll") for (int i_ = 0; i_ < NKC; ++i_) __builtin_amdgcn_global_load_lds((const unsigned*)(kt_ + kvo[i_]), (LAS unsigned*)(lds + KOFF + (bf) * KBUF + (512 * i_ + wid * 64) * 16), 16, 0, 0); \
        _Pragma("unroll") for (int i_ = 0; i_ < NVC; ++i_) __builtin_amdgcn_global_load_lds((const unsigned*)(vt_ + vvo[i_]), (LAS unsigned*)(lds + VOFF + (bf) * VBUF + (512 * i_ + wid * 64) * 16), 16, 0, 0); } while (0)
    float m_run = -1e30f, l_run = 0.f;
    f32x16 o[NDB];
#pragma unroll
    for (int i = 0; i < NDB; ++i)
#pragma unroll
        for (int r = 0; r < 16; ++r) o[i][r] = 0.f;
    const int qa = u.q0 + 32 * g;
    const int qpos = qa + r32;
    const int krow = 32 * kh + r32, kswz = AT_KSWZ(krow), vswz = (r32 >> 1) & 7;
    int buf = 0;
    AT_STAGE(u.t_lo, 0); VM_WAIT(); __syncthreads();
    for (int t = u.t_lo; t < u.t_hi; ++t) {
        if (t + 1 < u.t_hi) AT_STAGE(t + 1, buf ^ 1);
        SBAR();
        const int kb0 = 64 * t + 32 * kh;
        bool act = true;
#ifndef MK_NOSKIP
        if constexpr (MODE == 1) act = kb0 <= qa + 31;
        if constexpr (MODE == 2) act = (qa + 31 - kb0 >= 0) && (qa - (kb0 + 31) <= 127);
#endif
        if (act) {
            f32x16 p;
#pragma unroll
            for (int r = 0; r < 16; ++r) p[r] = 0.f;
            int ksw = kswz, vsw = vswz; asm volatile("" : "+v"(ksw), "+v"(vsw));
            const LAS unsigned char* kb = lds + KOFF + buf * KBUF + krow * KROW;
#pragma unroll
            for (int d0 = 0; d0 < ND0; ++d0) { const bf16x8 a = *(const LAS bf16x8*)(kb + (((2 * d0 + hi) ^ ksw) << 4)); p = __builtin_amdgcn_mfma_f32_32x32x16_bf16(a, qr[d0], p, 0, 0, 0); if ((d0 & 3) == 3) SBAR(); }
            const int dq = qpos - kb0 - 4 * hi;
            float pmax = -1e30f;
#pragma unroll
            for (int r = 0; r < 16; ++r) { const int c = (r & 3) + 8 * (r >> 2); float s = p[r] * scl2;
                if constexpr (MODE == 1) { if (dq - c < 0) s = -__builtin_inff(); }
                if constexpr (MODE == 2) { const int dist = dq - c; const bool ok = (unsigned)dist < 128u; const float bv = biasT[ok ? dist : 0]; s = ok ? s + bv : -__builtin_inff(); }
                p[r] = s; pmax = fmaxf(pmax, s); }
#if MK_DEBUG
            if (u.dbg && t == u.t_lo) { for (int r = 0; r < 16; ++r) u.dbg[(wid * 64 + lane) * 16 + r] = p[r]; }
#endif
            pmax = swap_max(pmax);
            const float m_new = fmaxf(m_run, pmax), alpha = ex2(m_run - m_new);
            float ps = 0.f;
#pragma unroll
            for (int r = 0; r < 16; ++r) { p[r] = ex2(p[r] - m_new); ps += p[r]; }
            ps = swap_sum(ps);
            l_run = l_run * alpha + ps; m_run = m_new;
            if (__any(alpha < 1.f)) {
                if (hi == 0) Al[r32] = alpha;
                LDS_WAIT();
#pragma unroll
                for (int r = 0; r < 16; ++r) { const float a = Al[crow(r, hi)];
#pragma unroll
                    for (int i = 0; i < NDB; ++i) o[i][r] *= a; }
                LDS_WAIT();
            }
            bf16x8 pa0, pa1; PK4(p, 0, pa0); PK4(p, 8, pa1);
            SBAR();
            const LAS unsigned char* vb = lds + VOFF + buf * VBUF + r32 * VROW;
#pragma unroll
            for (int i = 0; i < NDB; ++i) { const bf16x8 b0 = *(const LAS bf16x8*)(vb + i * 32 * VROW + (((4 * kh + hi) ^ vsw) << 4)), b1 = *(const LAS bf16x8*)(vb + i * 32 * VROW + (((4 * kh + 2 + hi) ^ vsw) << 4));
                o[i] = __builtin_amdgcn_mfma_f32_32x32x16_bf16(pa0, b0, o[i], 0, 0, 0); o[i] = __builtin_amdgcn_mfma_f32_32x32x16_bf16(pa1, b1, o[i], 0, 0, 0); if (i & 1) SBAR(); }
        }
        SBAR();
        VM_WAIT(); __syncthreads();
        buf ^= 1;
    }
#undef AT_STAGE
#undef AT_KSWZ
#if MK_DEBUG
    if (u.dbg) { u.dbg[8192 + (wid * 64 + lane) * 2] = m_run; u.dbg[8192 + (wid * 64 + lane) * 2 + 1] = l_run;
        for (int i = 0; i < NDB; ++i) for (int r = 0; r < 16; ++r) u.dbg[16384 + ((wid * 64 + lane) * 4 + i) * 16 + r] = o[i][r]; }
#endif
    if (hi == 0) { Ms[wid * 32 + r32] = m_run; Ls[wid * 32 + r32] = l_run; }
    if (kh == 1) {
#pragma unroll
        for (int i = 0; i < NDB; ++i)
#pragma unroll
            for (int r = 0; r < 16; ++r) OM[(g * 32 + crow(r, hi)) * DV + 32 * i + r32] = o[i][r];
    }
    LDS_WAIT(); __syncthreads();
    if (kh == 0) {
#pragma unroll
        for (int r = 0; r < 16; ++r) { const int q = crow(r, hi);
            const float m0 = Ms[g * 32 + q], m1 = Ms[(4 + g) * 32 + q], l0 = Ls[g * 32 + q], l1 = Ls[(4 + g) * 32 + q];
            const float mm = fmaxf(m0, m1), a0 = ex2(m0 - mm), a1 = ex2(m1 - mm);
            float L = l0 * a0 + l1 * a1; if constexpr (MODE == 2) L += ex2(sink2 - mm);
            const float inv = 1.f / L;
            bf16* orow = u.O + (size_t)(32 * g + q) * u.os;
#pragma unroll
            for (int i = 0; i < NDB; ++i) { const float v = (o[i][r] * a0 + OM[(g * 32 + q) * DV + 32 * i + r32] * a1) * inv; const float vn = __shfl_xor(v, 1);
                if ((r32 & 1) == 0) *(unsigned*)(orow + 32 * i + r32) = pk2(v, vn); }
            SBAR(); }
    }
    __syncthreads();
}

template <int NC>
__device__ __forceinline__ void transpose_tile64(LAS unsigned char* lds, const bf16* src, int sstr, const float* rowscale, bf16* dst, size_t dstr, int tid) {
    constexpr int CPT = NC / 8;
    const int row = tid >> 3, c0 = (tid & 7) * CPT;
    const float sc = rowscale ? rowscale[row] : 1.f;
#pragma unroll
    for (int i = 0; i < CPT / 8; ++i) { const u32x4 w = *(const u32x4*)(src + (size_t)row * sstr + c0 + 8 * i); const unsigned ww[4] = {w.x, w.y, w.z, w.w};
#pragma unroll
        for (int j = 0; j < 4; ++j) { unsigned lo = ww[j] & 0xffffu, hi = ww[j] >> 16; if (rowscale) { lo = f2bf(bf2f(lo) * sc); hi = f2bf(bf2f(hi) * sc); }
            *(LAS unsigned short*)(lds + (c0 + 8 * i + 2 * j) * 144 + row * 2) = (unsigned short)lo; *(LAS unsigned short*)(lds + (c0 + 8 * i + 2 * j + 1) * 144 + row * 2) = (unsigned short)hi; } }
    LDS_WAIT(); __syncthreads();
    if constexpr (NC == 512) { const int col = tid;
#pragma unroll
        for (int i = 0; i < 8; ++i) *(u32x4*)(dst + (size_t)col * dstr + 8 * i) = *(const LAS u32x4*)(lds + col * 144 + 16 * i); }
    else { const int col = tid >> 2, ch = (tid & 3) * 2;
#pragma unroll
        for (int i = 0; i < 2; ++i) *(u32x4*)(dst + (size_t)col * dstr + 8 * (ch + i)) = *(const LAS u32x4*)(lds + col * 144 + 16 * (ch + i)); }
    __syncthreads();
}

__device__ __forceinline__ void p_prep(Frame& F, int l) {
    bf16* U = (bf16*)(F.ws + WS_OVL + OV_U); bf16* SVT = (bf16*)(F.ws + WS_OVL + OV_SVT);
    float* rcq = (float*)(F.ws + WS_SMALL + SM_RSTDCQ); float* rckv = (float*)(F.ws + WS_SMALL + SM_RSTDCKV);
    const float* gq = F.in[6] + l * 64; const float* gk = F.in[7] + l * 64;
    const int lane = F.lane;
    for (int tile = F.bid; tile < NTOK / 64; tile += F.G) {
        for (int rr = 0; rr < 8; ++rr) { const int row = tile * 64 + F.wave * 8 + rr; bf16* up = U + (size_t)row * UW;
            { u32x4 w = *(const u32x4*)(up + C_SQ + 8 * lane); const unsigned ww[4] = {w.x, w.y, w.z, w.w}; float v[8]; float ss = 0.f;
#pragma unroll
              for (int j = 0; j < 4; ++j) { v[2 * j] = bflo(ww[j]); v[2 * j + 1] = bfhi(ww[j]); ss += v[2 * j] * v[2 * j] + v[2 * j + 1] * v[2 * j + 1]; }
              ss += __shfl_xor(ss, 1); ss += __shfl_xor(ss, 2); ss += __shfl_xor(ss, 4);
              const float rstd = __builtin_amdgcn_rsqf(ss * (1.f / 64) + EPS); const float* gp = gq + (lane & 7) * 8;
              u32x4 o; o.x = pk2(v[0] * rstd * gp[0], v[1] * rstd * gp[1]); o.y = pk2(v[2] * rstd * gp[2], v[3] * rstd * gp[3]); o.z = pk2(v[4] * rstd * gp[4], v[5] * rstd * gp[5]); o.w = pk2(v[6] * rstd * gp[6], v[7] * rstd * gp[7]);
              *(u32x4*)(up + C_SQ + 8 * lane) = o; }
            { const int l16 = lane & 15; u32x4 w = *(const u32x4*)(up + C_SK + 8 * l16); const unsigned ww[4] = {w.x, w.y, w.z, w.w}; float v[8]; float ss = 0.f;
#pragma unroll
              for (int j = 0; j < 4; ++j) { v[2 * j] = bflo(ww[j]); v[2 * j + 1] = bfhi(ww[j]); ss += v[2 * j] * v[2 * j] + v[2 * j + 1] * v[2 * j + 1]; }
              ss += __shfl_xor(ss, 1); ss += __shfl_xor(ss, 2); ss += __shfl_xor(ss, 4);
              const float rstd = __builtin_amdgcn_rsqf(ss * (1.f / 64) + EPS); const float* gp = gk + (lane & 7) * 8;
              u32x4 o; o.x = pk2(v[0] * rstd * gp[0], v[1] * rstd * gp[1]); o.y = pk2(v[2] * rstd * gp[2], v[3] * rstd * gp[3]); o.z = pk2(v[4] * rstd * gp[4], v[5] * rstd * gp[5]); o.w = pk2(v[6] * rstd * gp[6], v[7] * rstd * gp[7]);
              if (lane < 16) *(u32x4*)(up + C_SK + 8 * l16) = o; }
            { u32x4 w = *(const u32x4*)(up + C_CQ + 8 * lane); const unsigned ww[4] = {w.x, w.y, w.z, w.w}; float ss = 0.f;
#pragma unroll
              for (int j = 0; j < 4; ++j) { const float a = bflo(ww[j]), b = bfhi(ww[j]); ss += a * a + b * b; }
              ss = wave_sum(ss); if (lane == 0) rcq[row] = __builtin_amdgcn_rsqf(ss * (1.f / 512) + EPS); }
            { u32x2 w = *(const u32x2*)(up + C_CKV + 4 * lane); float ss = bflo(w.x) * bflo(w.x) + bfhi(w.x) * bfhi(w.x) + bflo(w.y) * bflo(w.y) + bfhi(w.y) * bfhi(w.y);
              ss = wave_sum(ss); if (lane == 0) rckv[row] = __builtin_amdgcn_rsqf(ss * (1.f / 256) + EPS); }
        }
        const int b = tile >> 6, s0 = (tile & 63) * 64;
        transpose_tile64<128>(F.lds, U + (size_t)tile * 64 * UW + C_SV, UW, nullptr, SVT + (size_t)b * 128 * SEQ + s0, SEQ, F.tid);
    }
}

__device__ __forceinline__ void p_mla_post(Frame& F, int l) {
    const bf16* U = (const bf16*)(F.ws + WS_OVL + OV_U); const bf16* QM = (const bf16*)(F.ws + WS_OVL + OV_QM); const bf16* KVM = (const bf16*)(F.ws + WS_OVL + OV_KVM);
    bf16* QF = (bf16*)(F.ws + WS_OVL + OV_QF); bf16* KF = (bf16*)(F.ws + WS_OVL + OV_KF); bf16* VT = (bf16*)(F.ws + WS_OVL + OV_VT);
    const float* rcq = (const float*)(F.ws + WS_SMALL + SM_RSTDCQ); const float* rckv = (const float*)(F.ws + WS_SMALL + SM_RSTDCKV);
    const float* rope = (const float*)(F.ws + WS_ROPE);
    const float* gq = F.in[14] + l * 192; const float* gk = F.in[15] + l * 192;
    const int lane = F.lane, h = lane >> 4, lh = lane & 15;
    for (int tile = F.bid; tile < NTOK / 64; tile += F.G) {
        for (int rr = 0; rr < 8; ++rr) { const int row = tile * 64 + F.wave * 8 + rr, b = row >> 12, s = row & 4095;
            const f32x4 cs = *(const f32x4*)(rope + ((size_t)s * 32 + 2 * lh) * 2);
#pragma unroll
            for (int which = 0; which < 2; ++which) {
                const bf16* np = which == 0 ? QM + (size_t)row * 768 + h * 192 + 8 * lh : KVM + (size_t)row * 1024 + h * 256 + 8 * lh;
                const bf16* rp = which == 0 ? QM + (size_t)row * 768 + h * 192 + 128 : U + (size_t)row * UW + C_KR;
                const float sc = which == 0 ? rcq[row] : rckv[row], scr = which == 0 ? sc : 1.f;
                const float* gg = which == 0 ? gq : gk;
                const u32x4 w = *(const u32x4*)np; const unsigned ww[4] = {w.x, w.y, w.z, w.w};
                const unsigned r1 = *(const unsigned*)(rp + 2 * lh), r2 = *(const unsigned*)(rp + 32 + 2 * lh);
                float v[8]; float ss = 0.f;
#pragma unroll
                for (int j = 0; j < 4; ++j) { v[2 * j] = bflo(ww[j]) * sc; v[2 * j + 1] = bfhi(ww[j]) * sc; ss += v[2 * j] * v[2 * j] + v[2 * j + 1] * v[2 * j + 1]; }
                float x1a = bflo(r1) * scr, x1b = bfhi(r1) * scr, x2a = bflo(r2) * scr, x2b = bfhi(r2) * scr;
                ss += x1a * x1a + x1b * x1b + x2a * x2a + x2b * x2b;
                ss += __shfl_xor(ss, 1); ss += __shfl_xor(ss, 2); ss += __shfl_xor(ss, 4); ss += __shfl_xor(ss, 8);
                const float rstd = __builtin_amdgcn_rsqf(ss * (1.f / 192) + EPS);
                const float* g8 = gg + 8 * lh;
                u32x4 o; o.x = pk2(v[0] * rstd * g8[0], v[1] * rstd * g8[1]); o.y = pk2(v[2] * rstd * g8[2], v[3] * rstd * g8[3]); o.z = pk2(v[4] * rstd * g8[4], v[5] * rstd * g8[5]); o.w = pk2(v[6] * rstd * g8[6], v[7] * rstd * g8[7]);
                x1a *= rstd * gg[128 + 2 * lh]; x1b *= rstd * gg[128 + 2 * lh + 1]; x2a *= rstd * gg[160 + 2 * lh]; x2b *= rstd * gg[160 + 2 * lh + 1];
                const float o1a = x1a * cs[0] - x2a * cs[1], o2a = x1a * cs[1] + x2a * cs[0], o1b = x1b * cs[2] - x2b * cs[3], o2b = x1b * cs[3] + x2b * cs[2];
                bf16* op = (which == 0 ? QF : KF) + ((size_t)(b * 4 + h) * SEQ + s) * 192;
                *(u32x4*)(op + 8 * lh) = o; *(unsigned*)(op + 128 + 2 * lh) = pk2(o1a, o1b); *(unsigned*)(op + 160 + 2 * lh) = pk2(o2a, o2b);
            } }
        const int b = tile >> 6, s0 = (tile & 63) * 64;
        for (int hh = 0; hh < 4; ++hh)
            transpose_tile64<128>(F.lds, KVM + (size_t)tile * 64 * 1024 + hh * 256 + 128, 1024, rckv + tile * 64, VT + ((size_t)(b * 4 + hh) * 128) * SEQ + s0, SEQ, F.tid);
    }
}

__device__ __forceinline__ void p_mem_post(Frame& F) {
    const int lane = F.lane, h = lane >> 4, lh = lane & 15;
    for (int unit = F.bid; unit < 32; unit += F.G) { const int l = unit >> 4, tile = unit & 15;
        const bf16* MKV = (const bf16*)(F.ws + WS_MKV) + (size_t)l * 1024 * 1024; bf16* MK = (bf16*)(F.ws + WS_MK) + (size_t)l * 1024 * 512; bf16* MVT = (bf16*)(F.ws + WS_MVT) + (size_t)l * 1024 * 512;
        const float* gk = F.in[22] + l * 128;
        for (int rr = 0; rr < 8; ++rr) { const int row = tile * 64 + F.wave * 8 + rr, b = row >> 8, m = row & 255;
            const u32x4 w = *(const u32x4*)(MKV + (size_t)row * 1024 + h * 128 + 8 * lh); const unsigned ww[4] = {w.x, w.y, w.z, w.w}; float v[8]; float ss = 0.f;
#pragma unroll
            for (int j = 0; j < 4; ++j) { v[2 * j] = bflo(ww[j]); v[2 * j + 1] = bfhi(ww[j]); ss += v[2 * j] * v[2 * j] + v[2 * j + 1] * v[2 * j + 1]; }
            ss += __shfl_xor(ss, 1); ss += __shfl_xor(ss, 2); ss += __shfl_xor(ss, 4); ss += __shfl_xor(ss, 8);
            const float rstd = __builtin_amdgcn_rsqf(ss * (1.f / 128) + EPS); const float* g8 = gk + 8 * lh;
            u32x4 o; o.x = pk2(v[0] * rstd * g8[0], v[1] * rstd * g8[1]); o.y = pk2(v[2] * rstd * g8[2], v[3] * rstd * g8[3]); o.z = pk2(v[4] * rstd * g8[4], v[5] * rstd * g8[5]); o.w = pk2(v[6] * rstd * g8[6], v[7] * rstd * g8[7]);
            *(u32x4*)(MK + ((size_t)(b * 4 + h) * 256 + m) * 128 + 8 * lh) = o; }
        const int b = tile >> 2, m0 = (tile & 3) * 64;
        for (int hh = 0; hh < 4; ++hh)
            transpose_tile64<128>(F.lds, MKV + (size_t)tile * 64 * 1024 + 512 + hh * 128, 1024, nullptr, MVT + ((size_t)(b * 4 + hh) * 128) * 256 + m0, 256, F.tid);
    }
}

constexpr int HG_QH = 0, HG_KH = 64 * 272, HG_KT = 2 * 64 * 272, HG_VT = HG_KT + 128 * 144, HG_TOT = HG_VT + 128 * 144;
__device__ __forceinline__ void p_hgrn1(Frame& F, int l) {
    const bf16* U = (const bf16*)(F.ws + WS_OVL + OV_U); bf16* QT = (bf16*)(F.ws + WS_OVL + OV_QT); bf16* INTRA = (bf16*)(F.ws + WS_OVL + OV_INTRA); bf16* UT = (bf16*)(F.ws + WS_OVL + OV_UT);
    float* DEC = (float*)(F.ws + WS_OVL + OV_DEC); const float* lb = (const float*)(F.ws + WS_SMALL + SM_LB) + l * 1024;
    LAS unsigned char* lds = F.lds; LAS float* tot = (LAS float*)(lds + HG_TOT);
    const int tid = F.tid, lane = F.lane, wid = F.wave, r32 = lane & 31, hi = lane >> 5;
    const int ch = tid & 127, part = tid >> 7;
    for (int unit = F.bid; unit < 2048; unit += F.G) {
        const int b = unit >> 9, h = (unit >> 6) & 7, c = unit & 63, row0 = b * SEQ + 64 * c;
        const bf16* base = U + (size_t)(row0 + 16 * part) * UW + h * 128 + ch;
        const float lbv = lb[h * 128 + ch];
        float cs[16], kin[16]; float run = 0.f;
#pragma unroll
        for (int i = 0; i < 16; ++i) { const float f = bf2f(base[(size_t)i * UW + C_HF]); const float sig = __builtin_amdgcn_rcpf(1.f + fexp(-f));
            const float fv = lbv + (1.f - lbv) * sig; run += flog(fv); cs[i] = run; kin[i] = (1.f - lbv) * (1.f - sig); }
        tot[part * 128 + ch] = run;
        LDS_WAIT(); __syncthreads();
        const float t0 = tot[ch], t1 = tot[128 + ch], t2 = tot[256 + ch], t3 = tot[384 + ch];
        const float off = (part > 0 ? t0 : 0.f) + (part > 1 ? t1 : 0.f) + (part > 2 ? t2 : 0.f), rref = t0 + t1, btot = (t0 + t1) + (t2 + t3);
#pragma unroll
        for (int i = 0; i < 16; ++i) { const int s = 16 * part + i; const float bc = off + cs[i];
            const float q = bf2f(base[(size_t)i * UW + C_HQ]); const unsigned short vb = base[(size_t)i * UW + C_HI];
            *(LAS unsigned short*)(lds + HG_QH + s * 272 + ch * 2) = (unsigned short)f2bf(q * fexp(bc - rref));
            *(LAS unsigned short*)(lds + HG_KH + s * 272 + ch * 2) = (unsigned short)f2bf(kin[i] * fexp(rref - bc));
            QT[(size_t)(row0 + s) * 1024 + h * 128 + ch] = (unsigned short)f2bf(q * fexp(bc));
            *(LAS unsigned short*)(lds + HG_KT + ch * 144 + s * 2) = (unsigned short)f2bf(kin[i] * fexp(btot - bc));
            *(LAS unsigned short*)(lds + HG_VT + ch * 144 + s * 2) = vb; }
        if (part == 0) DEC[unit * 128 + ch] = fexp(btot);
        LDS_WAIT(); __syncthreads();
        const int tb = wid >> 2, vb = wid & 3;
        bf16x8 pa[2][2];
#pragma unroll
        for (int sb = 0; sb < 2; ++sb) {
            if (sb <= tb) {
                f32x16 p;
#pragma unroll
                for (int r = 0; r < 16; ++r) p[r] = 0.f;
#pragma unroll
                for (int d0 = 0; d0 < 8; ++d0) { const bf16x8 a = *(const LAS bf16x8*)(lds + HG_KH + (32 * sb + r32) * 272 + (16 * d0 + 8 * hi) * 2), bq = *(const LAS bf16x8*)(lds + HG_QH + (32 * tb + r32) * 272 + (16 * d0 + 8 * hi) * 2);
                    p = __builtin_amdgcn_mfma_f32_32x32x16_bf16(a, bq, p, 0, 0, 0); }
#pragma unroll
                for (int r = 0; r < 16; ++r) { const int s = 32 * sb + crow(r, hi), t = 32 * tb + r32; if (s > t) p[r] = 0.f; }
                PK4(p, 0, pa[sb][0]); PK4(p, 8, pa[sb][1]);
            }
        }
        { f32x16 o;
#pragma unroll
          for (int r = 0; r < 16; ++r) o[r] = 0.f;
#pragma unroll
          for (int sb = 0; sb < 2; ++sb) if (sb <= tb) {
#pragma unroll
              for (int ks = 0; ks < 2; ++ks) { const bf16x8 bv = *(const LAS bf16x8*)(lds + HG_VT + (32 * vb + r32) * 144 + (32 * sb + 16 * ks + 8 * hi) * 2);
                  o = __builtin_amdgcn_mfma_f32_32x32x16_bf16(pa[sb][ks], bv, o, 0, 0, 0); } }
#pragma unroll
          for (int r = 0; r < 16; ++r) { const int t = 32 * tb + crow(r, hi); const float v = o[r], vn = __shfl_xor(v, 1);
              if ((r32 & 1) == 0) *(unsigned*)(INTRA + (size_t)(row0 + t) * 1024 + h * 128 + 32 * vb + r32) = pk2(v, vn); } }
#pragma unroll
        for (int j = 0; j < 2; ++j) { const int kbk = 2 * tb + j; f32x16 a2;
#pragma unroll
            for (int r = 0; r < 16; ++r) a2[r] = 0.f;
#pragma unroll
            for (int ks = 0; ks < 4; ++ks) { const bf16x8 av = *(const LAS bf16x8*)(lds + HG_VT + (32 * vb + r32) * 144 + (16 * ks + 8 * hi) * 2), bk = *(const LAS bf16x8*)(lds + HG_KT + (32 * kbk + r32) * 144 + (16 * ks + 8 * hi) * 2);
                a2 = __builtin_amdgcn_mfma_f32_32x32x16_bf16(av, bk, a2, 0, 0, 0); }
#pragma unroll
            for (int r = 0; r < 16; ++r) { const int v = 32 * vb + crow(r, hi); const float x = a2[r], xn = __shfl_xor(x, 1);
                if ((r32 & 1) == 0) *(unsigned*)(UT + ((size_t)unit * 128 + v) * 128 + 32 * kbk + r32) = pk2(x, xn); } }
        __syncthreads();
    }
}
__device__ __forceinline__ void p_hgrn2(Frame& F) {
    bf16* UT = (bf16*)(F.ws + WS_OVL + OV_UT); const float* DEC = (const float*)(F.ws + WS_OVL + OV_DEC);
    for (int id = F.bid * NTHR + F.tid; id < 32 * 4096; id += F.G * NTHR) {
        const int bh = id >> 12, rem = id & 4095, v = rem >> 5, k4 = rem & 31;
        float st[4] = {0.f, 0.f, 0.f, 0.f};
        for (int c0 = 0; c0 < 64; c0 += 8) {
            u32x2 uu[8]; f32x4 dd[8];
#pragma unroll
            for (int j = 0; j < 8; ++j) { const size_t un = (size_t)bh * 64 + c0 + j; uu[j] = *(const u32x2*)(UT + (un * 128 + v) * 128 + 4 * k4); dd[j] = *(const f32x4*)(DEC + un * 128 + 4 * k4); }
#pragma unroll
            for (int j = 0; j < 8; ++j) { const size_t un = (size_t)bh * 64 + c0 + j;
                u32x2 o; o.x = pk2(st[0], st[1]); o.y = pk2(st[2], st[3]); *(u32x2*)(UT + (un * 128 + v) * 128 + 4 * k4) = o;
                st[0] = st[0] * dd[j][0] + bflo(uu[j].x); st[1] = st[1] * dd[j][1] + bfhi(uu[j].x); st[2] = st[2] * dd[j][2] + bflo(uu[j].y); st[3] = st[3] * dd[j][3] + bfhi(uu[j].y); }
        }
    }
}
__device__ __forceinline__ void p_hgrn3(Frame& F, int l) {
    const bf16* U = (const bf16*)(F.ws + WS_OVL + OV_U); const bf16* QT = (const bf16*)(F.ws + WS_OVL + OV_QT); const bf16* INTRA = (const bf16*)(F.ws + WS_OVL + OV_INTRA); const bf16* UT = (const bf16*)(F.ws + WS_OVL + OV_UT);
    bf16* MIX = (bf16*)(F.ws + WS_OVL + OV_MIX); const float* gout = F.in[9] + l * 128;
    LAS float* OL = (LAS float*)F.lds;
    const int tid = F.tid, lane = F.lane, wid = F.wave, r32 = lane & 31, hi = lane >> 5, tb = wid >> 2, vb = wid & 3;
    for (int unit = F.bid; unit < 2048; unit += F.G) {
        const int b = unit >> 9, h = (unit >> 6) & 7, c = unit & 63, row0 = b * SEQ + 64 * c;
        f32x16 acc;
#pragma unroll
        for (int r = 0; r < 16; ++r) acc[r] = 0.f;
        const bf16* ap = QT + (size_t)(row0 + 32 * tb + r32) * 1024 + h * 128 + 8 * hi; const bf16* bp = UT + ((size_t)unit * 128 + 32 * vb + r32) * 128 + 8 * hi;
#pragma unroll
        for (int ks = 0; ks < 8; ++ks) { const bf16x8 a = *(const bf16x8*)(ap + 16 * ks), bb = *(const bf16x8*)(bp + 16 * ks); acc = __builtin_amdgcn_mfma_f32_32x32x16_bf16(a, bb, acc, 0, 0, 0); }
#pragma unroll
        for (int r = 0; r < 16; ++r) OL[(32 * tb + crow(r, hi)) * 132 + 32 * vb + r32] = acc[r];
        LDS_WAIT(); __syncthreads();
        { const int t = tid >> 3, j = tid & 7; const size_t row = (size_t)(row0 + t);
          const u32x4 i0 = *(const u32x4*)(INTRA + row * 1024 + h * 128 + 16 * j), i1 = *(const u32x4*)(INTRA + row * 1024 + h * 128 + 16 * j + 8);
          const u32x4 g0 = *(const u32x4*)(U + row * UW + C_HG + h * 128 + 16 * j), g1 = *(const u32x4*)(U + row * UW + C_HG + h * 128 + 16 * j + 8);
          const unsigned iw[8] = {i0.x, i0.y, i0.z, i0.w, i1.x, i1.y, i1.z, i1.w}, gw[8] = {g0.x, g0.y, g0.z, g0.w, g1.x, g1.y, g1.z, g1.w};
          float o[16]; float ss = 0.f;
#pragma unroll
          for (int i = 0; i < 4; ++i) { const f32x4 x = *(const LAS f32x4*)(OL + t * 132 + 16 * j + 4 * i);
              o[4 * i] = x[0] + bflo(iw[2 * i]); o[4 * i + 1] = x[1] + bfhi(iw[2 * i]); o[4 * i + 2] = x[2] + bflo(iw[2 * i + 1]); o[4 * i + 3] = x[3] + bfhi(iw[2 * i + 1]); }
#pragma unroll
          for (int i = 0; i < 16; ++i) ss += o[i] * o[i];
          ss += __shfl_xor(ss, 1); ss += __shfl_xor(ss, 2); ss += __shfl_xor(ss, 4);
          const float rstd = __builtin_amdgcn_rsqf(ss * (1.f / 128) + EPS);
          unsigned ow[8];
#pragma unroll
          for (int i = 0; i < 8; ++i) { const float ga = bflo(gw[i]), gb = bfhi(gw[i]);
              const float ya = o[2 * i] * rstd * gout[16 * j + 2 * i] * ga * __builtin_amdgcn_rcpf(1.f + fexp(-ga)), yb = o[2 * i + 1] * rstd * gout[16 * j + 2 * i + 1] * gb * __builtin_amdgcn_rcpf(1.f + fexp(-gb));
              ow[i] = pk2(ya, yb); }
          bf16* op = MIX + row * D + 512 + h * 128 + 16 * j;
          *(u32x4*)op = (u32x4){ow[0], ow[1], ow[2], ow[3]}; *(u32x4*)(op + 8) = (u32x4){ow[4], ow[5], ow[6], ow[7]}; }
        __syncthreads();
    }
}

__device__ __forceinline__ void p_router(Frame& F, int l) {
    const float* x = F.out; const float* gain = F.in[24] + (size_t)l * D; const float* wgr = F.in[25] + (size_t)l * D * 8; const float* bgr = F.in[26] + l * 8;
    const float* wer = F.in[27] + (size_t)l * D * 64; const float* ber = F.in[28] + l * 64;
    float* rstdo = (float*)(F.ws + WS_SMALL + SM_RSTDFFN); int* eidx = (int*)(F.ws + WS_SMALL + SM_EIDX); float* gate = (float*)(F.ws + WS_SMALL + SM_GATE); int* slot = (int*)(F.ws + WS_SMALL + SM_SLOT);
    unsigned* cnt = F.ctl + CW_CNT + l * 64;
    LAS float* LG = (LAS float*)(F.lds + F.wave * (16 * 84 * 4));
    const int lane = F.lane, c = lane & 15, q = lane >> 4;
    const int gw = F.bid + F.G * F.wave, NGW = F.G * NWAVES;
    for (int tile = gw; tile < NTOK / 16; tile += NGW) {
        f32x4 acc[5];
#pragma unroll
        for (int i = 0; i < 5; ++i) acc[i] = (f32x4){0.f, 0.f, 0.f, 0.f};
        float ss = 0.f;
        const float* xp = x + (size_t)(tile * 16 + c) * D + 4 * q;
        for (int i = 0; i < 128; ++i) {
            const f32x4 xv = *(const f32x4*)(xp + 16 * i), gv = *(const f32x4*)(gain + 16 * i + 4 * q);
            ss += (xv[0] * xv[0] + xv[1] * xv[1]) + (xv[2] * xv[2] + xv[3] * xv[3]);
#pragma unroll
            for (int j = 0; j < 4; ++j) { const float a = xv[j] * gv[j]; const int k = 16 * i + 4 * q + j;
                const float b0 = c < 8 ? wgr[(size_t)k * 8 + c] : 0.f;
                acc[0] = __builtin_amdgcn_mfma_f32_16x16x4f32(a, b0, acc[0], 0, 0, 0);
#pragma unroll
                for (int ct = 1; ct < 5; ++ct) { const float bb = wer[(size_t)k * 64 + 16 * (ct - 1) + c]; acc[ct] = __builtin_amdgcn_mfma_f32_16x16x4f32(a, bb, acc[ct], 0, 0, 0); } }
        }
        ss += __shfl_xor(ss, 16); ss += __shfl_xor(ss, 32);
        const float rstd = __builtin_amdgcn_rsqf(ss * (1.f / D) + EPS);
#pragma unroll
        for (int ct = 0; ct < 5; ++ct)
#pragma unroll
            for (int r = 0; r < 4; ++r) LG[(4 * q + r) * 84 + 16 * ct + c] = acc[ct][r];
        LDS_WAIT();
        if (lane < 16) {
            const int tok = tile * 16 + lane; const LAS float* lg = LG + lane * 84;
            float gl[8]; float gm = -3.4e38f; int grp = 0;
#pragma unroll
            for (int j = 0; j < 8; ++j) { gl[j] = lg[j] * rstd + bgr[j]; if (gl[j] > gm) { gm = gl[j]; grp = j; } }
            float gs = 0.f;
#pragma unroll
            for (int j = 0; j < 8; ++j) gs += expf(gl[j] - gm);
            const float pgrp = 1.f / gs;
            float el[8]; float e1 = -3.4e38f; int i1 = 0;
#pragma unroll
            for (int j = 0; j < 8; ++j) { el[j] = lg[16 + grp * 8 + j] * rstd + ber[grp * 8 + j]; if (el[j] > e1) { e1 = el[j]; i1 = j; } }
            float e2 = -3.4e38f; int i2 = 0;
#pragma unroll
            for (int j = 0; j < 8; ++j) if (j != i1 && el[j] > e2) { e2 = el[j]; i2 = j; }
            const float r21 = expf(e2 - e1), g1 = pgrp / (1.f + r21), g2 = pgrp * r21 / (1.f + r21);
            const int ex1 = grp * 8 + i1, ex2_ = grp * 8 + i2;
            const int s1 = (int)atomicAdd(cnt + ex1, 1u), s2 = (int)atomicAdd(cnt + ex2_, 1u);
            rstdo[tok] = rstd; eidx[2 * tok] = ex1; eidx[2 * tok + 1] = ex2_; gate[2 * tok] = g1; gate[2 * tok + 1] = g2; slot[2 * tok] = s1; slot[2 * tok + 1] = s2;
        }
        LDS_WAIT();
    }
}
__device__ __forceinline__ void p_gather(Frame& F, int l) {
    const float* x = F.out; const float* gain = F.in[24] + (size_t)l * D;
    const float* rstdi = (const float*)(F.ws + WS_SMALL + SM_RSTDFFN); const int* eidx = (const int*)(F.ws + WS_SMALL + SM_EIDX); const int* slot = (const int*)(F.ws + WS_SMALL + SM_SLOT);
    int* arow = (int*)(F.ws + WS_SMALL + SM_AROW); bf16* XG = (bf16*)(F.ws + WS_OVL + OV_XG);
    const unsigned* cnt = F.ctl + CW_CNT + l * 64;
    LAS int* OFF = (LAS int*)F.lds;
    LAS int* CN = OFF + 128;
    if (F.tid < 64) CN[F.tid] = (int)__hip_atomic_load(cnt + F.tid, __ATOMIC_RELAXED, __HIP_MEMORY_SCOPE_AGENT);
    LDS_WAIT(); __syncthreads();
    if (F.tid == 0) { int o = 0; for (int e = 0; e < 64; ++e) { OFF[e] = o; o += (CN[e] + 255) & ~255; } OFF[64] = o; }
    LDS_WAIT(); __syncthreads();
    if (F.bid == 0 && F.tid == 0) { int n = 0;
        for (int e = 0; e < 64; ++e) for (int r = OFF[e]; r < OFF[e + 1]; r += 256) { F.ctl[CW_MTE + l * 256 + n] = (unsigned)e; F.ctl[CW_MTR + l * 256 + n] = (unsigned)r; ++n; }
        F.ctl[CW_NMT + l] = (unsigned)n; }
    const int lane = F.lane, gw = F.bid * NWAVES + F.wave, NGW = F.G * NWAVES;
    for (int tok = gw; tok < NTOK; tok += NGW) {
        const float rstd = rstdi[tok]; const int r0 = OFF[eidx[2 * tok]] + slot[2 * tok], r1 = OFF[eidx[2 * tok + 1]] + slot[2 * tok + 1];
        if (lane == 0) { arow[2 * tok] = r0; arow[2 * tok + 1] = r1; }
#pragma unroll
        for (int j = 0; j < 8; ++j) { const f32x4 v = *((const f32x4*)(x + (size_t)tok * D) + lane + 64 * j), gv = *((const f32x4*)gain + lane + 64 * j);
            u32x2 o; o.x = pk2(v[0] * rstd * gv[0], v[1] * rstd * gv[1]); o.y = pk2(v[2] * rstd * gv[2], v[3] * rstd * gv[3]);
            *((u32x2*)(XG + (size_t)r0 * D) + lane + 64 * j) = o; *((u32x2*)(XG + (size_t)r1 * D) + lane + 64 * j) = o; }
    }
    for (int e = F.bid; e < 64; e += F.G)
        for (int r = OFF[e] + CN[e] + F.wave; r < OFF[e + 1]; r += NWAVES) {
#pragma unroll
            for (int j = 0; j < 4; ++j) *((u32x4*)(XG + (size_t)r * D) + lane + 64 * j) = (u32x4){0u, 0u, 0u, 0u}; }
    __syncthreads();
}

constexpr int PH_PER_LAYER = 14, PH_BASE = 3, N_PHASES = PH_BASE + DEPTH * PH_PER_LAYER;
__global__ void __launch_bounds__(NTHR, 2) mk_fwd(Args args) {
    extern __shared__ __attribute__((aligned(16))) unsigned char lds_raw[];
    Frame F; F.lds = (LAS unsigned char*)lds_raw; F.tid = threadIdx.x; F.lane = F.tid & 63; F.wave = __builtin_amdgcn_readfirstlane(F.tid >> 6);
    F.G = gridDim.x; F.bid = blockIdx.x; F.ws = args.ws; F.ctl = (unsigned*)(args.ws + WS_CTL); F.in = args.in; F.out = args.out;
    volatile LAS unsigned* MISC = (volatile LAS unsigned*)(F.lds + MISC_OFF);
    if (F.tid < 64) MISC[F.tid] = 0u;
    __syncthreads();
    XcdBarrier bar = xcd_barrier_post(F.ctl + CW_BAR, MISC + 8);
    const int lo = args.ph_lo, hi = args.ph_hi;
#ifndef MK_PHMASK
#define MK_PHMASK 0xFFFFFFFFu
#endif
#ifndef MK_STOP
#define MK_STOP 1000
#endif
#define IN(k) (lo <= (k) && (k) < hi && ((k) < MK_STOP || (k) >= N_PHASES))
#define EN(j) (((MK_PHMASK) >> (j)) & 1u)
#define SEAM(k) do { if (IN((k) + 1)) xcd_barrier(bar, P.tid == 0); } while (0)
#define LAUNDER(v) asm volatile("" : "+s"(v))
#define PHASE_FRAME() Frame P = F; int z_ = 0; LAUNDER(z_); asm volatile("v_mbcnt_lo_u32_b32 %0, -1, 0\n\tv_mbcnt_hi_u32_b32 %0, -1, %0" : "=v"(P.tid)); P.tid |= (F.wave << 6) + z_; P.lane = P.tid & 63; P.wave = __builtin_amdgcn_readfirstlane(P.tid >> 6); P.ws = F.ws + z_; P.ctl = F.ctl + z_; P.in = F.in + z_; P.out = F.out + z_; unsigned char* ws = P.ws; (void)ws
    if (EN(14) && IN(0)) {
        PHASE_FRAME();
        p_convert(P);
        const int gw = P.bid * NWAVES + P.wave, NGW = P.G * NWAVES;
        for (int r = gw; r < 2 * 1024; r += NGW) { const int l = r >> 10, row = r & 1023;
            norm_row(P.in[1] + (size_t)row * D, nullptr, (bf16*)(ws + WS_MEMN) + (size_t)r * D, P.in[18] + l * D, nullptr, nullptr, 0.f, 0.f, P.lane); }
        for (int r = gw; r < NTOK; r += NGW) norm_row(P.in[0] + (size_t)r * D, P.out + (size_t)r * D, (bf16*)(ws + WS_HN) + (size_t)r * D, P.in[4], nullptr, nullptr, 0.f, 0.f, P.lane);
        SEAM(0);
    }
    if (EN(15) && IN(1)) {
        PHASE_FRAME();
        for (int l = 0; l < DEPTH; ++l) {
            pg8::Gemm g{(const bf16*)(ws + WS_MEMN) + (size_t)l * 1024 * D, (const bf16*)(ws + WS_W + (size_t)l * WL_END + WL_WMKV), D, D};
            pg8::StaticOrder S; S.init(1024, 1024, D, D, P.G, P.bid);
            pg8::EpiBf16 E{(bf16*)(ws + WS_MKV) + (size_t)l * 1024 * 1024, 1024};
            pg8::gemm_phase(P.lds, P.tid, g, S, E);
        }
        SEAM(1);
    }
    if (EN(16) && IN(2)) { PHASE_FRAME(); p_mem_post(P); SEAM(2); }
    for (int l_ = 0; l_ < DEPTH; ++l_) {
        const int pb = PH_BASE + l_ * PH_PER_LAYER;
#define LAYER_FRAME() PHASE_FRAME(); int l = l_ + z_; unsigned char* wl = ws + WS_W + (size_t)l * WL_END; (void)wl; \
        bf16* U = (bf16*)(ws + WS_OVL + OV_U); bf16* MIX = (bf16*)(ws + WS_OVL + OV_MIX); bf16* HN = (bf16*)(ws + WS_HN); (void)U; (void)MIX; (void)HN
        if (EN(0) && IN(pb + 0)) {
            LAYER_FRAME();
            pg8::Gemm g{HN, (const bf16*)(wl + WL_WIN), D, D}; pg8::StaticOrder S; S.init(NTOK, UW, D, D, P.G, P.bid); pg8::EpiBf16 E{U, UW};
            pg8::gemm_phase(P.lds, P.tid, g, S, E);
            SEAM(pb + 0);
        }
        if (EN(1) && IN(pb + 1)) {
            LAYER_FRAME();
            { pg8::Gemm g{U + C_CQ, (const bf16*)(wl + WL_WUQ), UW, 512}; pg8::StaticOrder S; S.init(NTOK, 768, UW, 512, P.G, P.bid); pg8::EpiBf16 E{(bf16*)(ws + WS_OVL + OV_QM), 768};
              pg8::gemm_phase(P.lds, P.tid, g, S, E); }
            { pg8::Gemm g{U + C_CKV, (const bf16*)(wl + WL_WUKV), UW, 256}; pg8::StaticOrder S; S.init(NTOK, 1024, UW, 256, P.G, P.bid); pg8::EpiBf16 E{(bf16*)(ws + WS_OVL + OV_KVM), 1024};
              pg8::gemm_phase(P.lds, P.tid, g, S, E); }
            p_prep(P, l);
            p_hgrn1(P, l);
            SEAM(pb + 1);
        }
        if (EN(2) && IN(pb + 2)) {
            LAYER_FRAME();
            p_mla_post(P, l);
            p_hgrn2(P);
            { LAS float* bias = (LAS float*)(P.lds + AT_ML + 4096);
              for (int i = P.tid; i < 1024; i += NTHR) { const int h = i >> 7, d = i & 127; int bk = d;
                  if (d >= 16) { bk = 16 + (int)(logf((float)d / 16.f) / 2.0794415416798357f * 16.f); if (bk > 31) bk = 31; }
                  bias[i] = P.in[2][bk * 8 + h] * LOG2E; }
              LDS_WAIT(); __syncthreads();
              const bf16* SVT = (const bf16*)(ws + WS_OVL + OV_SVT);
              for (int un = P.bid; un < 1024; un += P.G) { const int b = un >> 8, h = (un >> 5) & 7, qb = un & 31;
                  AttnU a; a.Q = U + (size_t)(b * SEQ + qb * 128) * UW + C_SQ + h * 64; a.qs = UW; a.K = U + (size_t)(b * SEQ) * UW + C_SK + (h >> 2) * 64; a.ks = UW;
                  a.VT = SVT + (size_t)((b * 2 + (h >> 2)) * 64) * SEQ; a.vts = SEQ; a.O = MIX + (size_t)(b * SEQ + qb * 128) * D + h * 64; a.os = D; a.q0 = qb * 128;
                  a.t_lo = qb > 0 ? 2 * qb - 2 : 0; a.t_hi = 2 * qb + 2; a.dbg = nullptr;
                  attn_unit<64, 64, 2, false>(P.lds, P.tid, a, 0.125f * LOG2E, nullptr, P.in[8][l * 8 + h] * LOG2E, bias + h * 128); }
            }
            SEAM(pb + 2);
        }
        if (EN(3) && IN(pb + 3)) {
            LAYER_FRAME();
            { const bf16* QF = (const bf16*)(ws + WS_OVL + OV_QF); const bf16* KF = (const bf16*)(ws + WS_OVL + OV_KF); const bf16* VT = (const bf16*)(ws + WS_OVL + OV_VT);
              for (int it = P.bid; it < 512; it += P.G) { const int pair = it & 255, bh = pair >> 4, j = pair & 15, qb = it < 256 ? 31 - j : j;
                  AttnU a; a.Q = QF + ((size_t)bh * SEQ + qb * 128) * 192; a.qs = 192; a.K = KF + (size_t)bh * SEQ * 192; a.ks = 192; a.VT = VT + (size_t)bh * 128 * SEQ; a.vts = SEQ;
                  a.O = MIX + ((size_t)(bh >> 2) * SEQ + qb * 128) * D + 1536 + (bh & 3) * 128; a.os = D; a.q0 = qb * 128; a.t_lo = 0; a.t_hi = 2 * qb + 2; a.dbg = nullptr;
                  attn_unit<192, 128, 1, false>(P.lds, P.tid, a, 0.07216878364870322f * LOG2E, nullptr, 0.f, nullptr); } }
#ifndef MK_NOH3
            p_hgrn3(P, l);
#endif
            SEAM(pb + 3);
        }
        if (EN(4) && IN(pb + 4)) {
            LAYER_FRAME();
            pg8::Gemm g{MIX, (const bf16*)(wl + WL_WOUT), D, D}; pg8::StaticOrder S; S.init(NTOK, D, D, D, P.G, P.bid); pg8::EpiResid E{P.out, D};
            pg8::gemm_phase(P.lds, P.tid, g, S, E);
            SEAM(pb + 4);
        }
        if (EN(5) && IN(pb + 5)) {
            LAYER_FRAME();
            const int gw = P.bid * NWAVES + P.wave, NGW = P.G * NWAVES;
            for (int r = gw; r < NTOK; r += NGW) norm_row(P.out + (size_t)r * D, nullptr, HN + (size_t)r * D, P.in[17] + (size_t)l * D, nullptr, nullptr, 0.f, 0.f, P.lane);
            SEAM(pb + 5);
        }
        if (EN(6) && IN(pb + 6)) {
            LAYER_FRAME();
            pg8::Gemm g{HN, (const bf16*)(wl + WL_WMQ), D, D}; pg8::StaticOrder S; S.init(NTOK, 512, D, D, P.G, P.bid); pg8::EpiBf16 E{(bf16*)(ws + WS_MQ), 512};
            pg8::gemm_phase(P.lds, P.tid, g, S, E);
            SEAM(pb + 6);
        }
        if (EN(7) && IN(pb + 7)) {
            LAYER_FRAME();
            const bf16* MQ = (const bf16*)(ws + WS_MQ); bf16* MO = (bf16*)(ws + WS_MO);
            const bf16* MK = (const bf16*)(ws + WS_MK) + (size_t)l * 1024 * 512; const bf16* MVT = (const bf16*)(ws + WS_MVT) + (size_t)l * 1024 * 512;
            for (int un = P.bid; un < 512; un += P.G) { const int b = un >> 7, h = (un >> 5) & 3, qb = un & 31;
                AttnU a; a.Q = MQ + (size_t)(b * SEQ + qb * 128) * 512 + h * 128; a.qs = 512; a.K = MK + (size_t)((b * 4 + h) * 256) * 128; a.ks = 128; a.VT = MVT + (size_t)((b * 4 + h) * 128) * 256; a.vts = 256;
                a.O = MO + (size_t)(b * SEQ + qb * 128) * 512 + h * 128; a.os = 512; a.q0 = 0; a.t_lo = 0; a.t_hi = 4; a.dbg = nullptr;
                attn_unit<128, 128, 0, true>(P.lds, P.tid, a, 0.08838834764831845f * LOG2E, P.in[21] + l * 128, 0.f, nullptr); }
            SEAM(pb + 7);
        }
        if (EN(8) && IN(pb + 8)) {
            LAYER_FRAME();
            pg8::Gemm g{(const bf16*)(ws + WS_MO), (const bf16*)(wl + WL_WMO), 512, 512}; pg8::StaticOrder S; S.init(NTOK, D, 512, 512, P.G, P.bid); pg8::EpiResid E{P.out, D};
            pg8::gemm_phase(P.lds, P.tid, g, S, E);
            SEAM(pb + 8);
        }
        if (EN(9) && IN(pb + 9)) { LAYER_FRAME(); p_router(P, l); SEAM(pb + 9); }
        if (EN(10) && IN(pb + 10)) { LAYER_FRAME(); p_gather(P, l); SEAM(pb + 10); }
        if (EN(11) && IN(pb + 11)) {
            LAYER_FRAME();
            const int nmt = (int)__builtin_amdgcn_readfirstlane(__hip_atomic_load(P.ctl + CW_NMT + l, __ATOMIC_RELAXED, __HIP_MEMORY_SCOPE_AGENT));
            pg8::Gemm g{(const bf16*)(ws + WS_OVL + OV_XG), (const bf16*)(wl + WL_WGU), D, D};
            pg8::GroupedOrder S{P.ctl + CW_MTE + l * 256, P.ctl + CW_MTR + l * 256, nmt, 4, P.G, P.bid, D, D, (size_t)1024 * D * 2};
            pg8::EpiGateUp E{(bf16*)(ws + WS_OVL + OV_HMID), 512};
            pg8::gemm_phase(P.lds, P.tid, g, S, E);
            SEAM(pb + 11);
        }
        if (EN(12) && IN(pb + 12)) {
            LAYER_FRAME();
            const int nmt = (int)__builtin_amdgcn_readfirstlane(__hip_atomic_load(P.ctl + CW_NMT + l, __ATOMIC_RELAXED, __HIP_MEMORY_SCOPE_AGENT));
            pg8::Gemm g{(const bf16*)(ws + WS_OVL + OV_HMID), (const bf16*)(wl + WL_WD), 512, 512};
            pg8::GroupedOrder S{P.ctl + CW_MTE + l * 256, P.ctl + CW_MTR + l * 256, nmt, 8, P.G, P.bid, 512, 512, (size_t)D * 512 * 2};
            pg8::EpiBf16 E{(bf16*)(ws + WS_OVL + OV_YB), D};
            pg8::gemm_phase(P.lds, P.tid, g, S, E);
            SEAM(pb + 12);
        }
        if (EN(13) && IN(pb + 13)) {
            LAYER_FRAME();
            const int gw = P.bid * NWAVES + P.wave, NGW = P.G * NWAVES;
            const int* arow = (const int*)(ws + WS_SMALL + SM_AROW); const float* gate = (const float*)(ws + WS_SMALL + SM_GATE); const bf16* YB = (const bf16*)(ws + WS_OVL + OV_YB);
            for (int r = gw; r < NTOK; r += NGW)
                norm_row(P.out + (size_t)r * D, P.out + (size_t)r * D, l + 1 < DEPTH ? HN + (size_t)r * D : nullptr, P.in[4] + (size_t)(l + 1 < DEPTH ? l + 1 : 0) * D,
                         YB + (size_t)arow[2 * r] * D, YB + (size_t)arow[2 * r + 1] * D, gate[2 * r], gate[2 * r + 1], P.lane);
            SEAM(pb + 13);
        }
    }
#if MK_SANITIZE
    if (IN(N_PHASES)) { PHASE_FRAME(); for (size_t i = (size_t)P.bid * NTHR + P.tid; i < (size_t)NTOK * D; i += (size_t)P.G * NTHR) { float v = P.out[i]; if (!(fabsf(v) < 1e30f)) P.out[i] = 0.f; } }
#endif
#undef IN
#undef SEAM
}

#if MK_DEBUG
constexpr int CW_DBG = 12288;
__device__ __forceinline__ unsigned dh(unsigned x) { x ^= x >> 16; x *= 0x7feb352du; x ^= x >> 15; x *= 0x846ca68bu; x ^= x >> 16; return x; }
__device__ __forceinline__ void dbg_put(unsigned* ctl, int k, float got, float want, float scale) {
    float e = fabsf(got - want) / (fabsf(want) + scale); if (!(e == e) || !(fabsf(got) < 1e30f)) e = 1e9f;
    atomicMax(ctl + CW_DBG + k, __builtin_bit_cast(unsigned, e));
}
__device__ double dcos2pi(double fr, bool want_sin) {
    double th = (fr - 0.5) * 6.283185307179586;
    double t2 = th * th, c = 1.0, s = th, tc = 1.0, ts = th;
    for (int n = 1; n < 16; ++n) { tc *= -t2 / ((2.0 * n - 1.0) * (2.0 * n)); c += tc; ts *= -t2 / ((2.0 * n) * (2.0 * n + 1.0)); s += ts; }
    return want_sin ? -s : -c;
}
__global__ void __launch_bounds__(256) dbg_kernel(Args args, int stage, int l) {
    const float* const* in = args.in; unsigned char* ws = args.ws; unsigned* ctl = (unsigned*)(ws + WS_CTL);
    const int gid = blockIdx.x * 256 + threadIdx.x, NT = gridDim.x * 256;
    unsigned char* wl = ws + WS_W + (size_t)l * WL_END;
    const bf16* HN = (const bf16*)(ws + WS_HN); const bf16* U = (const bf16*)(ws + WS_OVL + OV_U); const bf16* MIX = (const bf16*)(ws + WS_OVL + OV_MIX);
    const bf16* WIN = (const bf16*)(wl + WL_WIN);
    if (stage == 1) {
        for (int s = gid; s < 8192; s += NT) { const unsigned h = dh(s * 2654435761u + 12345u);
            { const int n = h % INW, k = (h >> 13) % D; dbg_put(ctl, 1, bf2f(WIN[(size_t)n * D + k]), in[5][((size_t)l * D + k) * INW + n], 1e-3f); }
            { const int n = INW + h % (UW - INW), k = (h >> 13) % D; dbg_put(ctl, 1, bf2f(WIN[(size_t)n * D + k]), 0.f, 1e-3f); }
            { const int n = h % 768, k = (h >> 13) % 512; dbg_put(ctl, 1, bf2f(((const bf16*)(wl + WL_WUQ))[(size_t)n * 512 + k]), in[12][((size_t)l * 512 + k) * 768 + n] * in[10][l * 512 + k], 1e-3f); }
            { const int n = h % 1024, k = (h >> 13) % 256; dbg_put(ctl, 1, bf2f(((const bf16*)(wl + WL_WUKV))[(size_t)n * 256 + k]), in[13][((size_t)l * 256 + k) * 1024 + n] * in[11][l * 256 + k], 1e-3f); }
            { const int n = h % D, k = (h >> 13) % D; dbg_put(ctl, 1, bf2f(((const bf16*)(wl + WL_WOUT))[(size_t)n * D + k]), in[16][((size_t)l * D + k) * D + n], 1e-3f); }
            { const int n = h % 512, k = (h >> 13) % D; dbg_put(ctl, 1, bf2f(((const bf16*)(wl + WL_WMQ))[(size_t)n * D + k]), in[19][((size_t)l * D + k) * 512 + n], 1e-3f); }
            { const int n = h % 1024, k = (h >> 13) % D; dbg_put(ctl, 1, bf2f(((const bf16*)(wl + WL_WMKV))[(size_t)n * D + k]), in[20][((size_t)l * D + k) * 1024 + n], 1e-3f); }
            { const int n = h % D, k = (h >> 13) % 512; dbg_put(ctl, 1, bf2f(((const bf16*)(wl + WL_WMO))[(size_t)n * 512 + k]), in[23][((size_t)l * 512 + k) * D + n], 1e-3f); }
            { const int e = (h >> 3) % NEXP, n = h % DEXP, k = (h >> 13) % D; const bf16* gu = (const bf16*)(wl + WL_WGU) + (size_t)e * 1024 * D;
              dbg_put(ctl, 1, bf2f(gu[(size_t)((n >> 7) * 256 + (n & 127)) * D + k]), in[29][(((size_t)l * NEXP + e) * D + k) * DEXP + n], 1e-3f);
              dbg_put(ctl, 1, bf2f(gu[(size_t)((n >> 7) * 256 + 128 + (n & 127)) * D + k]), in[30][(((size_t)l * NEXP + e) * D + k) * DEXP + n], 1e-3f); }
            { const int e = (h >> 3) % NEXP, n = h % D, k = (h >> 13) % DEXP; dbg_put(ctl, 1, bf2f(((const bf16*)(wl + WL_WD))[((size_t)e * D + n) * DEXP + k]), in[31][(((size_t)l * NEXP + e) * DEXP + k) * D + n], 1e-3f); }
        }
    }
    if (stage == 2) {
        for (int s = gid; s < 512; s += NT) { const unsigned h = dh(s * 977u + 7u); const int r = (s < 4) ? (s & 1 ? NTOK - 1 : 0) : h % NTOK, c = (h >> 15) % D;
            const float* xr = in[0] + (size_t)r * D; float ss = 0.f; for (int k = 0; k < D; ++k) ss += xr[k] * xr[k];
            dbg_put(ctl, 2, bf2f(HN[(size_t)r * D + c]), xr[c] * rsqrtf(ss / D + EPS) * in[4][c], 1e-2f); dbg_put(ctl, 2, args.out[(size_t)r * D + c], xr[c], 1e-6f); }
    }
    if (stage == 3) {
        for (int s = gid; s < 4096; s += NT) { const unsigned h = dh(s * 31u + 99u); const int r = (s < 64) ? ((s & 1) ? NTOK - 1 - (s >> 1) : (s >> 1)) : h % NTOK; const int n = (s & 2) ? (UW - 1 - (h >> 14) % 512) : (h >> 14) % UW;
            float a = 0.f; for (int k = 0; k < D; ++k) a += bf2f(HN[(size_t)r * D + k]) * bf2f(WIN[(size_t)n * D + k]);
            dbg_put(ctl, 3, bf2f(U[(size_t)r * UW + n]), a, 0.05f); }
    }
    if (stage == 4) {
        const bf16* QM = (const bf16*)(ws + WS_OVL + OV_QM); const bf16* KVM = (const bf16*)(ws + WS_OVL + OV_KVM);
        for (int s = gid; s < 4096; s += NT) { const unsigned h = dh(s * 131u + 5u); const int r = h % NTOK;
            { const int n = (h >> 14) % 768; float a = 0.f; for (int k = 0; k < 512; ++k) a += bf2f(U[(size_t)r * UW + C_CQ + k]) * bf2f(((const bf16*)(wl + WL_WUQ))[(size_t)n * 512 + k]); dbg_put(ctl, 4, bf2f(QM[(size_t)r * 768 + n]), a, 0.05f); }
            { const int n = (h >> 14) % 1024; float a = 0.f; for (int k = 0; k < 256; ++k) a += bf2f(U[(size_t)r * UW + C_CKV + k]) * bf2f(((const bf16*)(wl + WL_WUKV))[(size_t)n * 256 + k]); dbg_put(ctl, 5, bf2f(KVM[(size_t)r * 1024 + n]), a, 0.05f); } }
    }
    if (stage == 6) {
        const float* rcq = (const float*)(ws + WS_SMALL + SM_RSTDCQ); const float* rckv = (const float*)(ws + WS_SMALL + SM_RSTDCKV); const bf16* SVT = (const bf16*)(ws + WS_OVL + OV_SVT);
        for (int s = gid; s < 256; s += NT) { const unsigned h = dh(s * 733u + 3u); const int r = h % NTOK, hd = (h >> 14) % 10, d = (h >> 20) % 64;
            const int c0 = hd < 8 ? C_SQ + hd * 64 : C_SK + (hd - 8) * 64; float ss = 0.f, mine = 0.f;
            for (int j = 0; j < 64; ++j) { float a = 0.f; for (int k = 0; k < D; ++k) a += bf2f(HN[(size_t)r * D + k]) * bf2f(WIN[(size_t)(c0 + j) * D + k]); a = bf2f(f2bf(a)); ss += a * a; if (j == d) mine = a; }
            dbg_put(ctl, 6, bf2f(U[(size_t)r * UW + c0 + d]), mine * rsqrtf(ss / 64 + EPS) * (hd < 8 ? in[6][l * 64 + d] : in[7][l * 64 + d]), 0.03f);
            float s1 = 0.f; for (int k = 0; k < 512; ++k) { const float a = bf2f(U[(size_t)r * UW + C_CQ + k]); s1 += a * a; } dbg_put(ctl, 6, rcq[r], rsqrtf(s1 / 512 + EPS), 1e-3f);
            float s2 = 0.f; for (int k = 0; k < 256; ++k) { const float a = bf2f(U[(size_t)r * UW + C_CKV + k]); s2 += a * a; } dbg_put(ctl, 6, rckv[r], rsqrtf(s2 / 256 + EPS), 1e-3f);
            const int b = r >> 12, sp = r & 4095, cc = (h >> 9) % 128; dbg_put(ctl, 7, bf2f(SVT[((size_t)b * 128 + cc) * SEQ + sp]), bf2f(U[(size_t)r * UW + C_SV + cc]), 1e-6f); }
    }
    if (stage == 8) {
        const bf16* QM = (const bf16*)(ws + WS_OVL + OV_QM); const bf16* KVM = (const bf16*)(ws + WS_OVL + OV_KVM); const bf16* QF = (const bf16*)(ws + WS_OVL + OV_QF); const bf16* KF = (const bf16*)(ws + WS_OVL + OV_KF); const bf16* VT = (const bf16*)(ws + WS_OVL + OV_VT);
        const float* rcq = (const float*)(ws + WS_SMALL + SM_RSTDCQ); const float* rckv = (const float*)(ws + WS_SMALL + SM_RSTDCKV);
        for (int s = gid; s < 2048; s += NT) { const unsigned h = dh(s * 3571u + 11u); const int r = h % NTOK, hh = (h >> 14) & 3, d = (h >> 16) % 192, b = r >> 12, sp = r & 4095;
            for (int which = 0; which < 2; ++which) {
                float ss = 0.f;
                for (int j = 0; j < 192; ++j) { float a; if (which == 0) a = bf2f(QM[(size_t)r * 768 + hh * 192 + j]) * rcq[r]; else a = j < 128 ? bf2f(KVM[(size_t)r * 1024 + hh * 256 + j]) * rckv[r] : bf2f(U[(size_t)r * UW + C_KR + j - 128]); ss += a * a; }
                const float rstd = rsqrtf(ss / 192 + EPS); const float* gg = which == 0 ? in[14] + l * 192 : in[15] + l * 192;
                auto el = [&](int j) { float a; if (which == 0) a = bf2f(QM[(size_t)r * 768 + hh * 192 + j]) * rcq[r]; else a = j < 128 ? bf2f(KVM[(size_t)r * 1024 + hh * 256 + j]) * rckv[r] : bf2f(U[(size_t)r * UW + C_KR + j - 128]); return a * rstd * gg[j]; };
                float want;
                if (d < 128) want = el(d);
                else { const int i = (d - 128) & 31; const float inv = powf(10000.f, -(float)i / 32.f); const float ang = (float)sp * inv; const double rev = (double)ang * 0.15915494309189535, fr = rev - floor(rev);
                    const float c = (float)dcos2pi(fr, false), sn = (float)dcos2pi(fr, true); const float x1 = el(128 + i), x2 = el(160 + i); want = d < 160 ? x1 * c - x2 * sn : x1 * sn + x2 * c; }
                dbg_put(ctl, 8 + which, bf2f((which == 0 ? QF : KF)[((size_t)(b * 4 + hh) * SEQ + sp) * 192 + d]), want, 0.03f);
            }
            const int dv = d & 127; dbg_put(ctl, 10, bf2f(VT[((size_t)(b * 4 + hh) * 128 + dv) * SEQ + sp]), bf2f(KVM[(size_t)r * 1024 + hh * 256 + 128 + dv]) * rckv[r], 0.01f); }
    }
    if (stage == 11) {
        for (int s = gid; s < 1024; s += NT) { const unsigned h = dh((s >> 4) * 7919u + 13u); const int cls = (s >> 4) % 3; const int r = cls == 0 ? (h % 4) * 4096 + (h >> 5) % 32 : cls == 1 ? (h % 4) * 4096 + 32 + (h >> 5) % 96 : h % NTOK, hq = (h >> 14) & 7, d = ((h >> 17) & 48) + (s & 15), b = r >> 12, t = r & 4095, hkv = hq >> 2;
            const float sink = in[8][l * 8 + hq]; float mx = sink;
            const int s_lo = t - 127 > 0 ? t - 127 : 0;
            for (int pass = 0; pass < 2; ++pass) { float den = 0.f, num = 0.f;
                for (int sk = s_lo; sk <= t; ++sk) { float sc = 0.f; for (int j = 0; j < 64; ++j) sc += bf2f(U[(size_t)r * UW + C_SQ + hq * 64 + j]) * bf2f(U[(size_t)(b * SEQ + sk) * UW + C_SK + hkv * 64 + j]);
                    const int dist = t - sk; int bk = dist; if (dist >= 16) { bk = 16 + (int)(logf((float)dist / 16.f) / 2.0794415416798357f * 16.f); if (bk > 31) bk = 31; }
                    sc = sc * 0.125f + in[2][bk * 8 + hq];
                    if (pass == 0) mx = fmaxf(mx, sc); else { const float p = expf(sc - mx); den += p; num += p * bf2f(U[(size_t)(b * SEQ + sk) * UW + C_SV + hkv * 64 + d]); } }
                if (pass == 1) { den += expf(sink - mx); dbg_put(ctl, 11, bf2f(MIX[(size_t)r * D + hq * 64 + d]), num / den, 0.2f); dbg_put(ctl, t < 32 ? 16 : t < 128 ? 17 : 18, bf2f(MIX[(size_t)r * D + hq * 64 + d]), num / den, 0.2f); } } }
    }
    if (stage == 12) {
        const bf16* QF = (const bf16*)(ws + WS_OVL + OV_QF); const bf16* KF = (const bf16*)(ws + WS_OVL + OV_KF); const bf16* VT = (const bf16*)(ws + WS_OVL + OV_VT);
        for (int s = gid; s < 512; s += NT) { const unsigned h = dh((s >> 3) * 104729u + 17u); const int cls = (s >> 3) % 4; const int r = cls == 0 ? (h % 4) * 4096 + (h >> 5) % 128 : cls == 1 ? (h % 4) * 4096 + 3968 + (h >> 5) % 128 : cls == 2 ? (h % 4) * 4096 + 128 + (h >> 5) % 128 : h % NTOK, hh = (h >> 14) & 3, d = ((h >> 16) & 120) + (s & 7), b = r >> 12, t = r & 4095;
            const bf16* q = QF + ((size_t)(b * 4 + hh) * SEQ + t) * 192; float mx = -1e30f;
            for (int pass = 0; pass < 2; ++pass) { float den = 0.f, num = 0.f;
                for (int sk = 0; sk <= t; ++sk) { const bf16* kk = KF + ((size_t)(b * 4 + hh) * SEQ + sk) * 192; float sc = 0.f; for (int j = 0; j < 192; ++j) sc += bf2f(q[j]) * bf2f(kk[j]); sc *= 0.07216878364870322f;
                    if (pass == 0) mx = fmaxf(mx, sc); else { const float p = expf(sc - mx); den += p; num += p * bf2f(VT[((size_t)(b * 4 + hh) * 128 + d) * SEQ + sk]); } }
                if (pass == 1) { dbg_put(ctl, 12, bf2f(MIX[(size_t)r * D + 1536 + hh * 128 + d]), num / den, 0.1f); dbg_put(ctl, t < 128 ? 19 : t >= 3968 ? 20 : t < 256 ? 21 : 22, bf2f(MIX[(size_t)r * D + 1536 + hh * 128 + d]), num / den, 0.1f); } } }
    }
    if (stage == 24) {
        const bf16* QF = (const bf16*)(ws + WS_OVL + OV_QF); const bf16* KF = (const bf16*)(ws + WS_OVL + OV_KF); const bf16* VT = (const bf16*)(ws + WS_OVL + OV_VT); const float* DB = (const float*)(ws + WS_MQ);
        const float sc2 = 0.07216878364870322f * LOG2E;
        for (int tl = gid; tl < 512; tl += NT) { const int wid = tl >> 6, lane = tl & 63, r32 = lane & 31, hi = lane >> 5, g = wid & 3, kh = wid >> 2, q = 32 * g + r32;
            float sv[32]; float mx = -1e30f;
            for (int kk = 0; kk < 32; ++kk) { const int key = 32 * kh + kk; float a = 0.f; for (int j = 0; j < 192; ++j) a += bf2f(QF[(size_t)q * 192 + j]) * bf2f(KF[(size_t)key * 192 + j]); a *= sc2; mx = fmaxf(mx, a);
                for (int r = 0; r < 16; ++r) if (crow(r, hi) == kk) dbg_put(ctl, 24, DB[(wid * 64 + lane) * 16 + r], a, 0.5f); }
            float l = 0.f; for (int kk = 0; kk < 32; ++kk) { const int key = 32 * kh + kk; float a = 0.f; for (int j = 0; j < 192; ++j) a += bf2f(QF[(size_t)q * 192 + j]) * bf2f(KF[(size_t)key * 192 + j]); a *= sc2; l += exp2f(a - mx); }
            dbg_put(ctl, 25, DB[8192 + (wid * 64 + lane) * 2], mx, 0.5f); dbg_put(ctl, 26, DB[8192 + (wid * 64 + lane) * 2 + 1], l, 0.5f);
            for (int i = 0; i < 4; ++i) for (int r = 0; r < 16; r += 5) { const int qq = 32 * g + crow(r, hi), d = 32 * i + r32; float m2 = -1e30f, acc = 0.f;
                for (int pass = 0; pass < 2; ++pass) for (int kk = 0; kk < 32; ++kk) { const int key = 32 * kh + kk; float a = 0.f; for (int j = 0; j < 192; ++j) a += bf2f(QF[(size_t)qq * 192 + j]) * bf2f(KF[(size_t)key * 192 + j]); a *= sc2;
                    if (pass == 0) m2 = fmaxf(m2, a); else acc += exp2f(a - m2) * bf2f(VT[(size_t)d * SEQ + key]); }
                dbg_put(ctl, 27, DB[16384 + ((wid * 64 + lane) * 4 + i) * 16 + r], acc, 0.3f); }
            (void)sv; }
    }
    if (stage == 13) {
        __shared__ float so[128]; const float* lb = (const float*)(ws + WS_SMALL + SM_LB) + l * 1024;
        for (int smp = blockIdx.x; smp < 64; smp += gridDim.x) { const unsigned h = dh(smp * 15485863u + 19u); const int r = smp < 4 ? ((smp & 1) ? 4096 + 63 + (smp >> 1) * 64 : (smp >> 1) * 70) : h % NTOK, hh = (h >> 14) & 7, b = r >> 12, t = r & 4095; const int v = threadIdx.x & 127;
            float o = 0.f;
            if (threadIdx.x < 128) {
                for (int k = 0; k < 128; ++k) { const float lbv = lb[hh * 128 + k]; const float q = bf2f(U[(size_t)r * UW + C_HQ + hh * 128 + k]); float dcy = 1.f, acc = 0.f;
                    for (int sk = t; sk >= 0 && dcy > 1e-12f; --sk) { const size_t rr = (size_t)(b * SEQ + sk) * UW; const float f = bf2f(U[rr + C_HF + hh * 128 + k]); const float sig = 1.f / (1.f + expf(-f)); const float fv = lbv + (1.f - lbv) * sig;
                        acc += dcy * (1.f - lbv) * (1.f - sig) * bf2f(U[rr + C_HI + hh * 128 + v]); dcy *= fv; }
                    o += q * acc; }
                so[v] = o; }
            __syncthreads();
            if (threadIdx.x < 128) { float ss = 0.f; for (int j = 0; j < 128; ++j) ss += so[j] * so[j]; const float gv = bf2f(U[(size_t)r * UW + C_HG + hh * 128 + v]);
                dbg_put(ctl, 13, bf2f(MIX[(size_t)r * D + 512 + hh * 128 + v]), o * rsqrtf(ss / 128 + EPS) * in[9][l * 128 + v] * gv / (1.f + expf(-gv)), 0.3f); }
            __syncthreads(); }
    }
    if (stage == 14) {
        for (int s = gid; s < 2048; s += NT) { const unsigned h = dh(s * 193u + 23u); const int r = h % NTOK, c = (h >> 14) % D; float a = in[0][(size_t)r * D + c];
            for (int k = 0; k < D; ++k) a += bf2f(MIX[(size_t)r * D + k]) * bf2f(((const bf16*)(wl + WL_WOUT))[(size_t)c * D + k]);
            dbg_put(ctl, 14, args.out[(size_t)r * D + c], a, 1.0f); }
    }
}
__global__ void dbg_final(Args args, float tol, int first, int count) {
    const unsigned* ctl = (const unsigned*)(args.ws + WS_CTL); float c = 1.f; int mask = 0;
    if (count > 0) { for (int k = 0; k < count; ++k) { const float e = __builtin_bit_cast(float, ctl[CW_DBG + first + k]); if (e > tol) mask |= 1 << k; } }
    else { for (int k = 0; k < -count; ++k) { const float e = __builtin_bit_cast(float, ctl[CW_DBG + first + k]);
        const int lv = e <= 0.05f ? 0 : e <= 0.2f ? 1 : e <= 1.f ? 2 : e <= 5.f ? 3 : e <= 100.f ? 4 : e <= 1e6f ? 5 : e < 1e9f ? 6 : 7; mask |= lv << (3 * k); } }
    if (mask) c = 2.f + 0.5f * mask;
    for (size_t i = (size_t)blockIdx.x * 256 + threadIdx.x; i < (size_t)NTOK * D; i += (size_t)gridDim.x * 256) args.out[i] = c * args.in[0][i];
}
#endif

extern "C" void kernel_launch(void* const* d_in, const int* in_sizes, int n_in, void* d_out, int out_size, void* d_ws, size_t ws_size, hipStream_t stream) {
    static int grid = 0;
    if (grid == 0) {
        if (n_in != 32 || out_size != NTOK * D || ws_size < WS_END) { fprintf(stderr, "kernel_launch: unexpected shapes (n_in %d out %d ws %zu need %zu)\n", n_in, out_size, ws_size, (size_t)WS_END); grid = -1; return; }
        int dev = 0, cus = 0, per_cu = 0;
        if (hipGetDevice(&dev) != hipSuccess || hipDeviceGetAttribute(&cus, hipDeviceAttributeMultiprocessorCount, dev) != hipSuccess) { grid = -1; return; }
        if (hipFuncSetAttribute((const void*)mk_fwd, hipFuncAttributeMaxDynamicSharedMemorySize, LDS_BYTES) != hipSuccess) { fprintf(stderr, "kernel_launch: hipFuncSetAttribute failed\n"); grid = -1; return; }
        if (hipOccupancyMaxActiveBlocksPerMultiprocessor(&per_cu, (const void*)mk_fwd, NTHR, LDS_BYTES) != hipSuccess || per_cu < 1) { fprintf(stderr, "kernel_launch: occupancy query says %d\n", per_cu); (void)hipGetLastError(); }
        grid = cus;
    }
    if (grid < 0) return;
    (void)hipMemsetAsync((char*)d_ws + WS_CTL, 0, CTL_BYTES, stream);
    Args a{};
    for (int i = 0; i < 32; ++i) a.in[i] = (const float*)d_in[i];
    a.out = (float*)d_out; a.ws = (unsigned char*)d_ws;
#if MK_ONE_LAUNCH
    a.ph_lo = 0; a.ph_hi = N_PHASES + MK_SANITIZE;
    hipLaunchKernelGGL(mk_fwd, dim3(grid), dim3(NTHR), LDS_BYTES, stream, a);
#else
    for (int p = 0; p < N_PHASES + MK_SANITIZE; ++p) { a.ph_lo = p; a.ph_hi = p + 1; hipLaunchKernelGGL(mk_fwd, dim3(grid), dim3(NTHR), LDS_BYTES, stream, a);
#if MK_DEBUG
        const int pb0 = PH_BASE;
        if (p == 0) { hipLaunchKernelGGL(dbg_kernel, dim3(64), dim3(256), 0, stream, a, 1, 0); hipLaunchKernelGGL(dbg_kernel, dim3(64), dim3(256), 0, stream, a, 2, 0); }
        if (p == pb0 + 0) hipLaunchKernelGGL(dbg_kernel, dim3(64), dim3(256), 0, stream, a, 3, 0);
        if (p == pb0 + 1) { hipLaunchKernelGGL(dbg_kernel, dim3(64), dim3(256), 0, stream, a, 4, 0); hipLaunchKernelGGL(dbg_kernel, dim3(64), dim3(256), 0, stream, a, 6, 0); }
        if (p == pb0 + 2) { hipLaunchKernelGGL(dbg_kernel, dim3(64), dim3(256), 0, stream, a, 8, 0); hipLaunchKernelGGL(dbg_kernel, dim3(64), dim3(256), 0, stream, a, 11, 0); }
        if (p == pb0 + 3) { hipLaunchKernelGGL(dbg_kernel, dim3(64), dim3(256), 0, stream, a, 12, 0); hipLaunchKernelGGL(dbg_kernel, dim3(64), dim3(256), 0, stream, a, 13, 0); }
        if (p == pb0 + 4) { hipLaunchKernelGGL(dbg_kernel, dim3(64), dim3(256), 0, stream, a, 14, 0); hipLaunchKernelGGL(dbg_final, dim3(1024), dim3(256), 0, stream, a, 0.05f, 11, 4); break; }
#endif
    }
#endif
}
```

```cpp
#include <hip/hip_runtime.h>
#include <cstdio>
#include <cstdint>

#ifndef MK_DEBUG
#define MK_DEBUG 0
#endif
#ifndef MK_SANITIZE
#define MK_SANITIZE 0
#endif
#ifndef MK_ONE_LAUNCH
#define MK_ONE_LAUNCH 1
#endif

#define GAS __attribute__((address_space(1)))
#define LAS __attribute__((address_space(3)))
typedef unsigned short bf16;
typedef short bf16x8 __attribute__((ext_vector_type(8)));
typedef float f32x4 __attribute__((ext_vector_type(4)));
typedef float f32x16 __attribute__((ext_vector_type(16)));
typedef unsigned u32x4 __attribute__((ext_vector_type(4)));
typedef unsigned u32x2 __attribute__((ext_vector_type(2)));

constexpr int D = 2048, NB = 4, SEQ = 4096, NTOK = NB * SEQ, DEPTH = 2;
constexpr int UW = 5888;
constexpr int C_SQ = 0, C_SK = 512, C_SV = 640, C_HQ = 768, C_HF = 1792, C_HI = 2816, C_HG = 3840, C_CQ = 4864, C_CKV = 5376, C_KR = 5632, INW = 5696;
constexpr int NEXP = 64, DEXP = 512, MAXROWS = 49152;
constexpr float EPS = 1e-6f;
constexpr float LOG2E = 1.4426950408889634f;

constexpr size_t MiB = 1u << 20;
constexpr size_t WS_CTL = 0, CTL_BYTES = 1 * MiB;
constexpr size_t SZ_WIN = (size_t)UW * D * 2, SZ_WUQ = 768 * 512 * 2, SZ_WUKV = 1024 * 256 * 2, SZ_WOUT = (size_t)D * D * 2, SZ_WMQ = 512 * (size_t)D * 2,
                 SZ_WMKV = 1024 * (size_t)D * 2, SZ_WMO = (size_t)D * 512 * 2, SZ_WGU = (size_t)NEXP * 1024 * D * 2, SZ_WD = (size_t)NEXP * D * 512 * 2;
constexpr size_t WL_WIN = 0, WL_WUQ = WL_WIN + SZ_WIN, WL_WUKV = WL_WUQ + SZ_WUQ, WL_WOUT = WL_WUKV + SZ_WUKV, WL_WMQ = WL_WOUT + SZ_WOUT, WL_WMKV = WL_WMQ + SZ_WMQ,
                 WL_WMO = WL_WMKV + SZ_WMKV, WL_WGU = WL_WMO + SZ_WMO, WL_WD = WL_WGU + SZ_WGU, WL_END = WL_WD + SZ_WD;
constexpr size_t WS_W = 1 * MiB;
constexpr size_t WS_PERS = WS_W + 2 * WL_END;
constexpr size_t WS_HN = WS_PERS;
constexpr size_t WS_MEMN = WS_HN + (size_t)NTOK * D * 2;
constexpr size_t WS_MKV = WS_MEMN + 2 * 1024 * (size_t)D * 2;
constexpr size_t WS_MK = WS_MKV + 2 * 1024 * 1024 * 2;
constexpr size_t WS_MVT = WS_MK + 2 * 1024 * 512 * 2;
constexpr size_t WS_ROPE = WS_MVT + 2 * 1024 * 512 * 2;
constexpr size_t WS_MQ = WS_ROPE + 4096 * 32 * 8;
constexpr size_t WS_MO = WS_MQ + (size_t)NTOK * 512 * 2;
constexpr size_t WS_SMALL = WS_MO + (size_t)NTOK * 512 * 2;
constexpr size_t SM_RSTDCQ = 0, SM_RSTDCKV = SM_RSTDCQ + NTOK * 4, SM_RSTDFFN = SM_RSTDCKV + NTOK * 4, SM_EIDX = SM_RSTDFFN + NTOK * 4, SM_GATE = SM_EIDX + NTOK * 8,
                 SM_SLOT = SM_GATE + NTOK * 8, SM_AROW = SM_SLOT + NTOK * 8, SM_LB = SM_AROW + NTOK * 8, SM_END = SM_LB + 2 * 1024 * 4;
constexpr size_t WS_OVL = (WS_SMALL + SM_END + 4095) / 4096 * 4096;
constexpr size_t OV_U = 0;
constexpr size_t OV_QM = OV_U + (size_t)NTOK * UW * 2;
constexpr size_t OV_KVM = OV_QM + (size_t)NTOK * 768 * 2;
constexpr size_t OV_QF = OV_KVM + (size_t)NTOK * 1024 * 2;
constexpr size_t OV_KF = OV_QF + (size_t)NTOK * 768 * 2;
constexpr size_t OV_VT = OV_KF + (size_t)NTOK * 768 * 2;
constexpr size_t OV_SVT = OV_VT + (size_t)NTOK * 512 * 2;
constexpr size_t OV_QT = OV_SVT + (size_t)NTOK * 128 * 2;
constexpr size_t OV_INTRA = OV_QT + (size_t)NTOK * 1024 * 2;
constexpr size_t OV_UT = OV_INTRA + (size_t)NTOK * 1024 * 2;
constexpr size_t OV_DEC = OV_UT + (size_t)2048 * 128 * 128 * 2;
constexpr size_t OV_MIX = OV_DEC + 2048 * 128 * 4;
constexpr size_t OV_MIXEND = OV_MIX + (size_t)NTOK * D * 2;
constexpr size_t OV_XG = 0;
constexpr size_t OV_HMID = OV_XG + (size_t)MAXROWS * D * 2;
constexpr size_t OV_YB = OV_HMID + (size_t)MAXROWS * 512 * 2;
constexpr size_t OV_MOEEND = OV_YB + (size_t)MAXROWS * D * 2;
constexpr size_t WS_END = WS_OVL + (OV_MIXEND > OV_MOEEND ? OV_MIXEND : OV_MOEEND);
static_assert(WS_END <= (size_t)2048 * MiB, "workspace map must fit 2 GiB");
constexpr int CW_BAR = 4096;
constexpr int CW_CNT = 8192;
constexpr int CW_NMT = 8192 + 128;
constexpr int CW_MTE = 8192 + 256;
constexpr int CW_MTR = 8192 + 768;

constexpr int LDS_WORK = 131072;
constexpr int MISC_OFF = LDS_WORK;
constexpr int LDS_BYTES = 147456;
constexpr int NWAVES = 8, NTHR = 512;

#define LDS_WAIT() asm volatile("s_waitcnt lgkmcnt(0)" ::: "memory")
#define VM_WAIT() asm volatile("s_waitcnt vmcnt(0)" ::: "memory")
#define SBAR() __builtin_amdgcn_sched_barrier(0)
__device__ __forceinline__ unsigned f2bf(float f) { unsigned u = __builtin_bit_cast(unsigned, f); return (u + 0x7fffu + ((u >> 16) & 1u)) >> 16; }
__device__ __forceinline__ unsigned pk2(float lo, float hi) { return f2bf(lo) | (f2bf(hi) << 16); }
__device__ __forceinline__ float bf2f(unsigned b) { return __builtin_bit_cast(float, b << 16); }
__device__ __forceinline__ float bflo(unsigned w) { return __builtin_bit_cast(float, w << 16); }
__device__ __forceinline__ float bfhi(unsigned w) { return __builtin_bit_cast(float, w & 0xffff0000u); }
__device__ __forceinline__ unsigned cvtpk(float lo, float hi) { unsigned r; asm volatile("v_cvt_pk_bf16_f32 %0, %1, %2" : "=v"(r) : "v"(lo), "v"(hi)); return r; }
__device__ __forceinline__ float ex2(float x) { return __builtin_amdgcn_exp2f(x); }
__device__ __forceinline__ float fexp(float x) { return __builtin_amdgcn_exp2f(x * LOG2E); }
__device__ __forceinline__ float flog(float x) { return __builtin_amdgcn_logf(x) * 0.6931471805599453f; }
__device__ __forceinline__ float wave_sum(float v) {
#pragma unroll
    for (int o = 1; o < 64; o <<= 1) v += __shfl_xor(v, o);
    return v;
}
__device__ __forceinline__ int crow(int r, int hi) { return (r & 3) + 8 * (r >> 2) + 4 * hi; }
#define PK4(P, B_, OUT) do { unsigned a0_ = cvtpk(P[B_ + 0], P[B_ + 1]), a1_ = cvtpk(P[B_ + 2], P[B_ + 3]), b0_ = cvtpk(P[B_ + 4], P[B_ + 5]), b1_ = cvtpk(P[B_ + 6], P[B_ + 7]); \
        auto r0_ = __builtin_amdgcn_permlane32_swap(a0_, b0_, false, false); auto r1_ = __builtin_amdgcn_permlane32_swap(a1_, b1_, false, false); \
        u32x4 w_ = {r0_[0], r1_[0], r0_[1], r1_[1]}; OUT = __builtin_bit_cast(bf16x8, w_); } while (0)
__device__ __forceinline__ float swap_max(float v) { return fmaxf(v, __shfl_xor(v, 32)); }
__device__ __forceinline__ float swap_sum(float v) { return v + __shfl_xor(v, 32); }

#define XB_TMO      128
#define XB_XCNT(j)  (256  + 64 * (j))
#define XB_XSUB(j)  (1280 + 64 * (j))
#define XB_XGEN(j)  (2304 + 64 * (j))
#define XB_TOP      3328
#define XB_TOPGEN   3392
#define XCD_BAR_WORDS 3456
#define XB_SPIN_CAP (1u << 22)
__device__ __forceinline__ unsigned xb_ld(unsigned* p)              { return __hip_atomic_load(p, __ATOMIC_RELAXED, __HIP_MEMORY_SCOPE_AGENT); }
__device__ __forceinline__ unsigned xb_add(unsigned* p, unsigned v) { return __hip_atomic_fetch_add(p, v, __ATOMIC_RELAXED, __HIP_MEMORY_SCOPE_AGENT); }
__device__ __forceinline__ unsigned xb_xcc_id() { return (unsigned)__builtin_amdgcn_s_getreg((3 << 11) | 20) & 0xFu; }
#define XB_SPIN(cond, bar) do { unsigned _sp = 0; while (cond) { __builtin_amdgcn_s_sleep(1); \
    if ((++_sp & 255u) == 0u) { if (xb_ld(&(bar)[XB_TMO])) break; if (_sp > XB_SPIN_CAP) { atomicAdd(&(bar)[XB_TMO], 1u); break; } } } } while (0)
struct XcdBarrier { unsigned* bar; unsigned x; volatile LAS unsigned* st; };
__device__ __forceinline__ XcdBarrier xcd_barrier_post(unsigned* bar, volatile LAS unsigned* st) {
    XcdBarrier b; b.bar = bar; b.x = xb_xcc_id(); b.st = st;
    if (threadIdx.x == 0) (void)xb_add(&bar[XB_XCNT(b.x)], 1u);
    return b;
}
__device__ __forceinline__ void xcd_barrier_complete(unsigned* bar, unsigned x, unsigned& nloc, unsigned& nx) {
    const unsigned G = gridDim.x * gridDim.y * gridDim.z;
    unsigned sum, cnt, mine, sp = 0u;
    for (;;) {
        sum = 0u; cnt = 0u; mine = 0u;
#pragma unroll
        for (unsigned j = 0; j < 16; ++j) { const unsigned c = xb_ld(&bar[XB_XCNT(j)]); sum += c; cnt += (c > 0u) ? 1u : 0u; mine = (j == x) ? c : mine; }
        if (sum == G) break;
        __builtin_amdgcn_s_sleep(1);
        if ((++sp & 255u) == 0u) { if (xb_ld(&bar[XB_TMO])) break; if (sp > XB_SPIN_CAP) { atomicAdd(&bar[XB_TMO], 1u); break; } }
    }
    nloc = mine > 0u ? mine : 1u; nx = cnt > 0u ? cnt : 1u;
}
__device__ __forceinline__ void xcd_barrier(const XcdBarrier& b, const bool leader) {
    asm volatile("s_waitcnt vmcnt(0)" ::: "memory");
    __syncthreads();
    if (leader) {
        unsigned* bar = b.bar;
        __builtin_amdgcn_s_waitcnt(0);
        unsigned nloc = b.st[0], nx = b.st[1];
        if (nloc == 0u) { xcd_barrier_complete(bar, b.x, nloc, nx); b.st[0] = nloc; b.st[1] = nx; }
        const unsigned old = xb_add(&bar[XB_XSUB(b.x)], 1u);
        const unsigned gen = old / nloc;
        if (old + 1u == (gen + 1u) * nloc) {
            __builtin_amdgcn_fence(__ATOMIC_RELEASE, "agent");
            asm volatile("s_waitcnt vmcnt(0)" ::: "memory");
            const unsigned og = xb_add(&bar[XB_TOP], 1u);
            const unsigned tg = og / nx;
            if (og + 1u == (tg + 1u) * nx) xb_add(&bar[XB_TOPGEN], 1u);
            else XB_SPIN(xb_ld(&bar[XB_TOPGEN]) == tg, bar);
            __builtin_amdgcn_fence(__ATOMIC_ACQUIRE, "agent");
            xb_add(&bar[XB_XGEN(b.x)], 1u);
            asm volatile("s_waitcnt vmcnt(0)" ::: "memory");
        } else {
            XB_SPIN(xb_ld(&bar[XB_XGEN(b.x)]) == gen, bar);
            __builtin_amdgcn_fence(__ATOMIC_ACQUIRE, "agent");
            asm volatile("s_waitcnt vmcnt(0)" ::: "memory");
        }
    }
    __syncthreads();
}

namespace pg8 {
constexpr int BM = 256, BK = 64, HALF = 128, HTB = HALF * BK * 2, STAGE_BYTES = 8 * HTB, NXCD = 8, WGM = 8;
__host__ __device__ __forceinline__ int lds_byte(int r, int c) { const int st = (r >> 4) * 2 + (c >> 5), rr = r & 15, cc = c & 31, ob = rr * 64 + cc * 2; return st * 1024 + (ob ^ (((ob >> 9) & 1) << 5)); }
__host__ __device__ __forceinline__ void stage_rc(int b, int& R, int& C) { const int st = b / 1024, sb = b % 1024, swz = sb ^ (((sb >> 9) & 1) << 5); R = (st >> 1) * 16 + swz / 64; C = (st & 1) * 32 + (swz % 64) / 2; }
__host__ __device__ __forceinline__ int perm32(int rho) { const int n = rho >> 4, i = rho & 15; return 8 * (i >> 2) + 4 * n + (i & 3); }

struct Unit { int pm, pn; size_t aoff, boff; };
struct Gemm { const bf16* A; const bf16* Bt; int lda, K; };

struct StaticOrder {
    int nM, nN, nwg, G, c, lda, K;
    __device__ void init(int M, int N, int lda_, int K_, int G_, int c_) { nM = M / BM; nN = N / BM; nwg = nM * nN; G = G_; c = c_; lda = lda_; K = K_; }
    __device__ bool next(int i, Unit& u) const {
        const long L = (long)i * G + c; if (L >= nwg) return false;
        int wgid = (int)L; { const int q = nwg / NXCD, r = nwg % NXCD, xcd = wgid % NXCD, off = wgid / NXCD; wgid = (xcd < r ? xcd * (q + 1) : r * (q + 1) + (xcd - r) * q) + off; }
        const int nig = WGM * nN, gid = wgid / nig, fm = gid * WGM, gsz = (nM - fm) < WGM ? (nM - fm) : WGM;
        u.pm = fm + ((wgid % nig) % gsz); u.pn = (wgid % nig) / gsz;
        u.aoff = (size_t)u.pm * BM * lda * 2; u.boff = (size_t)u.pn * BM * K * 2; return true;
    }
};
struct GroupedOrder {
    const unsigned* mte; const unsigned* mtr; int nmt, nN, G, c, lda, K; size_t bstride;
    __device__ bool next(int i, Unit& u) const {
        const long L = (long)i * G + c; if (L >= (long)nmt * nN) return false;
        const int mt = (int)(L / nN); u.pn = (int)(L % nN);
        const unsigned e = __builtin_amdgcn_readfirstlane(mte[mt]), r0 = __builtin_amdgcn_readfirstlane(mtr[mt]);
        u.pm = (int)(r0 >> 8); u.aoff = (size_t)r0 * lda * 2; u.boff = (size_t)e * bstride + (size_t)u.pn * BM * K * 2; return true;
    }
};

struct EpiBf16 {
    static constexpr bool PERM = true;
    bf16* O; int ldc;
    __device__ __forceinline__ void operator()(const f32x4 (&acc)[2][2][4][2], const Unit& u, int wr, int wc, int fr, int fq) const {
        const int row0 = u.pm * BM + wr * 64 + fr, col0 = u.pn * BM + wc * 32 + 8 * fq;
#pragma unroll
        for (int ai = 0; ai < 2; ++ai)
#pragma unroll
            for (int m = 0; m < 4; ++m) { bf16* rowp = O + (size_t)(row0 + ai * HALF + m * 16) * ldc + col0;
#pragma unroll
                for (int bj = 0; bj < 2; ++bj) { const f32x4 v0 = acc[ai][bj][m][0], v1 = acc[ai][bj][m][1];
                    u32x4 w; w.x = cvtpk(v0[0], v0[1]); w.y = cvtpk(v0[2], v0[3]); w.z = cvtpk(v1[0], v1[1]); w.w = cvtpk(v1[2], v1[3]);
                    *(u32x4*)(rowp + bj * HALF) = w; } }
    }
};
struct EpiResid {
    static constexpr bool PERM = false;
    float* X; int ldc;
    __device__ __forceinline__ void operator()(const f32x4 (&acc)[2][2][4][2], const Unit& u, int wr, int wc, int fr, int fq) const {
        const int row0 = u.pm * BM + wr * 64 + fr, col0 = u.pn * BM + wc * 32 + 4 * fq;
#pragma unroll
        for (int ai = 0; ai < 2; ++ai)
#pragma unroll
            for (int m = 0; m < 4; ++m) { float* rowp = X + (size_t)(row0 + ai * HALF + m * 16) * ldc + col0;
                f32x4 b[2][2];
#pragma unroll
                for (int bj = 0; bj < 2; ++bj)
#pragma unroll
                    for (int n = 0; n < 2; ++n) b[bj][n] = *(const f32x4*)(rowp + bj * HALF + n * 16);
#pragma unroll
                for (int bj = 0; bj < 2; ++bj)
#pragma unroll
                    for (int n = 0; n < 2; ++n) *(f32x4*)(rowp + bj * HALF + n * 16) = b[bj][n] + acc[ai][bj][m][n];
                asm volatile("" ::: "memory"); }
    }
};
struct EpiGateUp {
    static constexpr bool PERM = true;
    bf16* H; int ldc;
    __device__ __forceinline__ void operator()(const f32x4 (&acc)[2][2][4][2], const Unit& u, int wr, int wc, int fr, int fq) const {
        const int row0 = u.pm * BM + wr * 64 + fr, col0 = u.pn * HALF + wc * 32 + 8 * fq;
#pragma unroll
        for (int ai = 0; ai < 2; ++ai)
#pragma unroll
            for (int m = 0; m < 4; ++m) { bf16* rowp = H + (size_t)(row0 + ai * HALF + m * 16) * ldc + col0;
                float h[8];
#pragma unroll
                for (int n = 0; n < 2; ++n)
#pragma unroll
                    for (int j = 0; j < 4; ++j) { const float g = acc[ai][0][m][n][j], up = acc[ai][1][m][n][j]; h[n * 4 + j] = g * __builtin_amdgcn_rcpf(1.f + fexp(-g)) * up; }
                u32x4 w; w.x = cvtpk(h[0], h[1]); w.y = cvtpk(h[2], h[3]); w.z = cvtpk(h[4], h[5]); w.w = cvtpk(h[6], h[7]);
                *(u32x4*)rowp = w; }
    }
};

template <class Epi, class Sched>
__device__ __forceinline__ void gemm_phase(LAS unsigned char* lds, const int tid, const Gemm g, const Sched& S, const Epi& E) {
    const int wid = __builtin_amdgcn_readfirstlane(tid >> 6), lane = tid & 63, wr = wid >> 2, wc = wid & 3, fr = lane & 15, fq = lane >> 4;
    const int K = g.K, nt = K / BK, lda = g.lda;
    unsigned voffA[2], voffB[2];
#pragma unroll
    for (int i = 0; i < 2; ++i) { int R, C; stage_rc(tid * 16 + i * 8192, R, C); const int Rb = Epi::PERM ? ((R & ~31) + perm32(R & 31)) : R;
        voffA[i] = (unsigned)(R * lda + C) * 2u; voffB[i] = (unsigned)(Rb * K + C) * 2u; }
    const size_t kstep = (size_t)(BK * 2);
    const size_t hstepA = (size_t)HALF * lda * 2, hstepB = (size_t)HALF * K * 2;
    const unsigned ldsw = (unsigned)wid * 1024u;
    const int aoff = lds_byte(wr * 64 + fr, fq * 8), boff = lds_byte(wc * 32 + fr, fq * 8);
#define PG8_SA(b, h) (((b) * 2 + (h)) * HTB)
#define PG8_SB(b, h) ((4 + (b) * 2 + (h)) * HTB)
#define PG8_STAGE(bufoff, gbase, voff) do { _Pragma("unroll") for (int _i = 0; _i < 2; ++_i) \
        __builtin_amdgcn_global_load_lds((const unsigned*)((const char*)(gbase) + (voff)[_i]), (LAS unsigned*)(lds + (bufoff) + ldsw + _i * 8192), 16, 0, 0); } while (0)
#define PG8_LDA(dst, b, h) do { _Pragma("unroll") for (int m = 0; m < 4; ++m) _Pragma("unroll") for (int k = 0; k < 2; ++k) dst[m][k] = *(const LAS bf16x8*)(lds + PG8_SA(b, h) + aoff + m * 2048 + k * 1024); } while (0)
#define PG8_LDB(dst, b, h) do { _Pragma("unroll") for (int n = 0; n < 2; ++n) _Pragma("unroll") for (int k = 0; k < 2; ++k) dst[n][k] = *(const LAS bf16x8*)(lds + PG8_SB(b, h) + boff + n * 2048 + k * 1024); } while (0)
#define PG8_MMA(ai, bj, At, Bt) do { __builtin_amdgcn_s_setprio(1); _Pragma("unroll") for (int m = 0; m < 4; ++m) _Pragma("unroll") for (int n = 0; n < 2; ++n) _Pragma("unroll") for (int k = 0; k < 2; ++k) \
        acc[ai][bj][m][n] = __builtin_amdgcn_mfma_f32_16x16x32_bf16(Bt[n][k], At[m][k], acc[ai][bj][m][n], 0, 0, 0); __builtin_amdgcn_s_setprio(0); } while (0)
#define PG8_WAIT_V(n) asm volatile("s_waitcnt vmcnt(" #n ")" ::: "memory")
#define PG8_WAIT_L(n) asm volatile("s_waitcnt lgkmcnt(" #n ")" ::: "memory")
#define PG8_BAR __builtin_amdgcn_s_barrier()
#define PG8_SCHED __builtin_amdgcn_sched_barrier(0)
    Unit cur, nxt; int ui = 0;
    if (!S.next(0, cur)) return;
    f32x4 acc[2][2][4][2];
#pragma unroll
    for (int a = 0; a < 2; ++a)
#pragma unroll
        for (int b = 0; b < 2; ++b)
#pragma unroll
            for (int m = 0; m < 4; ++m)
#pragma unroll
                for (int n = 0; n < 2; ++n) acc[a][b][m][n] = (f32x4){0.f, 0.f, 0.f, 0.f};
    bf16x8 At[4][2], B0[2][2], B1[2][2];
    const char* cA = (const char*)g.A + cur.aoff; const char* cB = (const char*)g.Bt + cur.boff;
    PG8_STAGE(PG8_SB(0, 0), cB, voffB); PG8_STAGE(PG8_SB(0, 1), cB + hstepB, voffB); PG8_STAGE(PG8_SA(0, 0), cA, voffA); PG8_STAGE(PG8_SA(0, 1), cA + hstepA, voffA);
    if (wr == 1) PG8_BAR;
    PG8_WAIT_V(2); PG8_BAR;
    PG8_STAGE(PG8_SB(1, 0), cB + kstep, voffB); PG8_STAGE(PG8_SA(1, 0), cA + kstep, voffA); PG8_STAGE(PG8_SB(1, 1), cB + hstepB + kstep, voffB);
    PG8_WAIT_V(6); PG8_BAR;
    for (;;) {
        const bool has_next = S.next(ui + 1, nxt);
        const char* nA = has_next ? (const char*)g.A + nxt.aoff : cA; const char* nB = has_next ? (const char*)g.Bt + nxt.boff : cB;
#pragma nounroll
        for (int t = 0; t < nt; t += 2) {
            const bool last = (t == nt - 2);
            const char* a1 = cA + (size_t)(t + 1) * kstep;
            const char* a2 = last ? nA : cA + (size_t)(t + 2) * kstep; const char* b2 = last ? nB : cB + (size_t)(t + 2) * kstep;
            const char* a3 = a2 + kstep; const char* b3 = b2 + kstep;
            PG8_LDB(B0, 0, 0); PG8_LDB(B1, 0, 1); PG8_SCHED; PG8_LDA(At, 0, 0); PG8_STAGE(PG8_SA(1, 1), a1 + hstepA, voffA);
            PG8_WAIT_V(8); PG8_WAIT_L(0); PG8_BAR; PG8_MMA(0, 0, At, B0); PG8_MMA(0, 1, At, B1); PG8_BAR; PG8_SCHED;
            PG8_LDA(At, 0, 1); PG8_STAGE(PG8_SB(0, 0), b2, voffB); PG8_STAGE(PG8_SB(0, 1), b2 + hstepB, voffB); PG8_STAGE(PG8_SA(0, 0), a2, voffA);
            PG8_WAIT_V(8); PG8_WAIT_L(0); PG8_BAR; PG8_MMA(1, 0, At, B0); PG8_MMA(1, 1, At, B1); PG8_BAR; PG8_SCHED;
            PG8_LDB(B0, 1, 0); PG8_LDB(B1, 1, 1); PG8_SCHED; PG8_LDA(At, 1, 0); PG8_STAGE(PG8_SA(0, 1), a2 + hstepA, voffA);
            PG8_WAIT_V(8); PG8_WAIT_L(0); PG8_BAR; PG8_MMA(0, 0, At, B0); PG8_MMA(0, 1, At, B1); PG8_BAR; PG8_SCHED;
            PG8_LDA(At, 1, 1); PG8_STAGE(PG8_SB(1, 0), b3, voffB); PG8_STAGE(PG8_SB(1, 1), b3 + hstepB, voffB); PG8_STAGE(PG8_SA(1, 0), a3, voffA);
            PG8_WAIT_V(8); PG8_WAIT_L(0); PG8_BAR; PG8_MMA(1, 0, At, B0); PG8_MMA(1, 1, At, B1); PG8_BAR; PG8_SCHED;
        }
        if (wr == 0) PG8_BAR;
        E(acc, cur, wr, wc, fr, fq);
        if (!has_next) break;
#pragma unroll
        for (int a = 0; a < 2; ++a)
#pragma unroll
            for (int b = 0; b < 2; ++b)
#pragma unroll
                for (int m = 0; m < 4; ++m)
#pragma unroll
                    for (int n = 0; n < 2; ++n) acc[a][b][m][n] = (f32x4){0.f, 0.f, 0.f, 0.f};
        cur = nxt; cA = nA; cB = nB; ++ui;
        if (wr == 1) PG8_BAR;
    }
    PG8_WAIT_V(0);
    PG8_BAR;
#undef PG8_SA
#undef PG8_SB
#undef PG8_STAGE
#undef PG8_LDA
#undef PG8_LDB
#undef PG8_MMA
#undef PG8_WAIT_V
#undef PG8_WAIT_L
#undef PG8_BAR
#undef PG8_SCHED
}
}

struct Args { const float* in[32]; float* out; unsigned char* ws; int ph_lo, ph_hi; };
struct Frame {
    LAS unsigned char* lds; int tid, lane, wave, G, bid;
    unsigned char* ws; unsigned* ctl; const float* const* in; float* out;
};

__device__ __forceinline__ void transpose_item(const float* W, int K, int N, bf16* WT, int dst_row0, const float* gain, LAS float* scr, int kb, int nb, int lane) {
    const int k0 = 64 * kb, n0 = 32 * nb;
#pragma unroll 8
    for (int i = 0; i < 32; ++i) { const int kk = 2 * i + (lane >> 5); float v = W[(size_t)(k0 + kk) * N + n0 + (lane & 31)]; if (gain) v *= gain[k0 + kk]; scr[kk * 33 + (lane & 31)] = v; }
    LDS_WAIT(); asm volatile("" ::: "memory");
    const int c = lane & 7;
#pragma unroll
    for (int j = 0; j < 4; ++j) { const int n = (lane >> 3) + 8 * j; const LAS float* s = scr + (8 * c) * 33 + n;
        u32x4 o; o.x = pk2(s[0 * 33], s[1 * 33]); o.y = pk2(s[2 * 33], s[3 * 33]); o.z = pk2(s[4 * 33], s[5 * 33]); o.w = pk2(s[6 * 33], s[7 * 33]);
        *(u32x4*)(WT + (size_t)(dst_row0 + n) * K + k0 + 8 * c) = o; }
    LDS_WAIT(); asm volatile("" ::: "memory");
}
struct ConvMat { const float* W; bf16* WT; const float* gain; int K, N, kind; };
__device__ __forceinline__ void convert_matrix(Frame& F, const ConvMat& m, int& base, int gw, int NGW, LAS float* scr) {
    const int nnb = m.N / 32, nkb = m.K / 64, items = nnb * nkb;
    int first = (gw - base % NGW + NGW) % NGW;
    for (int it = first; it < items; it += NGW) {
        const int kb = it / nnb, nb = it % nnb, n0 = nb * 32;
        int r0 = n0; if (m.kind == 1) r0 = (n0 >> 7) * 256 + (n0 & 127); else if (m.kind == 2) r0 = (n0 >> 7) * 256 + 128 + (n0 & 127);
        transpose_item(m.W, m.K, m.N, m.WT, r0 - 0, m.gain, scr, kb, nb, F.lane);
        (void)n0;
    }
    base += items;
}
__device__ __forceinline__ void p_convert(Frame& F) {
    LAS float* scr = (LAS float*)(F.lds + F.wave * 16384);
    const int gw = F.bid * NWAVES + F.wave, NGW = F.G * NWAVES;
    int base = 0;
    for (int l = 0; l < DEPTH; ++l) {
        unsigned char* wl = F.ws + WS_W + (size_t)l * WL_END;
        { ConvMat m{F.in[5] + (size_t)l * D * INW, (bf16*)(wl + WL_WIN), nullptr, D, INW, 0}; convert_matrix(F, m, base, gw, NGW, scr); }
        { ConvMat m{F.in[12] + (size_t)l * 512 * 768, (bf16*)(wl + WL_WUQ), F.in[10] + l * 512, 512, 768, 0}; convert_matrix(F, m, base, gw, NGW, scr); }
        { ConvMat m{F.in[13] + (size_t)l * 256 * 1024, (bf16*)(wl + WL_WUKV), F.in[11] + l * 256, 256, 1024, 0}; convert_matrix(F, m, base, gw, NGW, scr); }
        { ConvMat m{F.in[16] + (size_t)l * D * D, (bf16*)(wl + WL_WOUT), nullptr, D, D, 0}; convert_matrix(F, m, base, gw, NGW, scr); }
        { ConvMat m{F.in[19] + (size_t)l * D * 512, (bf16*)(wl + WL_WMQ), nullptr, D, 512, 0}; convert_matrix(F, m, base, gw, NGW, scr); }
        { ConvMat m{F.in[20] + (size_t)l * D * 1024, (bf16*)(wl + WL_WMKV), nullptr, D, 1024, 0}; convert_matrix(F, m, base, gw, NGW, scr); }
        { ConvMat m{F.in[23] + (size_t)l * 512 * D, (bf16*)(wl + WL_WMO), nullptr, 512, D, 0}; convert_matrix(F, m, base, gw, NGW, scr); }
        for (int e = 0; e < NEXP; ++e) {
            bf16* gu = (bf16*)(wl + WL_WGU) + (size_t)e * 1024 * D;
            { ConvMat m{F.in[29] + ((size_t)l * NEXP + e) * D * DEXP, gu, nullptr, D, DEXP, 1}; convert_matrix(F, m, base, gw, NGW, scr); }
            { ConvMat m{F.in[30] + ((size_t)l * NEXP + e) * D * DEXP, gu, nullptr, D, DEXP, 2}; convert_matrix(F, m, base, gw, NGW, scr); }
            { ConvMat m{F.in[31] + ((size_t)l * NEXP + e) * DEXP * D, (bf16*)(wl + WL_WD) + (size_t)e * D * DEXP, nullptr, DEXP, D, 0}; convert_matrix(F, m, base, gw, NGW, scr); }
        }
        { u32x4* z = (u32x4*)((bf16*)(wl + WL_WIN) + (size_t)INW * D); const int n16 = (UW - INW) * D * 2 / 16;
          for (int i = F.bid * NTHR + F.tid; i < n16; i += F.G * NTHR) z[i] = (u32x4){0u, 0u, 0u, 0u}; }
    }
    for (int i = F.bid * NTHR + F.tid; i < 4096 * 32; i += F.G * NTHR) {
        const int pos = i >> 5, j = i & 31;
        const float inv = ex2(-(float)j * (13.287712379549449f / 32.0f));
        const float ang = (float)pos * inv;
        const double rev = (double)ang * 0.15915494309189535; const float fr = (float)(rev - floor(rev));
        float* rp = (float*)(F.ws + WS_ROPE) + 2 * i; rp[0] = __builtin_amdgcn_cosf(fr); rp[1] = __builtin_amdgcn_sinf(fr);
    }
    for (int i = F.bid * NTHR + F.tid; i < 1024; i += F.G * NTHR) {
        float* lb = (float*)(F.ws + WS_SMALL + SM_LB); const float a0 = F.in[3][i], a1 = F.in[3][1024 + i];
        const float mx = fmaxf(a0, a1), e0 = expf(a0 - mx), e1 = expf(a1 - mx), p0 = e0 / (e0 + e1), p1 = e1 / (e0 + e1);
        lb[i] = p0 - p0; lb[1024 + i] = (p0 + p1) - p0;
    }
}

__device__ __forceinline__ void norm_row(const float* xin, float* xout, bf16* hn, const float* gain, const bf16* y0, const bf16* y1, float g0, float g1, int lane) {
    f32x4 v[8]; float ss = 0.f;
#pragma unroll
    for (int j = 0; j < 8; ++j) { v[j] = *((const f32x4*)xin + lane + 64 * j);
        if (y0) { const u32x2 a = *((const u32x2*)y0 + lane + 64 * j), b = *((const u32x2*)y1 + lane + 64 * j);
            v[j][0] += g0 * bflo(a.x) + g1 * bflo(b.x); v[j][1] += g0 * bfhi(a.x) + g1 * bfhi(b.x); v[j][2] += g0 * bflo(a.y) + g1 * bflo(b.y); v[j][3] += g0 * bfhi(a.y) + g1 * bfhi(b.y); }
        ss += (v[j][0] * v[j][0] + v[j][1] * v[j][1]) + (v[j][2] * v[j][2] + v[j][3] * v[j][3]); }
    if (xout) {
#pragma unroll
        for (int j = 0; j < 8; ++j) *((f32x4*)xout + lane + 64 * j) = v[j]; }
    if (hn) {
        const float rstd = __builtin_amdgcn_rsqf(wave_sum(ss) * (1.f / D) + EPS);
#pragma unroll
        for (int j = 0; j < 8; ++j) { const f32x4 gv = *((const f32x4*)gain + lane + 64 * j);
            u32x2 o; o.x = pk2(v[j][0] * rstd * gv[0], v[j][1] * rstd * gv[1]); o.y = pk2(v[j][2] * rstd * gv[2], v[j][3] * rstd * gv[3]);
            *((u32x2*)hn + lane + 64 * j) = o; }
    }
}

struct AttnU { const bf16* Q; const bf16* K; const bf16* VT; bf16* O; int qs, ks, vts, os, q0, t_lo, t_hi; float* dbg; };
constexpr int AT_ML = 98304;
template <int DQK, int DV, int MODE, bool QNORM>
__device__ __forceinline__ void attn_unit(LAS unsigned char* lds, const int tid, const AttnU u, const float scl2, const float* qgain, const float sink2, const LAS float* biasT) {
    constexpr int KROW = DQK * 2, VROW = 128, KBUF = 64 * KROW, VBUF = DV * VROW, KOFF = 0, VOFF = 2 * KBUF;
    constexpr int KCH = DQK / 8, NKC = 64 * KCH / 512, NVC = DV * 8 / 512, ND0 = DQK / 16, NDB = DV / 32;
    static_assert(2 * KBUF + 2 * VBUF <= AT_ML && 4 * 32 * DV * 4 <= AT_ML, "attention LDS map");
#define AT_KSWZ(row) (KCH == 16 ? ((row) & 15) : (((row) >> 1) & 7))
    const int wid = __builtin_amdgcn_readfirstlane(tid >> 6), lane = tid & 63, r32 = lane & 31, hi = lane >> 5, g = wid & 3, kh = wid >> 2;
    LAS float* Ms = (LAS float*)(lds + AT_ML);
    LAS float* Ls = Ms + 256;
    LAS float* Al = Ls + 256 + wid * 32;
    LAS float* OM = (LAS float*)lds;
    bf16x8 qr[ND0];
    { const bf16* qp = u.Q + (size_t)(32 * g + r32) * u.qs + 8 * hi;
#pragma unroll
      for (int d0 = 0; d0 < ND0; ++d0) qr[d0] = *(const bf16x8*)(qp + 16 * d0);
      if constexpr (QNORM) {
          float ss = 0.f;
#pragma unroll
          for (int d0 = 0; d0 < ND0; ++d0)
#pragma unroll
              for (int j = 0; j < 8; ++j) { const float v = bf2f((unsigned short)qr[d0][j]); ss += v * v; }
          ss = swap_sum(ss);
          const float rstd = __builtin_amdgcn_rsqf(ss * (1.f / DQK) + EPS);
#pragma unroll
          for (int d0 = 0; d0 < ND0; ++d0) { const f32x4 g0 = *(const f32x4*)(qgain + 16 * d0 + 8 * hi), g1 = *(const f32x4*)(qgain + 16 * d0 + 8 * hi + 4);
              u32x4 w; w.x = pk2(bf2f((unsigned short)qr[d0][0]) * rstd * g0[0], bf2f((unsigned short)qr[d0][1]) * rstd * g0[1]); w.y = pk2(bf2f((unsigned short)qr[d0][2]) * rstd * g0[2], bf2f((unsigned short)qr[d0][3]) * rstd * g0[3]);
              w.z = pk2(bf2f((unsigned short)qr[d0][4]) * rstd * g1[0], bf2f((unsigned short)qr[d0][5]) * rstd * g1[1]); w.w = pk2(bf2f((unsigned short)qr[d0][6]) * rstd * g1[2], bf2f((unsigned short)qr[d0][7]) * rstd * g1[3]);
              qr[d0] = __builtin_bit_cast(bf16x8, w); }
      } }
    unsigned kvo[NKC], vvo[NVC];
#pragma unroll
    for (int i = 0; i < NKC; ++i) { const int p = tid + 512 * i, row = p / KCH, cp = p % KCH; kvo[i] = (unsigned)(row * u.ks + ((cp ^ AT_KSWZ(row)) << 3)); }
#pragma unroll
    for (int i = 0; i < NVC; ++i) { const int p = tid + 512 * i, d = p >> 3, cp = p & 7; vvo[i] = (unsigned)(d * u.vts + ((cp ^ ((d >> 1) & 7)) << 3)); }
#define AT_STAGE(t, bf) do { const bf16* kt_ = u.K + (size_t)(64 * (t)) * u.ks; const bf16* vt_ = u.VT + 64 * (t); \
        _Pragma("unroll") for (int i_ = 0; i_ < NKC; ++i_) __builtin_amdgcn_global_load_lds((const unsigned*)(kt_ + kvo[i_]), (LAS unsigned*)(lds + KOFF + (bf) * KBUF + (512 * i_ + wid * 64) * 16), 16, 0, 0); \
        _Pragma("unroll") for (int i_ = 0; i_ < NVC; ++i_) __builtin_amdgcn_global_load_lds((const unsigned*)(vt_ + vvo[i_]), (LAS unsigned*)(lds + VOFF + (bf) * VBUF + (512 * i_ + wid * 64) * 16), 16, 0, 0); } while (0)
    float m_run = -1e30f, l_run = 0.f;
    f32x16 o[NDB];
#pragma unroll
    for (int i = 0; i < NDB; ++i)
#pragma unroll
        for (int r = 0; r < 16; ++r) o[i][r] = 0.f;
    const int qa = u.q0 + 32 * g;
    const int qpos = qa + r32;
    const int krow = 32 * kh + r32, kswz = AT_KSWZ(krow), vswz = (r32 >> 1) & 7;
    int buf = 0;
    AT_STAGE(u.t_lo, 0); VM_WAIT(); __syncthreads();
    for (int t = u.t_lo; t < u.t_hi; ++t) {
        if (t + 1 < u.t_hi) AT_STAGE(t + 1, buf ^ 1);
        SBAR();
        const int kb0 = 64 * t + 32 * kh;
        bool act = true;
#ifndef MK_NOSKIP
        if constexpr (MODE == 1) act = kb0 <= qa + 31;
        if constexpr (MODE == 2) act = (qa + 31 - kb0 >= 0) && (qa - (kb0 + 31) <= 127);
#endif
        if (act) {
            f32x16 p;
#pragma unroll
            for (int r = 0; r < 16; ++r) p[r] = 0.f;
            int ksw = kswz, vsw = vswz; asm volatile("" : "+v"(ksw), "+v"(vsw));
            const LAS unsigned char* kb = lds + KOFF + buf * KBUF + krow * KROW;
#pragma unroll
            for (int d0 = 0; d0 < ND0; ++d0) { const bf16x8 a = *(const LAS bf16x8*)(kb + (((2 * d0 + hi) ^ ksw) << 4)); p = __builtin_amdgcn_mfma_f32_32x32x16_bf16(a, qr[d0], p, 0, 0, 0); if ((d0 & 3) == 3) SBAR(); }
            const int dq = qpos - kb0 - 4 * hi;
            float pmax = -1e30f;
#pragma unroll
            for (int r = 0; r < 16; ++r) { const int c = (r & 3) + 8 * (r >> 2); float s = p[r] * scl2;
                if constexpr (MODE == 1) { if (dq - c < 0) s = -__builtin_inff(); }
                if constexpr (MODE == 2) { const int dist = dq - c; const bool ok = (unsigned)dist < 128u; const float bv = biasT[ok ? dist : 0]; s = ok ? s + bv : -__builtin_inff(); }
                p[r] = s; pmax = fmaxf(pmax, s); }
#if MK_DEBUG
            if (u.dbg && t == u.t_lo) { for (int r = 0; r < 16; ++r) u.dbg[(wid * 64 + lane) * 16 + r] = p[r]; }
#endif
            pmax = swap_max(pmax);
            const float m_new = fmaxf(m_run, pmax), alpha = ex2(m_run - m_new);
            float ps = 0.f;
#pragma unroll
            for (int r = 0; r < 16; ++r) { p[r] = ex2(p[r] - m_new); ps += p[r]; }
            ps = swap_sum(ps);
            l_run = l_run * alpha + ps; m_run = m_new;
            if (__any(alpha < 1.f)) {
                if (hi == 0) Al[r32] = alpha;
                LDS_WAIT();
#pragma unroll
                for (int r = 0; r < 16; ++r) { const float a = Al[crow(r, hi)];
#pragma unroll
                    for (int i = 0; i < NDB; ++i) o[i][r] *= a; }
                LDS_WAIT();
            }
            bf16x8 pa0, pa1; PK4(p, 0, pa0); PK4(p, 8, pa1);
            SBAR();
            const LAS unsigned char* vb = lds + VOFF + buf * VBUF + r32 * VROW;
#pragma unroll
            for (int i = 0; i < NDB; ++i) { const bf16x8 b0 = *(const LAS bf16x8*)(vb + i * 32 * VROW + (((4 * kh + hi) ^ vsw) << 4)), b1 = *(const LAS bf16x8*)(vb + i * 32 * VROW + (((4 * kh + 2 + hi) ^ vsw) << 4));
                o[i] = __builtin_amdgcn_mfma_f32_32x32x16_bf16(pa0, b0, o[i], 0, 0, 0); o[i] = __builtin_amdgcn_mfma_f32_32x32x16_bf16(pa1, b1, o[i], 0, 0, 0); if (i & 1) SBAR(); }
        }
        SBAR();
        VM_WAIT(); __syncthreads();
        buf ^= 1;
    }
#undef AT_STAGE
#undef AT_KSWZ
#if MK_DEBUG
    if (u.dbg) { u.dbg[8192 + (wid * 64 + lane) * 2] = m_run; u.dbg[8192 + (wid * 64 + lane) * 2 + 1] = l_run;
        for (int i = 0; i < NDB; ++i) for (int r = 0; r < 16; ++r) u.dbg[16384 + ((wid * 64 + lane) * 4 + i) * 16 + r] = o[i][r]; }
#endif
    if (hi == 0) { Ms[wid * 32 + r32] = m_run; Ls[wid * 32 + r32] = l_run; }
    if (kh == 1) {
#pragma unroll
        for (int i = 0; i < NDB; ++i)
#pragma unroll
            for (int r = 0; r < 16; ++r) OM[(g * 32 + crow(r, hi)) * DV + 32 * i + r32] = o[i][r];
    }
    LDS_WAIT(); __syncthreads();
    if (kh == 0) {
#pragma unroll
        for (int r = 0; r < 16; ++r) { const int q = crow(r, hi);
            const float m0 = Ms[g * 32 + q], m1 = Ms[(4 + g) * 32 + q], l0 = Ls[g * 32 + q], l1 = Ls[(4 + g) * 32 + q];
            const float mm = fmaxf(m0, m1), a0 = ex2(m0 - mm), a1 = ex2(m1 - mm);
            float L = l0 * a0 + l1 * a1; if constexpr (MODE == 2) L += ex2(sink2 - mm);
            const float inv = 1.f / L;
            bf16* orow = u.O + (size_t)(32 * g + q) * u.os;
#pragma unroll
            for (int i = 0; i < NDB; ++i) { const float v = (o[i][r] * a0 + OM[(g * 32 + q) * DV + 32 * i + r32] * a1) * inv; const float vn = __shfl_xor(v, 1);
                if ((r32 & 1) == 0) *(unsigned*)(orow + 32 * i + r32) = pk2(v, vn); }
            SBAR(); }
    }
    __syncthreads();
}

template <int NC>
__device__ __forceinline__ void transpose_tile64(LAS unsigned char* lds, const bf16* src, int sstr, const float* rowscale, bf16* dst, size_t dstr, int tid) {
    constexpr int CPT = NC / 8;
    const int row = tid >> 3, c0 = (tid & 7) * CPT;
    const float sc = rowscale ? rowscale[row] : 1.f;
#pragma unroll
    for (int i = 0; i < CPT / 8; ++i) { const u32x4 w = *(const u32x4*)(src + (size_t)row * sstr + c0 + 8 * i); const unsigned ww[4] = {w.x, w.y, w.z, w.w};
#pragma unroll
        for (int j = 0; j < 4; ++j) { unsigned lo = ww[j] & 0xffffu, hi = ww[j] >> 16; if (rowscale) { lo = f2bf(bf2f(lo) * sc); hi = f2bf(bf2f(hi) * sc); }
            *(LAS unsigned short*)(lds + (c0 + 8 * i + 2 * j) * 144 + row * 2) = (unsigned short)lo; *(LAS unsigned short*)(lds + (c0 + 8 * i + 2 * j + 1) * 144 + row * 2) = (unsigned short)hi; } }
    LDS_WAIT(); __syncthreads();
    if constexpr (NC == 512) { const int col = tid;
#pragma unroll
        for (int i = 0; i < 8; ++i) *(u32x4*)(dst + (size_t)col * dstr + 8 * i) = *(const LAS u32x4*)(lds + col * 144 + 16 * i); }
    else { const int col = tid >> 2, ch = (tid & 3) * 2;
#pragma unroll
        for (int i = 0; i < 2; ++i) *(u32x4*)(dst + (size_t)col * dstr + 8 * (ch + i)) = *(const LAS u32x4*)(lds + col * 144 + 16 * (ch + i)); }
    __syncthreads();
}

__device__ __forceinline__ void p_prep(Frame& F, int l) {
    bf16* U = (bf16*)(F.ws + WS_OVL + OV_U); bf16* SVT = (bf16*)(F.ws + WS_OVL + OV_SVT);
    float* rcq = (float*)(F.ws + WS_SMALL + SM_RSTDCQ); float* rckv = (float*)(F.ws + WS_SMALL + SM_RSTDCKV);
    const float* gq = F.in[6] + l * 64; const float* gk = F.in[7] + l * 64;
    const int lane = F.lane;
    for (int tile = F.bid; tile < NTOK / 64; tile += F.G) {
        for (int rr = 0; rr < 8; ++rr) { const int row = tile * 64 + F.wave * 8 + rr; bf16* up = U + (size_t)row * UW;
            { u32x4 w = *(const u32x4*)(up + C_SQ + 8 * lane); const unsigned ww[4] = {w.x, w.y, w.z, w.w}; float v[8]; float ss = 0.f;
#pragma unroll
              for (int j = 0; j < 4; ++j) { v[2 * j] = bflo(ww[j]); v[2 * j + 1] = bfhi(ww[j]); ss += v[2 * j] * v[2 * j] + v[2 * j + 1] * v[2 * j + 1]; }
              ss += __shfl_xor(ss, 1); ss += __shfl_xor(ss, 2); ss += __shfl_xor(ss, 4);
              const float rstd = __builtin_amdgcn_rsqf(ss * (1.f / 64) + EPS); const float* gp = gq + (lane & 7) * 8;
              u32x4 o; o.x = pk2(v[0] * rstd * gp[0], v[1] * rstd * gp[1]); o.y = pk2(v[2] * rstd * gp[2], v[3] * rstd * gp[3]); o.z = pk2(v[4] * rstd * gp[4], v[5] * rstd * gp[5]); o.w = pk2(v[6] * rstd * gp[6], v[7] * rstd * gp[7]);
              *(u32x4*)(up + C_SQ + 8 * lane) = o; }
            { const int l16 = lane & 15; u32x4 w = *(const u32x4*)(up + C_SK + 8 * l16); const unsigned ww[4] = {w.x, w.y, w.z, w.w}; float v[8]; float ss = 0.f;
#pragma unroll
              for (int j = 0; j < 4; ++j) { v[2 * j] = bflo(ww[j]); v[2 * j + 1] = bfhi(ww[j]); ss += v[2 * j] * v[2 * j] + v[2 * j + 1] * v[2 * j + 1]; }
              ss += __shfl_xor(ss, 1); ss += __shfl_xor(ss, 2); ss += __shfl_xor(ss, 4);
              const float rstd = __builtin_amdgcn_rsqf(ss * (1.f / 64) + EPS); const float* gp = gk + (lane & 7) * 8;
              u32x4 o; o.x = pk2(v[0] * rstd * gp[0], v[1] * rstd * gp[1]); o.y = pk2(v[2] * rstd * gp[2], v[3] * rstd * gp[3]); o.z = pk2(v[4] * rstd * gp[4], v[5] * rstd * gp[5]); o.w = pk2(v[6] * rstd * gp[6], v[7] * rstd * gp[7]);
              if (lane < 16) *(u32x4*)(up + C_SK + 8 * l16) = o; }
            { u32x4 w = *(const u32x4*)(up + C_CQ + 8 * lane); const unsigned ww[4] = {w.x, w.y, w.z, w.w}; float ss = 0.f;
#pragma unroll
              for (int j = 0; j < 4; ++j) { const float a = bflo(ww[j]), b = bfhi(ww[j]); ss += a * a + b * b; }
              ss = wave_sum(ss); if (lane == 0) rcq[row] = __builtin_amdgcn_rsqf(ss * (1.f / 512) + EPS); }
            { u32x2 w = *(const u32x2*)(up + C_CKV + 4 * lane); float ss = bflo(w.x) * bflo(w.x) + bfhi(w.x) * bfhi(w.x) + bflo(w.y) * bflo(w.y) + bfhi(w.y) * bfhi(w.y);
              ss = wave_sum(ss); if (lane == 0) rckv[row] = __builtin_amdgcn_rsqf(ss * (1.f / 256) + EPS); }
        }
        const int b = tile >> 6, s0 = (tile & 63) * 64;
        transpose_tile64<128>(F.lds, U + (size_t)tile * 64 * UW + C_SV, UW, nullptr, SVT + (size_t)b * 128 * SEQ + s0, SEQ, F.tid);
    }
}

__device__ __forceinline__ void p_mla_post(Frame& F, int l) {
    const bf16* U = (const bf16*)(F.ws + WS_OVL + OV_U); const bf16* QM = (const bf16*)(F.ws + WS_OVL + OV_QM); const bf16* KVM = (const bf16*)(F.ws + WS_OVL + OV_KVM);
    bf16* QF = (bf16*)(F.ws + WS_OVL + OV_QF); bf16* KF = (bf16*)(F.ws + WS_OVL + OV_KF); bf16* VT = (bf16*)(F.ws + WS_OVL + OV_VT);
    const float* rcq = (const float*)(F.ws + WS_SMALL + SM_RSTDCQ); const float* rckv = (const float*)(F.ws + WS_SMALL + SM_RSTDCKV);
    const float* rope = (const float*)(F.ws + WS_ROPE);
    const float* gq = F.in[14] + l * 192; const float* gk = F.in[15] + l * 192;
    const int lane = F.lane, h = lane >> 4, lh = lane & 15;
    for (int tile = F.bid; tile < NTOK / 64; tile += F.G) {
        for (int rr = 0; rr < 8; ++rr) { const int row = tile * 64 + F.wave * 8 + rr, b = row >> 12, s = row & 4095;
            const f32x4 cs = *(const f32x4*)(rope + ((size_t)s * 32 + 2 * lh) * 2);
#pragma unroll
            for (int which = 0; which < 2; ++which) {
                const bf16* np = which == 0 ? QM + (size_t)row * 768 + h * 192 + 8 * lh : KVM + (size_t)row * 1024 + h * 256 + 8 * lh;
                const bf16* rp = which == 0 ? QM + (size_t)row * 768 + h * 192 + 128 : U + (size_t)row * UW + C_KR;
                const float sc = which == 0 ? rcq[row] : rckv[row], scr = which == 0 ? sc : 1.f;
                const float* gg = which == 0 ? gq : gk;
                const u32x4 w = *(const u32x4*)np; const unsigned ww[4] = {w.x, w.y, w.z, w.w};
                const unsigned r1 = *(const unsigned*)(rp + 2 * lh), r2 = *(const unsigned*)(rp + 32 + 2 * lh);
                float v[8]; float ss = 0.f;
#pragma unroll
                for (int j = 0; j < 4; ++j) { v[2 * j] = bflo(ww[j]) * sc; v[2 * j + 1] = bfhi(ww[j]) * sc; ss += v[2 * j] * v[2 * j] + v[2 * j + 1] * v[2 * j + 1]; }
                float x1a = bflo(r1) * scr, x1b = bfhi(r1) * scr, x2a = bflo(r2) * scr, x2b = bfhi(r2) * scr;
                ss += x1a * x1a + x1b * x1b + x2a * x2a + x2b * x2b;
                ss += __shfl_xor(ss, 1); ss += __shfl_xor(ss, 2); ss += __shfl_xor(ss, 4); ss += __shfl_xor(ss, 8);
                const float rstd = __builtin_amdgcn_rsqf(ss * (1.f / 192) + EPS);
                const float* g8 = gg + 8 * lh;
                u32x4 o; o.x = pk2(v[0] * rstd * g8[0], v[1] * rstd * g8[1]); o.y = pk2(v[2] * rstd * g8[2], v[3] * rstd * g8[3]); o.z = pk2(v[4] * rstd * g8[4], v[5] * rstd * g8[5]); o.w = pk2(v[6] * rstd * g8[6], v[7] * rstd * g8[7]);
                x1a *= rstd * gg[128 + 2 * lh]; x1b *= rstd * gg[128 + 2 * lh + 1]; x2a *= rstd * gg[160 + 2 * lh]; x2b *= rstd * gg[160 + 2 * lh + 1];
                const float o1a = x1a * cs[0] - x2a * cs[1], o2a = x1a * cs[1] + x2a * cs[0], o1b = x1b * cs[2] - x2b * cs[3], o2b = x1b * cs[3] + x2b * cs[2];
                bf16* op = (which == 0 ? QF : KF) + ((size_t)(b * 4 + h) * SEQ + s) * 192;
                *(u32x4*)(op + 8 * lh) = o; *(unsigned*)(op + 128 + 2 * lh) = pk2(o1a, o1b); *(unsigned*)(op + 160 + 2 * lh) = pk2(o2a, o2b);
            } }
        const int b = tile >> 6, s0 = (tile & 63) * 64;
        for (int hh = 0; hh < 4; ++hh)
            transpose_tile64<128>(F.lds, KVM + (size_t)tile * 64 * 1024 + hh * 256 + 128, 1024, rckv + tile * 64, VT + ((size_t)(b * 4 + hh) * 128) * SEQ + s0, SEQ, F.tid);
    }
}

__device__ __forceinline__ void p_mem_post(Frame& F) {
    const int lane = F.lane, h = lane >> 4, lh = lane & 15;
    for (int unit = F.bid; unit < 32; unit += F.G) { const int l = unit >> 4, tile = unit & 15;
        const bf16* MKV = (const bf16*)(F.ws + WS_MKV) + (size_t)l * 1024 * 1024; bf16* MK = (bf16*)(F.ws + WS_MK) + (size_t)l * 1024 * 512; bf16* MVT = (bf16*)(F.ws + WS_MVT) + (size_t)l * 1024 * 512;
        const float* gk = F.in[22] + l * 128;
        for (int rr = 0; rr < 8; ++rr) { const int row = tile * 64 + F.wave * 8 + rr, b = row >> 8, m = row & 255;
            const u32x4 w = *(const u32x4*)(MKV + (size_t)row * 1024 + h * 128 + 8 * lh); const unsigned ww[4] = {w.x, w.y, w.z, w.w}; float v[8]; float ss = 0.f;
#pragma unroll
            for (int j = 0; j < 4; ++j) { v[2 * j] = bflo(ww[j]); v[2 * j + 1] = bfhi(ww[j]); ss += v[2 * j] * v[2 * j] + v[2 * j + 1] * v[2 * j + 1]; }
            ss += __shfl_xor(ss, 1); ss += __shfl_xor(ss, 2); ss += __shfl_xor(ss, 4); ss += __shfl_xor(ss, 8);
            const float rstd = __builtin_amdgcn_rsqf(ss * (1.f / 128) + EPS); const float* g8 = gk + 8 * lh;
            u32x4 o; o.x = pk2(v[0] * rstd * g8[0], v[1] * rstd * g8[1]); o.y = pk2(v[2] * rstd * g8[2], v[3] * rstd * g8[3]); o.z = pk2(v[4] * rstd * g8[4], v[5] * rstd * g8[5]); o.w = pk2(v[6] * rstd * g8[6], v[7] * rstd * g8[7]);
            *(u32x4*)(MK + ((size_t)(b * 4 + h) * 256 + m) * 128 + 8 * lh) = o; }
        const int b = tile >> 2, m0 = (tile & 3) * 64;
        for (int hh = 0; hh < 4; ++hh)
            transpose_tile64<128>(F.lds, MKV + (size_t)tile * 64 * 1024 + 512 + hh * 128, 1024, nullptr, MVT + ((size_t)(b * 4 + hh) * 128) * 256 + m0, 256, F.tid);
    }
}

constexpr int HG_QH = 0, HG_KH = 64 * 272, HG_KT = 2 * 64 * 272, HG_VT = HG_KT + 128 * 144, HG_TOT = HG_VT + 128 * 144;
__device__ __forceinline__ void p_hgrn1(Frame& F, int l) {
    const bf16* U = (const bf16*)(F.ws + WS_OVL + OV_U); bf16* QT = (bf16*)(F.ws + WS_OVL + OV_QT); bf16* INTRA = (bf16*)(F.ws + WS_OVL + OV_INTRA); bf16* UT = (bf16*)(F.ws + WS_OVL + OV_UT);
    float* DEC = (float*)(F.ws + WS_OVL + OV_DEC); const float* lb = (const float*)(F.ws + WS_SMALL + SM_LB) + l * 1024;
    LAS unsigned char* lds = F.lds; LAS float* tot = (LAS float*)(lds + HG_TOT);
    const int tid = F.tid, lane = F.lane, wid = F.wave, r32 = lane & 31, hi = lane >> 5;
    const int ch = tid & 127, part = tid >> 7;
    for (int unit = F.bid; unit < 2048; unit += F.G) {
        const int b = unit >> 9, h = (unit >> 6) & 7, c = unit & 63, row0 = b * SEQ + 64 * c;
        const bf16* base = U + (size_t)(row0 + 16 * part) * UW + h * 128 + ch;
        const float lbv = lb[h * 128 + ch];
        float cs[16], kin[16]; float run = 0.f;
#pragma unroll
        for (int i = 0; i < 16; ++i) { const float f = bf2f(base[(size_t)i * UW + C_HF]); const float sig = __builtin_amdgcn_rcpf(1.f + fexp(-f));
            const float fv = lbv + (1.f - lbv) * sig; run += flog(fv); cs[i] = run; kin[i] = (1.f - lbv) * (1.f - sig); }
        tot[part * 128 + ch] = run;
        LDS_WAIT(); __syncthreads();
        const float t0 = tot[ch], t1 = tot[128 + ch], t2 = tot[256 + ch], t3 = tot[384 + ch];
        const float off = (part > 0 ? t0 : 0.f) + (part > 1 ? t1 : 0.f) + (part > 2 ? t2 : 0.f), rref = t0 + t1, btot = (t0 + t1) + (t2 + t3);
#pragma unroll
        for (int i = 0; i < 16; ++i) { const int s = 16 * part + i; const float bc = off + cs[i];
            const float q = bf2f(base[(size_t)i * UW + C_HQ]); const unsigned short vb = base[(size_t)i * UW + C_HI];
            *(LAS unsigned short*)(lds + HG_QH + s * 272 + ch * 2) = (unsigned short)f2bf(q * fexp(bc - rref));
            *(LAS unsigned short*)(lds + HG_KH + s * 272 + ch * 2) = (unsigned short)f2bf(kin[i] * fexp(rref - bc));
            QT[(size_t)(row0 + s) * 1024 + h * 128 + ch] = (unsigned short)f2bf(q * fexp(bc));
            *(LAS unsigned short*)(lds + HG_KT + ch * 144 + s * 2) = (unsigned short)f2bf(kin[i] * fexp(btot - bc));
            *(LAS unsigned short*)(lds + HG_VT + ch * 144 + s * 2) = vb; }
        if (part == 0) DEC[unit * 128 + ch] = fexp(btot);
        LDS_WAIT(); __syncthreads();
        const int tb = wid >> 2, vb = wid & 3;
        bf16x8 pa[2][2];
#pragma unroll
        for (int sb = 0; sb < 2; ++sb) {
            if (sb <= tb) {
                f32x16 p;
#pragma unroll
                for (int r = 0; r < 16; ++r) p[r] = 0.f;
#pragma unroll
                for (int d0 = 0; d0 < 8; ++d0) { const bf16x8 a = *(const LAS bf16x8*)(lds + HG_KH + (32 * sb + r32) * 272 + (16 * d0 + 8 * hi) * 2), bq = *(const LAS bf16x8*)(lds + HG_QH + (32 * tb + r32) * 272 + (16 * d0 + 8 * hi) * 2);
                    p = __builtin_amdgcn_mfma_f32_32x32x16_bf16(a, bq, p, 0, 0, 0); }
#pragma unroll
                for (int r = 0; r < 16; ++r) { const int s = 32 * sb + crow(r, hi), t = 32 * tb + r32; if (s > t) p[r] = 0.f; }
                PK4(p, 0, pa[sb][0]); PK4(p, 8, pa[sb][1]);
            }
        }
        { f32x16 o;
#pragma unroll
          for (int r = 0; r < 16; ++r) o[r] = 0.f;
#pragma unroll
          for (int sb = 0; sb < 2; ++sb) if (sb <= tb) {
#pragma unroll
              for (int ks = 0; ks < 2; ++ks) { const bf16x8 bv = *(const LAS bf16x8*)(lds + HG_VT + (32 * vb + r32) * 144 + (32 * sb + 16 * ks + 8 * hi) * 2);
                  o = __builtin_amdgcn_mfma_f32_32x32x16_bf16(pa[sb][ks], bv, o, 0, 0, 0); } }
#pragma unroll
          for (int r = 0; r < 16; ++r) { const int t = 32 * tb + crow(r, hi); const float v = o[r], vn = __shfl_xor(v, 1);
              if ((r32 & 1) == 0) *(unsigned*)(INTRA + (size_t)(row0 + t) * 1024 + h * 128 + 32 * vb + r32) = pk2(v, vn); } }
#pragma unroll
        for (int j = 0; j < 2; ++j) { const int kbk = 2 * tb + j; f32x16 a2;
#pragma unroll
            for (int r = 0; r < 16; ++r) a2[r] = 0.f;
#pragma unroll
            for (int ks = 0; ks < 4; ++ks) { const bf16x8 av = *(const LAS bf16x8*)(lds + HG_VT + (32 * vb + r32) * 144 + (16 * ks + 8 * hi) * 2), bk = *(const LAS bf16x8*)(lds + HG_KT + (32 * kbk + r32) * 144 + (16 * ks + 8 * hi) * 2);
                a2 = __builtin_amdgcn_mfma_f32_32x32x16_bf16(av, bk, a2, 0, 0, 0); }
#pragma unroll
            for (int r = 0; r < 16; ++r) { const int v = 32 * vb + crow(r, hi); const float x = a2[r], xn = __shfl_xor(x, 1);
                if ((r32 & 1) == 0) *(unsigned*)(UT + ((size_t)unit * 128 + v) * 128 + 32 * kbk + r32) = pk2(x, xn); } }
        __syncthreads();
    }
}
__device__ __forceinline__ void p_hgrn2(Frame& F) {
    bf16* UT = (bf16*)(F.ws + WS_OVL + OV_UT); const float* DEC = (const float*)(F.ws + WS_OVL + OV_DEC);
    for (int id = F.bid * NTHR + F.tid; id < 32 * 4096; id += F.G * NTHR) {
        const int bh = id >> 12, rem = id & 4095, v = rem >> 5, k4 = rem & 31;
        float st[4] = {0.f, 0.f, 0.f, 0.f};
        for (int c0 = 0; c0 < 64; c0 += 8) {
            u32x2 uu[8]; f32x4 dd[8];
#pragma unroll
            for (int j = 0; j < 8; ++j) { const size_t un = (size_t)bh * 64 + c0 + j; uu[j] = *(const u32x2*)(UT + (un * 128 + v) * 128 + 4 * k4); dd[j] = *(const f32x4*)(DEC + un * 128 + 4 * k4); }
#pragma unroll
            for (int j = 0; j < 8; ++j) { const size_t un = (size_t)bh * 64 + c0 + j;
                u32x2 o; o.x = pk2(st[0], st[1]); o.y = pk2(st[2], st[3]); *(u32x2*)(UT + (un * 128 + v) * 128 + 4 * k4) = o;
                st[0] = st[0] * dd[j][0] + bflo(uu[j].x); st[1] = st[1] * dd[j][1] + bfhi(uu[j].x); st[2] = st[2] * dd[j][2] + bflo(uu[j].y); st[3] = st[3] * dd[j][3] + bfhi(uu[j].y); }
        }
    }
}
__device__ __forceinline__ void p_hgrn3(Frame& F, int l) {
    const bf16* U = (const bf16*)(F.ws + WS_OVL + OV_U); const bf16* QT = (const bf16*)(F.ws + WS_OVL + OV_QT); const bf16* INTRA = (const bf16*)(F.ws + WS_OVL + OV_INTRA); const bf16* UT = (const bf16*)(F.ws + WS_OVL + OV_UT);
    bf16* MIX = (bf16*)(F.ws + WS_OVL + OV_MIX); const float* gout = F.in[9] + l * 128;
    LAS float* OL = (LAS float*)F.lds;
    const int tid = F.tid, lane = F.lane, wid = F.wave, r32 = lane & 31, hi = lane >> 5, tb = wid >> 2, vb = wid & 3;
    for (int unit = F.bid; unit < 2048; unit += F.G) {
        const int b = unit >> 9, h = (unit >> 6) & 7, c = unit & 63, row0 = b * SEQ + 64 * c;
        f32x16 acc;
#pragma unroll
        for (int r = 0; r < 16; ++r) acc[r] = 0.f;
        const bf16* ap = QT + (size_t)(row0 + 32 * tb + r32) * 1024 + h * 128 + 8 * hi; const bf16* bp = UT + ((size_t)unit * 128 + 32 * vb + r32) * 128 + 8 * hi;
#pragma unroll
        for (int ks = 0; ks < 8; ++ks) { const bf16x8 a = *(const bf16x8*)(ap + 16 * ks), bb = *(const bf16x8*)(bp + 16 * ks); acc = __builtin_amdgcn_mfma_f32_32x32x16_bf16(a, bb, acc, 0, 0, 0); }
#pragma unroll
        for (int r = 0; r < 16; ++r) OL[(32 * tb + crow(r, hi)) * 132 + 32 * vb + r32] = acc[r];
        LDS_WAIT(); __syncthreads();
        { const int t = tid >> 3, j = tid & 7; const size_t row = (size_t)(row0 + t);
          const u32x4 i0 = *(const u32x4*)(INTRA + row * 1024 + h * 128 + 16 * j), i1 = *(const u32x4*)(INTRA + row * 1024 + h * 128 + 16 * j + 8);
          const u32x4 g0 = *(const u32x4*)(U + row * UW + C_HG + h * 128 + 16 * j), g1 = *(const u32x4*)(U + row * UW + C_HG + h * 128 + 16 * j + 8);
          const unsigned iw[8] = {i0.x, i0.y, i0.z, i0.w, i1.x, i1.y, i1.z, i1.w}, gw[8] = {g0.x, g0.y, g0.z, g0.w, g1.x, g1.y, g1.z, g1.w};
          float o[16]; float ss = 0.f;
#pragma unroll
          for (int i = 0; i < 4; ++i) { const f32x4 x = *(const LAS f32x4*)(OL + t * 132 + 16 * j + 4 * i);
              o[4 * i] = x[0] + bflo(iw[2 * i]); o[4 * i + 1] = x[1] + bfhi(iw[2 * i]); o[4 * i + 2] = x[2] + bflo(iw[2 * i + 1]); o[4 * i + 3] = x[3] + bfhi(iw[2 * i + 1]); }
#pragma unroll
          for (int i = 0; i < 16; ++i) ss += o[i] * o[i];
          ss += __shfl_xor(ss, 1); ss += __shfl_xor(ss, 2); ss += __shfl_xor(ss, 4);
          const float rstd = __builtin_amdgcn_rsqf(ss * (1.f / 128) + EPS);
          unsigned ow[8];
#pragma unroll
          for (int i = 0; i < 8; ++i) { const float ga = bflo(gw[i]), gb = bfhi(gw[i]);
              const float ya = o[2 * i] * rstd * gout[16 * j + 2 * i] * ga * __builtin_amdgcn_rcpf(1.f + fexp(-ga)), yb = o[2 * i + 1] * rstd * gout[16 * j + 2 * i + 1] * gb * __builtin_amdgcn_rcpf(1.f + fexp(-gb));
              ow[i] = pk2(ya, yb); }
          bf16* op = MIX + row * D + 512 + h * 128 + 16 * j;
          *(u32x4*)op = (u32x4){ow[0], ow[1], ow[2], ow[3]}; *(u32x4*)(op + 8) = (u32x4){ow[4], ow[5], ow[6], ow[7]}; }
        __syncthreads();
    }
}

__device__ __forceinline__ void p_router(Frame& F, int l) {
    const float* x = F.out; const float* gain = F.in[24] + (size_t)l * D; const float* wgr = F.in[25] + (size_t)l * D * 8; const float* bgr = F.in[26] + l * 8;
    const float* wer = F.in[27] + (size_t)l * D * 64; const float* ber = F.in[28] + l * 64;
    float* rstdo = (float*)(F.ws + WS_SMALL + SM_RSTDFFN); int* eidx = (int*)(F.ws + WS_SMALL + SM_EIDX); float* gate = (float*)(F.ws + WS_SMALL + SM_GATE); int* slot = (int*)(F.ws + WS_SMALL + SM_SLOT);
    unsigned* cnt = F.ctl + CW_CNT + l * 64;
    LAS float* LG = (LAS float*)(F.lds + F.wave * (16 * 84 * 4));
    const int lane = F.lane, c = lane & 15, q = lane >> 4;
    const int gw = F.bid + F.G * F.wave, NGW = F.G * NWAVES;
    for (int tile = gw; tile < NTOK / 16; tile += NGW) {
        f32x4 acc[5];
#pragma unroll
        for (int i = 0; i < 5; ++i) acc[i] = (f32x4){0.f, 0.f, 0.f, 0.f};
        float ss = 0.f;
        const float* xp = x + (size_t)(tile * 16 + c) * D + 4 * q;
        for (int i = 0; i < 128; ++i) {
            const f32x4 xv = *(const f32x4*)(xp + 16 * i), gv = *(const f32x4*)(gain + 16 * i + 4 * q);
            ss += (xv[0] * xv[0] + xv[1] * xv[1]) + (xv[2] * xv[2] + xv[3] * xv[3]);
#pragma unroll
            for (int j = 0; j < 4; ++j) { const float a = xv[j] * gv[j]; const int k = 16 * i + 4 * q + j;
                const float b0 = c < 8 ? wgr[(size_t)k * 8 + c] : 0.f;
                acc[0] = __builtin_amdgcn_mfma_f32_16x16x4f32(a, b0, acc[0], 0, 0, 0);
#pragma unroll
                for (int ct = 1; ct < 5; ++ct) { const float bb = wer[(size_t)k * 64 + 16 * (ct - 1) + c]; acc[ct] = __builtin_amdgcn_mfma_f32_16x16x4f32(a, bb, acc[ct], 0, 0, 0); } }
        }
        ss += __shfl_xor(ss, 16); ss += __shfl_xor(ss, 32);
        const float rstd = __builtin_amdgcn_rsqf(ss * (1.f / D) + EPS);
#pragma unroll
        for (int ct = 0; ct < 5; ++ct)
#pragma unroll
            for (int r = 0; r < 4; ++r) LG[(4 * q + r) * 84 + 16 * ct + c] = acc[ct][r];
        LDS_WAIT();
        if (lane < 16) {
            const int tok = tile * 16 + lane; const LAS float* lg = LG + lane * 84;
            float gl[8]; float gm = -3.4e38f; int grp = 0;
#pragma unroll
            for (int j = 0; j < 8; ++j) { gl[j] = lg[j] * rstd + bgr[j]; if (gl[j] > gm) { gm = gl[j]; grp = j; } }
            float gs = 0.f;
#pragma unroll
            for (int j = 0; j < 8; ++j) gs += expf(gl[j] - gm);
            const float pgrp = 1.f / gs;
            float el[8]; float e1 = -3.4e38f; int i1 = 0;
#pragma unroll
            for (int j = 0; j < 8; ++j) { el[j] = lg[16 + grp * 8 + j] * rstd + ber[grp * 8 + j]; if (el[j] > e1) { e1 = el[j]; i1 = j; } }
            float e2 = -3.4e38f; int i2 = 0;
#pragma unroll
            for (int j = 0; j < 8; ++j) if (j != i1 && el[j] > e2) { e2 = el[j]; i2 = j; }
            const float r21 = expf(e2 - e1), g1 = pgrp / (1.f + r21), g2 = pgrp * r21 / (1.f + r21);
            const int ex1 = grp * 8 + i1, ex2_ = grp * 8 + i2;
            const int s1 = (int)atomicAdd(cnt + ex1, 1u), s2 = (int)atomicAdd(cnt + ex2_, 1u);
            rstdo[tok] = rstd; eidx[2 * tok] = ex1; eidx[2 * tok + 1] = ex2_; gate[2 * tok] = g1; gate[2 * tok + 1] = g2; slot[2 * tok] = s1; slot[2 * tok + 1] = s2;
        }
        LDS_WAIT();
    }
}
__device__ __forceinline__ void p_gather(Frame& F, int l) {
    const float* x = F.out; const float* gain = F.in[24] + (size_t)l * D;
    const float* rstdi = (const float*)(F.ws + WS_SMALL + SM_RSTDFFN); const int* eidx = (const int*)(F.ws + WS_SMALL + SM_EIDX); const int* slot = (const int*)(F.ws + WS_SMALL + SM_SLOT);
    int* arow = (int*)(F.ws + WS_SMALL + SM_AROW); bf16* XG = (bf16*)(F.ws + WS_OVL + OV_XG);
    const unsigned* cnt = F.ctl + CW_CNT + l * 64;
    LAS int* OFF = (LAS int*)F.lds;
    LAS int* CN = OFF + 128;
    if (F.tid < 64) CN[F.tid] = (int)__hip_atomic_load(cnt + F.tid, __ATOMIC_RELAXED, __HIP_MEMORY_SCOPE_AGENT);
    LDS_WAIT(); __syncthreads();
    if (F.tid == 0) { int o = 0; for (int e = 0; e < 64; ++e) { OFF[e] = o; o += (CN[e] + 255) & ~255; } OFF[64] = o; }
    LDS_WAIT(); __syncthreads();
    if (F.bid == 0 && F.tid == 0) { int n = 0;
        for (int e = 0; e < 64; ++e) for (int r = OFF[e]; r < OFF[e + 1]; r += 256) { F.ctl[CW_MTE + l * 256 + n] = (unsigned)e; F.ctl[CW_MTR + l * 256 + n] = (unsigned)r; ++n; }
        F.ctl[CW_NMT + l] = (unsigned)n; }
    const int lane = F.lane, gw = F.bid * NWAVES + F.wave, NGW = F.G * NWAVES;
    for (int tok = gw; tok < NTOK; tok += NGW) {
        const float rstd = rstdi[tok]; const int r0 = OFF[eidx[2 * tok]] + slot[2 * tok], r1 = OFF[eidx[2 * tok + 1]] + slot[2 * tok + 1];
        if (lane == 0) { arow[2 * tok] = r0; arow[2 * tok + 1] = r1; }
#pragma unroll
        for (int j = 0; j < 8; ++j) { const f32x4 v = *((const f32x4*)(x + (size_t)tok * D) + lane + 64 * j), gv = *((const f32x4*)gain + lane + 64 * j);
            u32x2 o; o.x = pk2(v[0] * rstd * gv[0], v[1] * rstd * gv[1]); o.y = pk2(v[2] * rstd * gv[2], v[3] * rstd * gv[3]);
            *((u32x2*)(XG + (size_t)r0 * D) + lane + 64 * j) = o; *((u32x2*)(XG + (size_t)r1 * D) + lane + 64 * j) = o; }
    }
    for (int e = F.bid; e < 64; e += F.G)
        for (int r = OFF[e] + CN[e] + F.wave; r < OFF[e + 1]; r += NWAVES) {
#pragma unroll
            for (int j = 0; j < 4; ++j) *((u32x4*)(XG + (size_t)r * D) + lane + 64 * j) = (u32x4){0u, 0u, 0u, 0u}; }
    __syncthreads();
}

constexpr int PH_PER_LAYER = 14, PH_BASE = 3, N_PHASES = PH_BASE + DEPTH * PH_PER_LAYER;
__global__ void __launch_bounds__(NTHR, 2) mk_fwd(Args args) {
    extern __shared__ __attribute__((aligned(16))) unsigned char lds_raw[];
    Frame F; F.lds = (LAS unsigned char*)lds_raw; F.tid = threadIdx.x; F.lane = F.tid & 63; F.wave = __builtin_amdgcn_readfirstlane(F.tid >> 6);
    F.G = gridDim.x; F.bid = blockIdx.x; F.ws = args.ws; F.ctl = (unsigned*)(args.ws + WS_CTL); F.in = args.in; F.out = args.out;
    volatile LAS unsigned* MISC = (volatile LAS unsigned*)(F.lds + MISC_OFF);
    if (F.tid < 64) MISC[F.tid] = 0u;
    __syncthreads();
    XcdBarrier bar = xcd_barrier_post(F.ctl + CW_BAR, MISC + 8);
    const int lo = args.ph_lo, hi = args.ph_hi;
#ifndef MK_PHMASK
#define MK_PHMASK 0xFFFFFFFFu
#endif
#ifndef MK_STOP
#define MK_STOP 1000
#endif
#define IN(k) (lo <= (k) && (k) < hi && ((k) < MK_STOP || (k) >= N_PHASES))
#define EN(j) (((MK_PHMASK) >> (j)) & 1u)
#define SEAM(k) do { if (IN((k) + 1)) xcd_barrier(bar, P.tid == 0); } while (0)
#define LAUNDER(v) asm volatile("" : "+s"(v))
#define PHASE_FRAME() Frame P = F; int z_ = 0; LAUNDER(z_); asm volatile("v_mbcnt_lo_u32_b32 %0, -1, 0\n\tv_mbcnt_hi_u32_b32 %0, -1, %0" : "=v"(P.tid)); P.tid |= (F.wave << 6) + z_; P.lane = P.tid & 63; P.wave = __builtin_amdgcn_readfirstlane(P.tid >> 6); P.ws = F.ws + z_; P.ctl = F.ctl + z_; P.in = F.in + z_; P.out = F.out + z_; unsigned char* ws = P.ws; (void)ws
    if (EN(14) && IN(0)) {
        PHASE_FRAME();
        p_convert(P);
        const int gw = P.bid * NWAVES + P.wave, NGW = P.G * NWAVES;
        for (int r = gw; r < 2 * 1024; r += NGW) { const int l = r >> 10, row = r & 1023;
            norm_row(P.in[1] + (size_t)row * D, nullptr, (bf16*)(ws + WS_MEMN) + (size_t)r * D, P.in[18] + l * D, nullptr, nullptr, 0.f, 0.f, P.lane); }
        for (int r = gw; r < NTOK; r += NGW) norm_row(P.in[0] + (size_t)r * D, P.out + (size_t)r * D, (bf16*)(ws + WS_HN) + (size_t)r * D, P.in[4], nullptr, nullptr, 0.f, 0.f, P.lane);
        SEAM(0);
    }
    if (EN(15) && IN(1)) {
        PHASE_FRAME();
        for (int l = 0; l < DEPTH; ++l) {
            pg8::Gemm g{(const bf16*)(ws + WS_MEMN) + (size_t)l * 1024 * D, (const bf16*)(ws + WS_W + (size_t)l * WL_END + WL_WMKV), D, D};
            pg8::StaticOrder S; S.init(1024, 1024, D, D, P.G, P.bid);
            pg8::EpiBf16 E{(bf16*)(ws + WS_MKV) + (size_t)l * 1024 * 1024, 1024};
            pg8::gemm_phase(P.lds, P.tid, g, S, E);
        }
        SEAM(1);
    }
    if (EN(16) && IN(2)) { PHASE_FRAME(); p_mem_post(P); SEAM(2); }
    for (int l_ = 0; l_ < DEPTH; ++l_) {
        const int pb = PH_BASE + l_ * PH_PER_LAYER;
#define LAYER_FRAME() PHASE_FRAME(); int l = l_ + z_; unsigned char* wl = ws + WS_W + (size_t)l * WL_END; (void)wl; \
        bf16* U = (bf16*)(ws + WS_OVL + OV_U); bf16* MIX = (bf16*)(ws + WS_OVL + OV_MIX); bf16* HN = (bf16*)(ws + WS_HN); (void)U; (void)MIX; (void)HN
        if (EN(0) && IN(pb + 0)) {
            LAYER_FRAME();
            pg8::Gemm g{HN, (const bf16*)(wl + WL_WIN), D, D}; pg8::StaticOrder S; S.init(NTOK, UW, D, D, P.G, P.bid); pg8::EpiBf16 E{U, UW};
            pg8::gemm_phase(P.lds, P.tid, g, S, E);
            SEAM(pb + 0);
        }
        if (EN(1) && IN(pb + 1)) {
            LAYER_FRAME();
            { pg8::Gemm g{U + C_CQ, (const bf16*)(wl + WL_WUQ), UW, 512}; pg8::StaticOrder S; S.init(NTOK, 768, UW, 512, P.G, P.bid); pg8::EpiBf16 E{(bf16*)(ws + WS_OVL + OV_QM), 768};
              pg8::gemm_phase(P.lds, P.tid, g, S, E); }
            { pg8::Gemm g{U + C_CKV, (const bf16*)(wl + WL_WUKV), UW, 256}; pg8::StaticOrder S; S.init(NTOK, 1024, UW, 256, P.G, P.bid); pg8::EpiBf16 E{(bf16*)(ws + WS_OVL + OV_KVM), 1024};
              pg8::gemm_phase(P.lds, P.tid, g, S, E); }
            p_prep(P, l);
            p_hgrn1(P, l);
            SEAM(pb + 1);
        }
        if (EN(2) && IN(pb + 2)) {
            LAYER_FRAME();
            p_mla_post(P, l);
            p_hgrn2(P);
            { LAS float* bias = (LAS float*)(P.lds + AT_ML + 4096);
              for (int i = P.tid; i < 1024; i += NTHR) { const int h = i >> 7, d = i & 127; int bk = d;
                  if (d >= 16) { bk = 16 + (int)(logf((float)d / 16.f) / 2.0794415416798357f * 16.f); if (bk > 31) bk = 31; }
                  bias[i] = P.in[2][bk * 8 + h] * LOG2E; }
              LDS_WAIT(); __syncthreads();
              const bf16* SVT = (const bf16*)(ws + WS_OVL + OV_SVT);
              for (int un = P.bid; un < 1024; un += P.G) { const int b = un >> 8, h = (un >> 5) & 7, qb = un & 31;
                  AttnU a; a.Q = U + (size_t)(b * SEQ + qb * 128) * UW + C_SQ + h * 64; a.qs = UW; a.K = U + (size_t)(b * SEQ) * UW + C_SK + (h >> 2) * 64; a.ks = UW;
                  a.VT = SVT + (size_t)((b * 2 + (h >> 2)) * 64) * SEQ; a.vts = SEQ; a.O = MIX + (size_t)(b * SEQ + qb * 128) * D + h * 64; a.os = D; a.q0 = qb * 128;
                  a.t_lo = qb > 0 ? 2 * qb - 2 : 0; a.t_hi = 2 * qb + 2; a.dbg = nullptr;
                  attn_unit<64, 64, 2, false>(P.lds, P.tid, a, 0.125f * LOG2E, nullptr, P.in[8][l * 8 + h] * LOG2E, bias + h * 128); }
            }
            SEAM(pb + 2);
        }
        if (EN(3) && IN(pb + 3)) {
            LAYER_FRAME();
            { const bf16* QF = (const bf16*)(ws + WS_OVL + OV_QF); const bf16* KF = (const bf16*)(ws + WS_OVL + OV_KF); const bf16* VT = (const bf16*)(ws + WS_OVL + OV_VT);
              for (int it = P.bid; it < 512; it += P.G) { const int pair = it & 255, bh = pair >> 4, j = pair & 15, qb = it < 256 ? 31 - j : j;
                  AttnU a; a.Q = QF + ((size_t)bh * SEQ + qb * 128) * 192; a.qs = 192; a.K = KF + (size_t)bh * SEQ * 192; a.ks = 192; a.VT = VT + (size_t)bh * 128 * SEQ; a.vts = SEQ;
                  a.O = MIX + ((size_t)(bh >> 2) * SEQ + qb * 128) * D + 1536 + (bh & 3) * 128; a.os = D; a.q0 = qb * 128; a.t_lo = 0; a.t_hi = 2 * qb + 2; a.dbg = nullptr;
                  attn_unit<192, 128, 1, false>(P.lds, P.tid, a, 0.07216878364870322f * LOG2E, nullptr, 0.f, nullptr); } }
#ifndef MK_NOH3
            p_hgrn3(P, l);
#endif
            SEAM(pb + 3);
        }
        if (EN(4) && IN(pb + 4)) {
            LAYER_FRAME();
            pg8::Gemm g{MIX, (const bf16*)(wl + WL_WOUT), D, D}; pg8::StaticOrder S; S.init(NTOK, D, D, D, P.G, P.bid); pg8::EpiResid E{P.out, D};
            pg8::gemm_phase(P.lds, P.tid, g, S, E);
            SEAM(pb + 4);
        }
        if (EN(5) && IN(pb + 5)) {
            LAYER_FRAME();
            const int gw = P.bid * NWAVES + P.wave, NGW = P.G * NWAVES;
            for (int r = gw; r < NTOK; r += NGW) norm_row(P.out + (size_t)r * D, nullptr, HN + (size_t)r * D, P.in[17] + (size_t)l * D, nullptr, nullptr, 0.f, 0.f, P.lane);
            SEAM(pb + 5);
        }
        if (EN(6) && IN(pb + 6)) {
            LAYER_FRAME();
            pg8::Gemm g{HN, (const bf16*)(wl + WL_WMQ), D, D}; pg8::StaticOrder S; S.init(NTOK, 512, D, D, P.G, P.bid); pg8::EpiBf16 E{(bf16*)(ws + WS_MQ), 512};
            pg8::gemm_phase(P.lds, P.tid, g, S, E);
            SEAM(pb + 6);
        }
        if (EN(7) && IN(pb + 7)) {
            LAYER_FRAME();
            const bf16* MQ = (const bf16*)(ws + WS_MQ); bf16* MO = (bf16*)(ws + WS_MO);
            const bf16* MK = (const bf16*)(ws + WS_MK) + (size_t)l * 1024 * 512; const bf16* MVT = (const bf16*)(ws + WS_MVT) + (size_t)l * 1024 * 512;
            for (int un = P.bid; un < 512; un += P.G) { const int b = un >> 7, h = (un >> 5) & 3, qb = un & 31;
                AttnU a; a.Q = MQ + (size_t)(b * SEQ + qb * 128) * 512 + h * 128; a.qs = 512; a.K = MK + (size_t)((b * 4 + h) * 256) * 128; a.ks = 128; a.VT = MVT + (size_t)((b * 4 + h) * 128) * 256; a.vts = 256;
                a.O = MO + (size_t)(b * SEQ + qb * 128) * 512 + h * 128; a.os = 512; a.q0 = 0; a.t_lo = 0; a.t_hi = 4; a.dbg = nullptr;
                attn_unit<128, 128, 0, true>(P.lds, P.tid, a, 0.08838834764831845f * LOG2E, P.in[21] + l * 128, 0.f, nullptr); }
            SEAM(pb + 7);
        }
        if (EN(8) && IN(pb + 8)) {
            LAYER_FRAME();
            pg8::Gemm g{(const bf16*)(ws + WS_MO), (const bf16*)(wl + WL_WMO), 512, 512}; pg8::StaticOrder S; S.init(NTOK, D, 512, 512, P.G, P.bid); pg8::EpiResid E{P.out, D};
            pg8::gemm_phase(P.lds, P.tid, g, S, E);
            SEAM(pb + 8);
        }
        if (EN(9) && IN(pb + 9)) { LAYER_FRAME(); p_router(P, l); SEAM(pb + 9); }
        if (EN(10) && IN(pb + 10)) { LAYER_FRAME(); p_gather(P, l); SEAM(pb + 10); }
        if (EN(11) && IN(pb + 11)) {
            LAYER_FRAME();
            const int nmt = (int)__builtin_amdgcn_readfirstlane(__hip_atomic_load(P.ctl + CW_NMT + l, __ATOMIC_RELAXED, __HIP_MEMORY_SCOPE_AGENT));
            pg8::Gemm g{(const bf16*)(ws + WS_OVL + OV_XG), (const bf16*)(wl + WL_WGU), D, D};
            pg8::GroupedOrder S{P.ctl + CW_MTE + l * 256, P.ctl + CW_MTR + l * 256, nmt, 4, P.G, P.bid, D, D, (size_t)1024 * D * 2};
            pg8::EpiGateUp E{(bf16*)(ws + WS_OVL + OV_HMID), 512};
            pg8::gemm_phase(P.lds, P.tid, g, S, E);
            SEAM(pb + 11);
        }
        if (EN(12) && IN(pb + 12)) {
            LAYER_FRAME();
            const int nmt = (int)__builtin_amdgcn_readfirstlane(__hip_atomic_load(P.ctl + CW_NMT + l, __ATOMIC_RELAXED, __HIP_MEMORY_SCOPE_AGENT));
            pg8::Gemm g{(const bf16*)(ws + WS_OVL + OV_HMID), (const bf16*)(wl + WL_WD), 512, 512};
            pg8::GroupedOrder S{P.ctl + CW_MTE + l * 256, P.ctl + CW_MTR + l * 256, nmt, 8, P.G, P.bid, 512, 512, (size_t)D * 512 * 2};
            pg8::EpiBf16 E{(bf16*)(ws + WS_OVL + OV_YB), D};
            pg8::gemm_phase(P.lds, P.tid, g, S, E);
            SEAM(pb + 12);
        }
        if (EN(13) && IN(pb + 13)) {
            LAYER_FRAME();
            const int gw = P.bid * NWAVES + P.wave, NGW = P.G * NWAVES;
            const int* arow = (const int*)(ws + WS_SMALL + SM_AROW); const float* gate = (const float*)(ws + WS_SMALL + SM_GATE); const bf16* YB = (const bf16*)(ws + WS_OVL + OV_YB);
            for (int r = gw; r < NTOK; r += NGW)
                norm_row(P.out + (size_t)r * D, P.out + (size_t)r * D, l + 1 < DEPTH ? HN + (size_t)r * D : nullptr, P.in[4] + (size_t)(l + 1 < DEPTH ? l + 1 : 0) * D,
                         YB + (size_t)arow[2 * r] * D, YB + (size_t)arow[2 * r + 1] * D, gate[2 * r], gate[2 * r + 1], P.lane);
            SEAM(pb + 13);
        }
    }
#if MK_SANITIZE
    if (IN(N_PHASES)) { PHASE_FRAME(); for (size_t i = (size_t)P.bid * NTHR + P.tid; i < (size_t)NTOK * D; i += (size_t)P.G * NTHR) { float v = P.out[i]; if (!(fabsf(v) < 1e30f)) P.out[i] = 0.f; } }
#endif
#undef IN
#undef SEAM
}

#if MK_DEBUG
constexpr int CW_DBG = 12288;
__device__ __forceinline__ unsigned dh(unsigned x) { x ^= x >> 16; x *= 0x7feb352du; x ^= x >> 15; x *= 0x846ca68bu; x ^= x >> 16; return x; }
__device__ __forceinline__ void dbg_put(unsigned* ctl, int k, float got, float want, float scale) {
    float e = fabsf(got - want) / (fabsf(want) + scale); if (!(e == e) || !(fabsf(got) < 1e30f)) e = 1e9f;
    atomicMax(ctl + CW_DBG + k, __builtin_bit_cast(unsigned, e));
}
__device__ double dcos2pi(double fr, bool want_sin) {
    double th = (fr - 0.5) * 6.283185307179586;
    double t2 = th * th, c = 1.0, s = th, tc = 1.0, ts = th;
    for (int n = 1; n < 16; ++n) { tc *= -t2 / ((2.0 * n - 1.0) * (2.0 * n)); c += tc; ts *= -t2 / ((2.0 * n) * (2.0 * n + 1.0)); s += ts; }
    return want_sin ? -s : -c;
}
__global__ void __launch_bounds__(256) dbg_kernel(Args args, int stage, int l) {
    const float* const* in = args.in; unsigned char* ws = args.ws; unsigned* ctl = (unsigned*)(ws + WS_CTL);
    const int gid = blockIdx.x * 256 + threadIdx.x, NT = gridDim.x * 256;
    unsigned char* wl = ws + WS_W + (size_t)l * WL_END;
    const bf16* HN = (const bf16*)(ws + WS_HN); const bf16* U = (const bf16*)(ws + WS_OVL + OV_U); const bf16* MIX = (const bf16*)(ws + WS_OVL + OV_MIX);
    const bf16* WIN = (const bf16*)(wl + WL_WIN);
    if (stage == 1) {
        for (int s = gid; s < 8192; s += NT) { const unsigned h = dh(s * 2654435761u + 12345u);
            { const int n = h % INW, k = (h >> 13) % D; dbg_put(ctl, 1, bf2f(WIN[(size_t)n * D + k]), in[5][((size_t)l * D + k) * INW + n], 1e-3f); }
            { const int n = INW + h % (UW - INW), k = (h >> 13) % D; dbg_put(ctl, 1, bf2f(WIN[(size_t)n * D + k]), 0.f, 1e-3f); }
            { const int n = h % 768, k = (h >> 13) % 512; dbg_put(ctl, 1, bf2f(((const bf16*)(wl + WL_WUQ))[(size_t)n * 512 + k]), in[12][((size_t)l * 512 + k) * 768 + n] * in[10][l * 512 + k], 1e-3f); }
            { const int n = h % 1024, k = (h >> 13) % 256; dbg_put(ctl, 1, bf2f(((const bf16*)(wl + WL_WUKV))[(size_t)n * 256 + k]), in[13][((size_t)l * 256 + k) * 1024 + n] * in[11][l * 256 + k], 1e-3f); }
            { const int n = h % D, k = (h >> 13) % D; dbg_put(ctl, 1, bf2f(((const bf16*)(wl + WL_WOUT))[(size_t)n * D + k]), in[16][((size_t)l * D + k) * D + n], 1e-3f); }
            { const int n = h % 512, k = (h >> 13) % D; dbg_put(ctl, 1, bf2f(((const bf16*)(wl + WL_WMQ))[(size_t)n * D + k]), in[19][((size_t)l * D + k) * 512 + n], 1e-3f); }
            { const int n = h % 1024, k = (h >> 13) % D; dbg_put(ctl, 1, bf2f(((const bf16*)(wl + WL_WMKV))[(size_t)n * D + k]), in[20][((size_t)l * D + k) * 1024 + n], 1e-3f); }
            { const int n = h % D, k = (h >> 13) % 512; dbg_put(ctl, 1, bf2f(((const bf16*)(wl + WL_WMO))[(size_t)n * 512 + k]), in[23][((size_t)l * 512 + k) * D + n], 1e-3f); }
            { const int e = (h >> 3) % NEXP, n = h % DEXP, k = (h >> 13) % D; const bf16* gu = (const bf16*)(wl + WL_WGU) + (size_t)e * 1024 * D;
              dbg_put(ctl, 1, bf2f(gu[(size_t)((n >> 7) * 256 + (n & 127)) * D + k]), in[29][(((size_t)l * NEXP + e) * D + k) * DEXP + n], 1e-3f);
              dbg_put(ctl, 1, bf2f(gu[(size_t)((n >> 7) * 256 + 128 + (n & 127)) * D + k]), in[30][(((size_t)l * NEXP + e) * D + k) * DEXP + n], 1e-3f); }
            { const int e = (h >> 3) % NEXP, n = h % D, k = (h >> 13) % DEXP; dbg_put(ctl, 1, bf2f(((const bf16*)(wl + WL_WD))[((size_t)e * D + n) * DEXP + k]), in[31][(((size_t)l * NEXP + e) * DEXP + k) * D + n], 1e-3f); }
        }
    }
    if (stage == 2) {
        for (int s = gid; s < 512; s += NT) { const unsigned h = dh(s * 977u + 7u); const int r = (s < 4) ? (s & 1 ? NTOK - 1 : 0) : h % NTOK, c = (h >> 15) % D;
            const float* xr = in[0] + (size_t)r * D; float ss = 0.f; for (int k = 0; k < D; ++k) ss += xr[k] * xr[k];
            dbg_put(ctl, 2, bf2f(HN[(size_t)r * D + c]), xr[c] * rsqrtf(ss / D + EPS) * in[4][c], 1e-2f); dbg_put(ctl, 2, args.out[(size_t)r * D + c], xr[c], 1e-6f); }
    }
    if (stage == 3) {
        for (int s = gid; s < 4096; s += NT) { const unsigned h = dh(s * 31u + 99u); const int r = (s < 64) ? ((s & 1) ? NTOK - 1 - (s >> 1) : (s >> 1)) : h % NTOK; const int n = (s & 2) ? (UW - 1 - (h >> 14) % 512) : (h >> 14) % UW;
            float a = 0.f; for (int k = 0; k < D; ++k) a += bf2f(HN[(size_t)r * D + k]) * bf2f(WIN[(size_t)n * D + k]);
            dbg_put(ctl, 3, bf2f(U[(size_t)r * UW + n]), a, 0.05f); }
    }
    if (stage == 4) {
        const bf16* QM = (const bf16*)(ws + WS_OVL + OV_QM); const bf16* KVM = (const bf16*)(ws + WS_OVL + OV_KVM);
        for (int s = gid; s < 4096; s += NT) { const unsigned h = dh(s * 131u + 5u); const int r = h % NTOK;
            { const int n = (h >> 14) % 768; float a = 0.f; for (int k = 0; k < 512; ++k) a += bf2f(U[(size_t)r * UW + C_CQ + k]) * bf2f(((const bf16*)(wl + WL_WUQ))[(size_t)n * 512 + k]); dbg_put(ctl, 4, bf2f(QM[(size_t)r * 768 + n]), a, 0.05f); }
            { const int n = (h >> 14) % 1024; float a = 0.f; for (int k = 0; k < 256; ++k) a += bf2f(U[(size_t)r * UW + C_CKV + k]) * bf2f(((const bf16*)(wl + WL_WUKV))[(size_t)n * 256 + k]); dbg_put(ctl, 5, bf2f(KVM[(size_t)r * 1024 + n]), a, 0.05f); } }
    }
    if (stage == 6) {
        const float* rcq = (const float*)(ws + WS_SMALL + SM_RSTDCQ); const float* rckv = (const float*)(ws + WS_SMALL + SM_RSTDCKV); const bf16* SVT = (const bf16*)(ws + WS_OVL + OV_SVT);
        for (int s = gid; s < 256; s += NT) { const unsigned h = dh(s * 733u + 3u); const int r = h % NTOK, hd = (h >> 14) % 10, d = (h >> 20) % 64;
            const int c0 = hd < 8 ? C_SQ + hd * 64 : C_SK + (hd - 8) * 64; float ss = 0.f, mine = 0.f;
            for (int j = 0; j < 64; ++j) { float a = 0.f; for (int k = 0; k < D; ++k) a += bf2f(HN[(size_t)r * D + k]) * bf2f(WIN[(size_t)(c0 + j) * D + k]); a = bf2f(f2bf(a)); ss += a * a; if (j == d) mine = a; }
            dbg_put(ctl, 6, bf2f(U[(size_t)r * UW + c0 + d]), mine * rsqrtf(ss / 64 + EPS) * (hd < 8 ? in[6][l * 64 + d] : in[7][l * 64 + d]), 0.03f);
            float s1 = 0.f; for (int k = 0; k < 512; ++k) { const float a = bf2f(U[(size_t)r * UW + C_CQ + k]); s1 += a * a; } dbg_put(ctl, 6, rcq[r], rsqrtf(s1 / 512 + EPS), 1e-3f);
            float s2 = 0.f; for (int k = 0; k < 256; ++k) { const float a = bf2f(U[(size_t)r * UW + C_CKV + k]); s2 += a * a; } dbg_put(ctl, 6, rckv[r], rsqrtf(s2 / 256 + EPS), 1e-3f);
            const int b = r >> 12, sp = r & 4095, cc = (h >> 9) % 128; dbg_put(ctl, 7, bf2f(SVT[((size_t)b * 128 + cc) * SEQ + sp]), bf2f(U[(size_t)r * UW + C_SV + cc]), 1e-6f); }
    }
    if (stage == 8) {
        const bf16* QM = (const bf16*)(ws + WS_OVL + OV_QM); const bf16* KVM = (const bf16*)(ws + WS_OVL + OV_KVM); const bf16* QF = (const bf16*)(ws + WS_OVL + OV_QF); const bf16* KF = (const bf16*)(ws + WS_OVL + OV_KF); const bf16* VT = (const bf16*)(ws + WS_OVL + OV_VT);
        const float* rcq = (const float*)(ws + WS_SMALL + SM_RSTDCQ); const float* rckv = (const float*)(ws + WS_SMALL + SM_RSTDCKV);
        for (int s = gid; s < 2048; s += NT) { const unsigned h = dh(s * 3571u + 11u); const int r = h % NTOK, hh = (h >> 14) & 3, d = (h >> 16) % 192, b = r >> 12, sp = r & 4095;
            for (int which = 0; which < 2; ++which) {
                float ss = 0.f;
                for (int j = 0; j < 192; ++j) { float a; if (which == 0) a = bf2f(QM[(size_t)r * 768 + hh * 192 + j]) * rcq[r]; else a = j < 128 ? bf2f(KVM[(size_t)r * 1024 + hh * 256 + j]) * rckv[r] : bf2f(U[(size_t)r * UW + C_KR + j - 128]); ss += a * a; }
                const float rstd = rsqrtf(ss / 192 + EPS); const float* gg = which == 0 ? in[14] + l * 192 : in[15] + l * 192;
                auto el = [&](int j) { float a; if (which == 0) a = bf2f(QM[(size_t)r * 768 + hh * 192 + j]) * rcq[r]; else a = j < 128 ? bf2f(KVM[(size_t)r * 1024 + hh * 256 + j]) * rckv[r] : bf2f(U[(size_t)r * UW + C_KR + j - 128]); return a * rstd * gg[j]; };
                float want;
                if (d < 128) want = el(d);
                else { const int i = (d - 128) & 31; const float inv = powf(10000.f, -(float)i / 32.f); const float ang = (float)sp * inv; const double rev = (double)ang * 0.15915494309189535, fr = rev - floor(rev);
                    const float c = (float)dcos2pi(fr, false), sn = (float)dcos2pi(fr, true); const float x1 = el(128 + i), x2 = el(160 + i); want = d < 160 ? x1 * c - x2 * sn : x1 * sn + x2 * c; }
                dbg_put(ctl, 8 + which, bf2f((which == 0 ? QF : KF)[((size_t)(b * 4 + hh) * SEQ + sp) * 192 + d]), want, 0.03f);
            }
            const int dv = d & 127; dbg_put(ctl, 10, bf2f(VT[((size_t)(b * 4 + hh) * 128 + dv) * SEQ + sp]), bf2f(KVM[(size_t)r * 1024 + hh * 256 + 128 + dv]) * rckv[r], 0.01f); }
    }
    if (stage == 11) {
        for (int s = gid; s < 1024; s += NT) { const unsigned h = dh((s >> 4) * 7919u + 13u); const int cls = (s >> 4) % 3; const int r = cls == 0 ? (h % 4) * 4096 + (h >> 5) % 32 : cls == 1 ? (h % 4) * 4096 + 32 + (h >> 5) % 96 : h % NTOK, hq = (h >> 14) & 7, d = ((h >> 17) & 48) + (s & 15), b = r >> 12, t = r & 4095, hkv = hq >> 2;
            const float sink = in[8][l * 8 + hq]; float mx = sink;
            const int s_lo = t - 127 > 0 ? t - 127 : 0;
            for (int pass = 0; pass < 2; ++pass) { float den = 0.f, num = 0.f;
                for (int sk = s_lo; sk <= t; ++sk) { float sc = 0.f; for (int j = 0; j < 64; ++j) sc += bf2f(U[(size_t)r * UW + C_SQ + hq * 64 + j]) * bf2f(U[(size_t)(b * SEQ + sk) * UW + C_SK + hkv * 64 + j]);
                    const int dist = t - sk; int bk = dist; if (dist >= 16) { bk = 16 + (int)(logf((float)dist / 16.f) / 2.0794415416798357f * 16.f); if (bk > 31) bk = 31; }
                    sc = sc * 0.125f + in[2][bk * 8 + hq];
                    if (pass == 0) mx = fmaxf(mx, sc); else { const float p = expf(sc - mx); den += p; num += p * bf2f(U[(size_t)(b * SEQ + sk) * UW + C_SV + hkv * 64 + d]); } }
                if (pass == 1) { den += expf(sink - mx); dbg_put(ctl, 11, bf2f(MIX[(size_t)r * D + hq * 64 + d]), num / den, 0.2f); dbg_put(ctl, t < 32 ? 16 : t < 128 ? 17 : 18, bf2f(MIX[(size_t)r * D + hq * 64 + d]), num / den, 0.2f); } } }
    }
    if (stage == 12) {
        const bf16* QF = (const bf16*)(ws + WS_OVL + OV_QF); const bf16* KF = (const bf16*)(ws + WS_OVL + OV_KF); const bf16* VT = (const bf16*)(ws + WS_OVL + OV_VT);
        for (int s = gid; s < 512; s += NT) { const unsigned h = dh((s >> 3) * 104729u + 17u); const int cls = (s >> 3) % 4; const int r = cls == 0 ? (h % 4) * 4096 + (h >> 5) % 128 : cls == 1 ? (h % 4) * 4096 + 3968 + (h >> 5) % 128 : cls == 2 ? (h % 4) * 4096 + 128 + (h >> 5) % 128 : h % NTOK, hh = (h >> 14) & 3, d = ((h >> 16) & 120) + (s & 7), b = r >> 12, t = r & 4095;
            const bf16* q = QF + ((size_t)(b * 4 + hh) * SEQ + t) * 192; float mx = -1e30f;
            for (int pass = 0; pass < 2; ++pass) { float den = 0.f, num = 0.f;
                for (int sk = 0; sk <= t; ++sk) { const bf16* kk = KF + ((size_t)(b * 4 + hh) * SEQ + sk) * 192; float sc = 0.f; for (int j = 0; j < 192; ++j) sc += bf2f(q[j]) * bf2f(kk[j]); sc *= 0.07216878364870322f;
                    if (pass == 0) mx = fmaxf(mx, sc); else { const float p = expf(sc - mx); den += p; num += p * bf2f(VT[((size_t)(b * 4 + hh) * 128 + d) * SEQ + sk]); } }
                if (pass == 1) { dbg_put(ctl, 12, bf2f(MIX[(size_t)r * D + 1536 + hh * 128 + d]), num / den, 0.1f); dbg_put(ctl, t < 128 ? 19 : t >= 3968 ? 20 : t < 256 ? 21 : 22, bf2f(MIX[(size_t)r * D + 1536 + hh * 128 + d]), num / den, 0.1f); } } }
    }
    if (stage == 24) {
        const bf16* QF = (const bf16*)(ws + WS_OVL + OV_QF); const bf16* KF = (const bf16*)(ws + WS_OVL + OV_KF); const bf16* VT = (const bf16*)(ws + WS_OVL + OV_VT); const float* DB = (const float*)(ws + WS_MQ);
        const float sc2 = 0.07216878364870322f * LOG2E;
        for (int tl = gid; tl < 512; tl += NT) { const int wid = tl >> 6, lane = tl & 63, r32 = lane & 31, hi = lane >> 5, g = wid & 3, kh = wid >> 2, q = 32 * g + r32;
            float sv[32]; float mx = -1e30f;
            for (int kk = 0; kk < 32; ++kk) { const int key = 32 * kh + kk; float a = 0.f; for (int j = 0; j < 192; ++j) a += bf2f(QF[(size_t)q * 192 + j]) * bf2f(KF[(size_t)key * 192 + j]); a *= sc2; mx = fmaxf(mx, a);
                for (int r = 0; r < 16; ++r) if (crow(r, hi) == kk) dbg_put(ctl, 24, DB[(wid * 64 + lane) * 16 + r], a, 0.5f); }
            float l = 0.f; for (int kk = 0; kk < 32; ++kk) { const int key = 32 * kh + kk; float a = 0.f; for (int j = 0; j < 192; ++j) a += bf2f(QF[(size_t)q * 192 + j]) * bf2f(KF[(size_t)key * 192 + j]); a *= sc2; l += exp2f(a - mx); }
            dbg_put(ctl, 25, DB[8192 + (wid * 64 + lane) * 2], mx, 0.5f); dbg_put(ctl, 26, DB[8192 + (wid * 64 + lane) * 2 + 1], l, 0.5f);
            for (int i = 0; i < 4; ++i) for (int r = 0; r < 16; r += 5) { const int qq = 32 * g + crow(r, hi), d = 32 * i + r32; float m2 = -1e30f, acc = 0.f;
                for (int pass = 0; pass < 2; ++pass) for (int kk = 0; kk < 32; ++kk) { const int key = 32 * kh + kk; float a = 0.f; for (int j = 0; j < 192; ++j) a += bf2f(QF[(size_t)qq * 192 + j]) * bf2f(KF[(size_t)key * 192 + j]); a *= sc2;
                    if (pass == 0) m2 = fmaxf(m2, a); else acc += exp2f(a - m2) * bf2f(VT[(size_t)d * SEQ + key]); }
                dbg_put(ctl, 27, DB[16384 + ((wid * 64 + lane) * 4 + i) * 16 + r], acc, 0.3f); }
            (void)sv; }
    }
    if (stage == 13) {
        __shared__ float so[128]; const float* lb = (const float*)(ws + WS_SMALL + SM_LB) + l * 1024;
        for (int smp = blockIdx.x; smp < 64; smp += gridDim.x) { const unsigned h = dh(smp * 15485863u + 19u); const int r = smp < 4 ? ((smp & 1) ? 4096 + 63 + (smp >> 1) * 64 : (smp >> 1) * 70) : h % NTOK, hh = (h >> 14) & 7, b = r >> 12, t = r & 4095; const int v = threadIdx.x & 127;
            float o = 0.f;
            if (threadIdx.x < 128) {
                for (int k = 0; k < 128; ++k) { const float lbv = lb[hh * 128 + k]; const float q = bf2f(U[(size_t)r * UW + C_HQ + hh * 128 + k]); float dcy = 1.f, acc = 0.f;
                    for (int sk = t; sk >= 0 && dcy > 1e-12f; --sk) { const size_t rr = (size_t)(b * SEQ + sk) * UW; const float f = bf2f(U[rr + C_HF + hh * 128 + k]); const float sig = 1.f / (1.f + expf(-f)); const float fv = lbv + (1.f - lbv) * sig;
                        acc += dcy * (1.f - lbv) * (1.f - sig) * bf2f(U[rr + C_HI + hh * 128 + v]); dcy *= fv; }
                    o += q * acc; }
                so[v] = o; }
            __syncthreads();
            if (threadIdx.x < 128) { float ss = 0.f; for (int j = 0; j < 128; ++j) ss += so[j] * so[j]; const float gv = bf2f(U[(size_t)r * UW + C_HG + hh * 128 + v]);
                dbg_put(ctl, 13, bf2f(MIX[(size_t)r * D + 512 + hh * 128 + v]), o * rsqrtf(ss / 128 + EPS) * in[9][l * 128 + v] * gv / (1.f + expf(-gv)), 0.3f); }
            __syncthreads(); }
    }
    if (stage == 14) {
        for (int s = gid; s < 2048; s += NT) { const unsigned h = dh(s * 193u + 23u); const int r = h % NTOK, c = (h >> 14) % D; float a = in[0][(size_t)r * D + c];
            for (int k = 0; k < D; ++k) a += bf2f(MIX[(size_t)r * D + k]) * bf2f(((const bf16*)(wl + WL_WOUT))[(size_t)c * D + k]);
            dbg_put(ctl, 14, args.out[(size_t)r * D + c], a, 1.0f); }
    }
}
__global__ void dbg_final(Args args, float tol, int first, int count) {
    const unsigned* ctl = (const unsigned*)(args.ws + WS_CTL); float c = 1.f; int mask = 0;
    if (count > 0) { for (int k = 0; k < count; ++k) { const float e = __builtin_bit_cast(float, ctl[CW_DBG + first + k]); if (e > tol) mask |= 1 << k; } }
    else { for (int k = 0; k < -count; ++k) { const float e = __builtin_bit_cast(float, ctl[CW_DBG + first + k]);
        const int lv = e <= 0.05f ? 0 : e <= 0.2f ? 1 : e <= 1.f ? 2 : e <= 5.f ? 3 : e <= 100.f ? 4 : e <= 1e6f ? 5 : e < 1e9f ? 6 : 7; mask |= lv << (3 * k); } }
    if (mask) c = 2.f + 0.5f * mask;
    for (size_t i = (size_t)blockIdx.x * 256 + threadIdx.x; i < (size_t)NTOK * D; i += (size_t)gridDim.x * 256) args.out[i] = c * args.in[0][i];
}
#endif

extern "C" void kernel_launch(void* const* d_in, const int* in_sizes, int n_in, void* d_out, int out_size, void* d_ws, size_t ws_size, hipStream_t stream) {
    static int grid = 0;
    if (grid == 0) {
        if (n_in != 32 || out_size != NTOK * D || ws_size < WS_END) { fprintf(stderr, "kernel_launch: unexpected shapes (n_in %d out %d ws %zu need %zu)\n", n_in, out_size, ws_size, (size_t)WS_END); grid = -1; return; }
        int dev = 0, cus = 0, per_cu = 0;
        if (hipGetDevice(&dev) != hipSuccess || hipDeviceGetAttribute(&cus, hipDeviceAttributeMultiprocessorCount, dev) != hipSuccess) { grid = -1; return; }
        if (hipFuncSetAttribute((const void*)mk_fwd, hipFuncAttributeMaxDynamicSharedMemorySize, LDS_BYTES) != hipSuccess) { fprintf(stderr, "kernel_launch: hipFuncSetAttribute failed\n"); grid = -1; return; }
        if (hipOccupancyMaxActiveBlocksPerMultiprocessor(&per_cu, (const void*)mk_fwd, NTHR, LDS_BYTES) != hipSuccess || per_cu < 1) { fprintf(stderr, "kernel_launch: occupancy query says %d\n", per_cu); (void)hipGetLastError(); }
        grid = cus;
    }
    if (grid < 0) return;
    (void)hipMemsetAsync((char*)d_ws + WS_CTL, 0, CTL_BYTES, stream);
    Args a{};
    for (int i = 0; i < 32; ++i) a.in[i] = (const float*)d_in[i];
    a.out = (float*)d_out; a.ws = (unsigned char*)d_ws;
#if MK_ONE_LAUNCH
    a.ph_lo = 0; a.ph_hi = N_PHASES + MK_SANITIZE;
    hipLaunchKernelGGL(mk_fwd, dim3(grid), dim3(NTHR), LDS_BYTES, stream, a);
#else
    for (int p = 0; p < N_PHASES + MK_SANITIZE; ++p) { a.ph_lo = p; a.ph_hi = p + 1; hipLaunchKernelGGL(mk_fwd, dim3(grid), dim3(NTHR), LDS_BYTES, stream, a);
#if MK_DEBUG
        const int pb0 = PH_BASE;
        if (p == 0) { hipLaunchKernelGGL(dbg_kernel, dim3(64), dim3(256), 0, stream, a, 1, 0); hipLaunchKernelGGL(dbg_kernel, dim3(64), dim3(256), 0, stream, a, 2, 0); }
        if (p == pb0 + 0) hipLaunchKernelGGL(dbg_kernel, dim3(64), dim3(256), 0, stream, a, 3, 0);
        if (p == pb0 + 1) { hipLaunchKernelGGL(dbg_kernel, dim3(64), dim3(256), 0, stream, a, 4, 0); hipLaunchKernelGGL(dbg_kernel, dim3(64), dim3(256), 0, stream, a, 6, 0); }
        if (p == pb0 + 2) { hipLaunchKernelGGL(dbg_kernel, dim3(64), dim3(256), 0, stream, a, 8, 0); hipLaunchKernelGGL(dbg_kernel, dim3(64), dim3(256), 0, stream, a, 11, 0); }
        if (p == pb0 + 3) { hipLaunchKernelGGL(dbg_kernel, dim3(64), dim3(256), 0, stream, a, 12, 0); hipLaunchKernelGGL(dbg_kernel, dim3(64), dim3(256), 0, stream, a, 13, 0); }
        if (p == pb0 + 4) { hipLaunchKernelGGL(dbg_kernel, dim3(64), dim3(256), 0, stream, a, 14, 0); hipLaunchKernelGGL(dbg_final, dim3(1024), dim3(256), 0, stream, a, 0.05f, 11, 4); break; }
#endif
    }
#endif
}
```

```cpp
#include <hip/hip_runtime.h>
#include <cstdio>
#include <cstdint>

#ifndef MK_DEBUG
#define MK_DEBUG 0
#endif
#ifndef MK_STAMP
#define MK_STAMP 0
#endif
#ifndef MK_STAMP_A
#define MK_STAMP_A 0
#define MK_STAMP_B 1
#endif
#ifndef MK_DUP
#define MK_DUP 0
#endif
#define DUP(g) for (int dup_ = 0; dup_ < 1 + ((MK_DUP >> (g)) & 1); ++dup_)
#ifndef MK_SANITIZE
#define MK_SANITIZE 0
#endif
#ifndef MK_ONE_LAUNCH
#define MK_ONE_LAUNCH 1
#endif

#define GAS __attribute__((address_space(1)))
#define LAS __attribute__((address_space(3)))
typedef unsigned short bf16;
typedef short bf16x8 __attribute__((ext_vector_type(8)));
typedef float f32x4 __attribute__((ext_vector_type(4)));
typedef float f32x16 __attribute__((ext_vector_type(16)));
typedef unsigned u32x4 __attribute__((ext_vector_type(4)));
typedef unsigned u32x2 __attribute__((ext_vector_type(2)));

constexpr int D = 2048, NB = 4, SEQ = 4096, NTOK = NB * SEQ, DEPTH = 2;
constexpr int UW = 5888;
constexpr int C_SQ = 0, C_SK = 512, C_SV = 640, C_HQ = 768, C_HF = 1792, C_HI = 2816, C_HG = 3840, C_CQ = 4864, C_CKV = 5376, C_KR = 5632, INW = 5696;
constexpr int NEXP = 64, DEXP = 512, MAXROWS = 49152;
constexpr float EPS = 1e-6f;
constexpr float LOG2E = 1.4426950408889634f;

constexpr size_t MiB = 1u << 20;
constexpr size_t WS_CTL = 0, CTL_BYTES = 1 * MiB;
constexpr size_t SZ_WIN = (size_t)UW * D * 2, SZ_WUQ = 768 * 512 * 2, SZ_WUKV = 1024 * 256 * 2, SZ_WOUT = (size_t)D * D * 2, SZ_WMQ = 512 * (size_t)D * 2,
                 SZ_WMKV = 1024 * (size_t)D * 2, SZ_WMO = (size_t)D * 512 * 2, SZ_WGU = (size_t)NEXP * 1024 * D * 2, SZ_WD = (size_t)NEXP * D * 512 * 2;
constexpr size_t WL_WIN = 0, WL_WUQ = WL_WIN + SZ_WIN, WL_WUKV = WL_WUQ + SZ_WUQ, WL_WOUT = WL_WUKV + SZ_WUKV, WL_WMQ = WL_WOUT + SZ_WOUT, WL_WMKV = WL_WMQ + SZ_WMQ,
                 WL_WMO = WL_WMKV + SZ_WMKV, WL_WGU = WL_WMO + SZ_WMO, WL_WD = WL_WGU + SZ_WGU, WL_END = WL_WD + SZ_WD;
constexpr size_t WS_W = 1 * MiB;
constexpr size_t WS_PERS = WS_W + 2 * WL_END;
constexpr size_t WS_HN = WS_PERS;
constexpr size_t WS_MEMN = WS_HN + (size_t)NTOK * D * 2;
constexpr size_t WS_MKV = WS_MEMN + 2 * 1024 * (size_t)D * 2;
constexpr size_t WS_MK = WS_MKV + 2 * 1024 * 1024 * 2;
constexpr size_t WS_MVT = WS_MK + 2 * 1024 * 512 * 2;
constexpr size_t WS_ROPE = WS_MVT + 2 * 1024 * 512 * 2;
constexpr size_t WS_MQ = WS_ROPE + 4096 * 32 * 8;
constexpr size_t WS_MO = WS_MQ + (size_t)NTOK * 512 * 2;
constexpr size_t WS_SMALL = WS_MO + (size_t)NTOK * 512 * 2;
constexpr size_t SM_RSTDCQ = 0, SM_RSTDCKV = SM_RSTDCQ + NTOK * 4, SM_RSTDFFN = SM_RSTDCKV + NTOK * 4, SM_EIDX = SM_RSTDFFN + NTOK * 4, SM_GATE = SM_EIDX + NTOK * 8,
                 SM_SLOT = SM_GATE + NTOK * 8, SM_AROW = SM_SLOT + NTOK * 8, SM_LB = SM_AROW + NTOK * 8, SM_ROWTOK = SM_LB + 2 * 1024 * 4, SM_ROWSS = (SM_ROWTOK + (size_t)MAXROWS * 4 + 15) / 16 * 16, SM_RS = SM_ROWSS + (size_t)NTOK * 32 * 4, SM_RW = SM_RS + NTOK * 4, SM_END = SM_RW + (size_t)2 * 2 * 80 * D * 2;
constexpr size_t WS_OVL = (WS_SMALL + SM_END + 4095) / 4096 * 4096;
constexpr size_t OV_U = 0;
constexpr size_t OV_QM = OV_U + (size_t)NTOK * UW * 2;
constexpr size_t OV_KVM = OV_QM + (size_t)NTOK * 768 * 2;
constexpr size_t OV_QF = OV_KVM + (size_t)NTOK * 1024 * 2;
constexpr size_t OV_KF = OV_QF + (size_t)NTOK * 768 * 2;
constexpr size_t OV_VT = OV_KF + (size_t)NTOK * 768 * 2;
constexpr size_t OV_SVT = OV_VT + (size_t)NTOK * 512 * 2;
constexpr size_t OV_QT = OV_SVT + (size_t)NTOK * 128 * 2;
constexpr size_t OV_INTRA = OV_QT + (size_t)NTOK * 1024 * 2;
constexpr size_t OV_UT = OV_INTRA + (size_t)NTOK * 1024 * 2;
constexpr size_t OV_DEC = OV_UT + (size_t)2048 * 128 * 128 * 2;
constexpr size_t OV_MIX = OV_DEC + 2048 * 128 * 4;
constexpr size_t OV_MIXEND = OV_MIX + (size_t)NTOK * D * 2;
constexpr size_t OV_XG = 0;
constexpr size_t OV_HMID = OV_XG + (size_t)MAXROWS * D * 2;
constexpr size_t OV_YB = OV_HMID + (size_t)MAXROWS * 512 * 2;
constexpr size_t OV_MOEEND = OV_YB + (size_t)MAXROWS * D * 2;
constexpr size_t WS_END = WS_OVL + (OV_MIXEND > OV_MOEEND ? OV_MIXEND : OV_MOEEND);
static_assert(WS_END <= (size_t)2048 * MiB, "workspace map must fit 2 GiB");
constexpr int CW_BAR = 4096;
constexpr int CW_CNT = 32768;
constexpr int CW_NMT = 8192 + 128;
constexpr int CW_MTE = 8192 + 256;
constexpr int CW_MTR = 8192 + 768;
constexpr int CW_STAMPS = 14336;

constexpr int LDS_WORK = 131072;
constexpr int MISC_OFF = LDS_WORK;
constexpr int LDS_BYTES = 147456;
constexpr int NWAVES = 8, NTHR = 512;
constexpr int MT_OFF = 0, MT_CN = 80, MT_E = 160, MT_R = 416, MT_B = 672, MT_N = 928, MT_WORDS = 1184, MT_LDS = MISC_OFF + 2048;
constexpr size_t RS2_OFF = (size_t)8 << 20;
constexpr int RT_CAP = 16384;

#define LDS_WAIT() asm volatile("s_waitcnt lgkmcnt(0)" ::: "memory")
#define VM_WAIT() asm volatile("s_waitcnt vmcnt(0)" ::: "memory")
#define BAR_LDS() do { asm volatile("s_waitcnt lgkmcnt(0)" ::: "memory"); __builtin_amdgcn_s_barrier(); asm volatile("" ::: "memory"); } while (0)
#define SBAR() __builtin_amdgcn_sched_barrier(0)
__device__ __forceinline__ unsigned f2bf(float f) { unsigned u = __builtin_bit_cast(unsigned, f); return (u + 0x7fffu + ((u >> 16) & 1u)) >> 16; }
__device__ __forceinline__ unsigned pk2(float lo, float hi) { return f2bf(lo) | (f2bf(hi) << 16); }
__device__ __forceinline__ float bf2f(unsigned b) { return __builtin_bit_cast(float, b << 16); }
__device__ __forceinline__ float bflo(unsigned w) { return __builtin_bit_cast(float, w << 16); }
__device__ __forceinline__ float bfhi(unsigned w) { return __builtin_bit_cast(float, w & 0xffff0000u); }
__device__ __forceinline__ unsigned cvtpk(float lo, float hi) { unsigned r; asm volatile("v_cvt_pk_bf16_f32 %0, %1, %2" : "=v"(r) : "v"(lo), "v"(hi)); return r; }
__device__ __forceinline__ float ex2(float x) { return __builtin_amdgcn_exp2f(x); }
__device__ __forceinline__ float fexp(float x) { return __builtin_amdgcn_exp2f(x * LOG2E); }
__device__ __forceinline__ float flog(float x) { return __builtin_amdgcn_logf(x) * 0.6931471805599453f; }
__device__ __forceinline__ float wave_sum(float v) {
#pragma unroll
    for (int o = 1; o < 64; o <<= 1) v += __shfl_xor(v, o);
    return v;
}
__device__ __forceinline__ int crow(int r, int hi) { return (r & 3) + 8 * (r >> 2) + 4 * hi; }
#define PK4(P, B_, OUT) do { unsigned a0_ = cvtpk(P[B_ + 0], P[B_ + 1]), a1_ = cvtpk(P[B_ + 2], P[B_ + 3]), b0_ = cvtpk(P[B_ + 4], P[B_ + 5]), b1_ = cvtpk(P[B_ + 6], P[B_ + 7]); \
        auto r0_ = __builtin_amdgcn_permlane32_swap(a0_, b0_, false, false); auto r1_ = __builtin_amdgcn_permlane32_swap(a1_, b1_, false, false); \
        u32x4 w_ = {r0_[0], r1_[0], r0_[1], r1_[1]}; OUT = __builtin_bit_cast(bf16x8, w_); } while (0)
__device__ __forceinline__ float swap_max(float v) { return fmaxf(v, __shfl_xor(v, 32)); }
__device__ __forceinline__ float swap_sum(float v) { return v + __shfl_xor(v, 32); }

#define XB_TMO      128
#define XB_XCNT(j)  (256  + 64 * (j))
#define XB_XSUB(j)  (1280 + 64 * (j))
#define XB_XGEN(j)  (2304 + 64 * (j))
#define XB_TOP      3328
#define XB_TOPGEN   3392
#define XCD_BAR_WORDS 3456
#define XB_SPIN_CAP (1u << 22)
__device__ __forceinline__ unsigned xb_ld(unsigned* p)              { return __hip_atomic_load(p, __ATOMIC_RELAXED, __HIP_MEMORY_SCOPE_AGENT); }
__device__ __forceinline__ unsigned xb_add(unsigned* p, unsigned v) { return __hip_atomic_fetch_add(p, v, __ATOMIC_RELAXED, __HIP_MEMORY_SCOPE_AGENT); }
__device__ __forceinline__ unsigned xb_xcc_id() { return (unsigned)__builtin_amdgcn_s_getreg((3 << 11) | 20) & 0xFu; }
#define XB_SPIN(cond, bar) do { unsigned _sp = 0; while (cond) { __builtin_amdgcn_s_sleep(1); \
    if ((++_sp & 255u) == 0u) { if (xb_ld(&(bar)[XB_TMO])) break; if (_sp > XB_SPIN_CAP) { atomicAdd(&(bar)[XB_TMO], 1u); break; } } } } while (0)
struct XcdBarrier { unsigned* bar; unsigned x; volatile LAS unsigned* st; };
__device__ __forceinline__ XcdBarrier xcd_barrier_post(unsigned* bar, volatile LAS unsigned* st) {
    XcdBarrier b; b.bar = bar; b.x = xb_xcc_id(); b.st = st;
    if (threadIdx.x == 0) (void)xb_add(&bar[XB_XCNT(b.x)], 1u);
    return b;
}
__device__ __forceinline__ void xcd_barrier_complete(unsigned* bar, unsigned x, unsigned& nloc, unsigned& nx) {
    const unsigned G = gridDim.x * gridDim.y * gridDim.z;
    unsigned sum, cnt, mine, sp = 0u;
    for (;;) {
        sum = 0u; cnt = 0u; mine = 0u;
#pragma unroll
        for (unsigned j = 0; j < 16; ++j) { const unsigned c = xb_ld(&bar[XB_XCNT(j)]); sum += c; cnt += (c > 0u) ? 1u : 0u; mine = (j == x) ? c : mine; }
        if (sum == G) break;
        __builtin_amdgcn_s_sleep(1);
        if ((++sp & 255u) == 0u) { if (xb_ld(&bar[XB_TMO])) break; if (sp > XB_SPIN_CAP) { atomicAdd(&bar[XB_TMO], 1u); break; } }
    }
    nloc = mine > 0u ? mine : 1u; nx = cnt > 0u ? cnt : 1u;
}
__device__ __forceinline__ void xcd_barrier(const XcdBarrier& b, const bool leader) {
    asm volatile("s_waitcnt vmcnt(0)" ::: "memory");
    __syncthreads();
    if (leader) {
        unsigned* bar = b.bar;
        __builtin_amdgcn_s_waitcnt(0);
        unsigned nloc = b.st[0], nx = b.st[1];
        if (nloc == 0u) { xcd_barrier_complete(bar, b.x, nloc, nx); b.st[0] = nloc; b.st[1] = nx; }
        const unsigned old = xb_add(&bar[XB_XSUB(b.x)], 1u);
        const unsigned gen = old / nloc;
        if (old + 1u == (gen + 1u) * nloc) {
            __builtin_amdgcn_fence(__ATOMIC_RELEASE, "agent");
            asm volatile("s_waitcnt vmcnt(0)" ::: "memory");
            const unsigned og = xb_add(&bar[XB_TOP], 1u);
            const unsigned tg = og / nx;
            if (og + 1u == (tg + 1u) * nx) xb_add(&bar[XB_TOPGEN], 1u);
            else XB_SPIN(xb_ld(&bar[XB_TOPGEN]) == tg, bar);
            __builtin_amdgcn_fence(__ATOMIC_ACQUIRE, "agent");
            xb_add(&bar[XB_XGEN(b.x)], 1u);
            asm volatile("s_waitcnt vmcnt(0)" ::: "memory");
        } else {
            XB_SPIN(xb_ld(&bar[XB_XGEN(b.x)]) == gen, bar);
            __builtin_amdgcn_fence(__ATOMIC_ACQUIRE, "agent");
            asm volatile("s_waitcnt vmcnt(0)" ::: "memory");
        }
    }
    __syncthreads();
}

namespace pg8 {
constexpr int BM = 256, BK = 64, HALF = 128, HTB = HALF * BK * 2, STAGE_BYTES = 8 * HTB, NXCD = 8, WGM = 8;
__host__ __device__ __forceinline__ int lds_byte(int r, int c) { const int st = (r >> 4) * 2 + (c >> 5), rr = r & 15, cc = c & 31, ob = rr * 64 + cc * 2; return st * 1024 + (ob ^ (((ob >> 9) & 1) << 5)); }
__host__ __device__ __forceinline__ void stage_rc(int b, int& R, int& C) { const int st = b / 1024, sb = b % 1024, swz = sb ^ (((sb >> 9) & 1) << 5); R = (st >> 1) * 16 + swz / 64; C = (st & 1) * 32 + (swz % 64) / 2; }
__host__ __device__ __forceinline__ int perm32(int rho) { const int n = rho >> 4, i = rho & 15; return 8 * (i >> 2) + 4 * n + (i & 3); }

struct Unit { int pm, pn; size_t aoff, boff; bf16* obase; int oldc; int half; int roff; int rbase, rend; };
struct Gemm { const bf16* A; const bf16* Bt; int lda, K; const int* rowtok; };

struct StaticOrder {
    int nM, nN, nwg, G, c, lda, K;
    __device__ __forceinline__ void init(int M, int N, int lda_, int K_, int G_, int c_) { nM = M / BM; nN = N / BM; nwg = nM * nN; G = G_; c = c_; lda = lda_; K = K_; }
    __device__ __forceinline__ bool next(int i, Unit& u) const {
        const long L = (long)i * G + c; if (L >= nwg) return false;
        int wgid = (int)L; { const int q = nwg / NXCD, r = nwg % NXCD, xcd = wgid % NXCD, off = wgid / NXCD; wgid = (xcd < r ? xcd * (q + 1) : r * (q + 1) + (xcd - r) * q) + off; }
        const int nig = WGM * nN, gid = wgid / nig, fm = gid * WGM, gsz = (nM - fm) < WGM ? (nM - fm) : WGM;
        u.pm = fm + ((wgid % nig) % gsz); u.pn = (wgid % nig) / gsz;
        u.aoff = (size_t)u.pm * BM * lda * 2; u.boff = (size_t)u.pn * BM * K * 2; u.obase = nullptr; u.oldc = 0; u.half = 0; u.roff = -1; u.rbase = 0; u.rend = 0; return true;
    }
};
struct HalfOrder {
    StaticOrder base;
    __device__ __forceinline__ bool next(int i, Unit& u) const {
        const long L = (long)i * base.G + base.c; if (L >= 2L * base.nwg) return false;
        StaticOrder b2 = base; b2.c = (int)(L >> 1); b2.G = 0;
        if (!b2.next(0, u)) return false;
        const int mh = (int)(L & 1); u.aoff += (size_t)mh * HALF * base.lda * 2; u.half = 1; u.roff = mh * HALF; return true;
    }
};
struct WinPlusExtra {
    StaticOrder base; int nx; long xa, xb; long xa_l, xb_l; bf16* xo; size_t xo_l;
    __device__ __forceinline__ bool next(int i, Unit& u) const {
        const long L = (long)i * base.G + base.c;
        if (L < base.nwg) return base.next(i, u);
        const long m = L - base.nwg; if (m >= nx) return false;
        const int ll = (int)(m >> 4), t = (int)(m & 15); u.pm = t >> 2; u.pn = t & 3;
        u.aoff = (size_t)(xa + ll * xa_l + (long)u.pm * BM * base.lda * 2); u.boff = (size_t)(xb + ll * xb_l + (long)u.pn * BM * base.K * 2);
        u.obase = xo + (size_t)ll * xo_l; u.oldc = 1024; u.half = 0; u.roff = -1; u.rbase = 0; u.rend = 0; return true;
    }
};
struct GroupedOrder {
    const LAS int* tb; int nmt, nN, G, c, lda, K; size_t bstride;
    __device__ __forceinline__ bool next(int i, Unit& u) const {
        const int n = nmt * nN, nfull = n / G * G, rem = n - nfull;
        int L = i * G + c, mh = -1;
        if (2 * rem <= G && L >= nfull) { const int p = L - nfull; if (p >= 2 * rem) return false; L = nfull + (p >> 1); mh = p & 1; }
        else if (L >= n) return false;
        const int mt = L / nN; u.pn = L % nN;
        const unsigned e = (unsigned)__builtin_amdgcn_readfirstlane(tb[MT_E + mt]), rw_ = (unsigned)__builtin_amdgcn_readfirstlane(tb[MT_R + mt]), r0 = rw_ & 0x7fffffffu;
        u.rbase = __builtin_amdgcn_readfirstlane(tb[MT_B + mt]); u.rend = __builtin_amdgcn_readfirstlane(tb[MT_N + mt]);
        u.pm = (int)(r0 >> 8); u.aoff = (size_t)r0 * lda * 2; u.boff = (size_t)e * bstride + (size_t)u.pn * BM * K * 2; u.obase = nullptr; u.oldc = 0; u.half = (int)(rw_ >> 31); u.roff = -1;
        if (mh >= 0) { u.half = 1; u.roff = mh * HALF; u.aoff += (size_t)mh * HALF * lda * 2; }
        return true;
    }
};

struct EpiBf16 {
    static constexpr bool PERM = true;
    bf16* O; int ldc; const float* rowss; const float* rstd;
    __device__ __forceinline__ void operator()(const f32x4 (&acc)[2][2][4][2], const Unit& u, int wr, int wc, int fr, int fq) const {
        const int row0 = u.pm * BM + (u.roff > 0 ? u.roff : 0) + wr * 64 + fr, col0 = u.pn * BM + wc * 32 + 8 * fq;
        bf16* const Ob = u.obase ? u.obase : O; const int ld = u.obase ? u.oldc : ldc;
#pragma unroll
        for (int ai = 0; ai < 2; ++ai) { if (ai == 1 && u.roff >= 0) break;
#pragma unroll
            for (int m = 0; m < 4; ++m) { bf16* rowp = Ob + (size_t)(row0 + ai * HALF + m * 16) * ld + col0;
                float sr = 1.f;
                if (rowss) { const f32x4* sp = (const f32x4*)(rowss + (size_t)(row0 + ai * HALF + m * 16) * 32); f32x4 t = sp[0];
#pragma unroll
                    for (int k = 1; k < 8; ++k) t = t + sp[k];
                    sr = __builtin_amdgcn_rsqf(((t[0] + t[1]) + (t[2] + t[3])) * (1.f / 2048.f) + 1e-6f); }
                if (rstd && !u.obase) sr = rstd[row0 + ai * HALF + m * 16];
#pragma unroll
                for (int bj = 0; bj < 2; ++bj) { const f32x4 v0 = acc[ai][bj][m][0] * sr, v1 = acc[ai][bj][m][1] * sr;
                    u32x4 w; w.x = cvtpk(v0[0], v0[1]); w.y = cvtpk(v0[2], v0[3]); w.z = cvtpk(v1[0], v1[1]); w.w = cvtpk(v1[2], v1[3]);
                    *(u32x4*)(rowp + bj * HALF) = w; } } }
    }
};
struct EpiResid {
    static constexpr bool PERM = true;
    const float* B; float* X; int ldc; bf16* XB; float* rowss;
    __device__ __forceinline__ void operator()(const f32x4 (&acc)[2][2][4][2], const Unit& u, int wr, int wc, int fr, int fq) const {
        const int row0 = u.pm * BM + wr * 64 + fr, col0 = u.pn * BM + wc * 32 + 8 * fq;
#pragma unroll
        for (int ai = 0; ai < 2; ++ai)
#pragma unroll
            for (int m = 0; m < 4; ++m) { const size_t ro = (size_t)(row0 + ai * HALF + m * 16) * ldc + col0; float* rowp = X + ro; const float* bp = B + ro;
                f32x4 b[2][2];
#pragma unroll
                for (int bj = 0; bj < 2; ++bj)
#pragma unroll
                    for (int n = 0; n < 2; ++n) b[bj][n] = *(const f32x4*)(bp + bj * HALF + n * 4);
                float ssq = 0.f;
#pragma unroll
                for (int bj = 0; bj < 2; ++bj) {
#pragma unroll
                    for (int n = 0; n < 2; ++n) { b[bj][n] = b[bj][n] + acc[ai][bj][m][n]; *(f32x4*)(rowp + bj * HALF + n * 4) = b[bj][n]; }
                    if (XB) { const f32x4 v0 = b[bj][0], v1 = b[bj][1]; ssq += (v0[0] * v0[0] + v0[1] * v0[1]) + (v0[2] * v0[2] + v0[3] * v0[3]) + (v1[0] * v1[0] + v1[1] * v1[1]) + (v1[2] * v1[2] + v1[3] * v1[3]);
                        u32x4 w; w.x = cvtpk(v0[0], v0[1]); w.y = cvtpk(v0[2], v0[3]); w.z = cvtpk(v1[0], v1[1]); w.w = cvtpk(v1[2], v1[3]); *(u32x4*)(XB + ro + bj * HALF) = w; } }
                if (XB) { ssq += __shfl_xor(ssq, 16); ssq += __shfl_xor(ssq, 32); if (fq == 0) rowss[(size_t)(row0 + ai * HALF + m * 16) * 32 + u.pn * 4 + wc] = ssq; }
                asm volatile("" ::: "memory"); }
    }
};
struct EpiResid16 {
    static constexpr bool PERM = true;
    bf16* X; int ldc; float* rowss;
    __device__ __forceinline__ void operator()(const f32x4 (&acc)[2][2][4][2], const Unit& u, int wr, int wc, int fr, int fq) const {
        const int row0 = u.pm * BM + wr * 64 + fr, col0 = u.pn * BM + wc * 32 + 8 * fq;
#pragma unroll
        for (int ai = 0; ai < 2; ++ai)
#pragma unroll
            for (int m = 0; m < 4; ++m) { bf16* rowp = X + (size_t)(row0 + ai * HALF + m * 16) * ldc + col0;
                u32x4 b[2];
#pragma unroll
                for (int bj = 0; bj < 2; ++bj) b[bj] = *(const u32x4*)(rowp + bj * HALF);
                float ssq = 0.f;
#pragma unroll
                for (int bj = 0; bj < 2; ++bj) { const f32x4 a0 = acc[ai][bj][m][0], a1 = acc[ai][bj][m][1];
                    const float v0 = bflo(b[bj].x) + a0[0], v1 = bfhi(b[bj].x) + a0[1], v2 = bflo(b[bj].y) + a0[2], v3 = bfhi(b[bj].y) + a0[3];
                    const float v4 = bflo(b[bj].z) + a1[0], v5 = bfhi(b[bj].z) + a1[1], v6 = bflo(b[bj].w) + a1[2], v7 = bfhi(b[bj].w) + a1[3];
                    ssq += ((v0 * v0 + v1 * v1) + (v2 * v2 + v3 * v3)) + ((v4 * v4 + v5 * v5) + (v6 * v6 + v7 * v7));
                    u32x4 w; w.x = cvtpk(v0, v1); w.y = cvtpk(v2, v3); w.z = cvtpk(v4, v5); w.w = cvtpk(v6, v7); *(u32x4*)(rowp + bj * HALF) = w; }
                if (rowss) { ssq += __shfl_xor(ssq, 16); ssq += __shfl_xor(ssq, 32); if (fq == 0) rowss[(size_t)(row0 + ai * HALF + m * 16) * 32 + u.pn * 4 + wc] = ssq; }
                asm volatile("" ::: "memory"); }
    }
};
struct EpiGateUp {
    static constexpr bool PERM = true;
    bf16* H; int ldc; const int* rowtok; const float* rstd;
    __device__ __forceinline__ void operator()(const f32x4 (&acc)[2][2][4][2], const Unit& u, int wr, int wc, int fr, int fq) const {
        const int row0 = u.pm * BM + (u.roff > 0 ? u.roff : 0) + wr * 64 + fr, col0 = u.pn * HALF + wc * 32 + 8 * fq;
        float sc[2][4];
#pragma unroll
        for (int ai = 0; ai < 2; ++ai)
#pragma unroll
            for (int m = 0; m < 4; ++m) { const int r_ = row0 + ai * HALF + m * 16; sc[ai][m] = r_ < u.rend ? rstd[u.rbase + r_] : 0.f; }
#pragma unroll
        for (int ai = 0; ai < 2; ++ai) { if (ai == 1 && u.roff >= 0) break;
#pragma unroll
            for (int m = 0; m < 4; ++m) { bf16* rowp = H + (size_t)(row0 + ai * HALF + m * 16) * ldc + col0;
                float h[8];
#pragma unroll
                for (int n = 0; n < 2; ++n)
#pragma unroll
                    for (int j = 0; j < 4; ++j) { const float g = acc[ai][0][m][n][j] * sc[ai][m], up = acc[ai][1][m][n][j] * sc[ai][m]; h[n * 4 + j] = g * __builtin_amdgcn_rcpf(1.f + fexp(-g)) * up; }
                u32x4 w; w.x = cvtpk(h[0], h[1]); w.y = cvtpk(h[2], h[3]); w.z = cvtpk(h[4], h[5]); w.w = cvtpk(h[6], h[7]);
                *(u32x4*)rowp = w; } }
    }
};

template <class Epi, class Sched, bool GATHER = false>
__device__ __forceinline__ void gemm_phase(LAS unsigned char* lds, const int tid, const Gemm g, const Sched& S, const Epi& E) {
    const int wid = __builtin_amdgcn_readfirstlane(tid >> 6), lane = tid & 63, wr = wid >> 2, wc = wid & 3, fr = lane & 15, fq = lane >> 4;
    const int K = g.K, nt = K / BK, lda = g.lda;
    unsigned voffA[2], voffB[2]; int gR[2], gC[2];
#pragma unroll
    for (int i = 0; i < 2; ++i) { int R, C; stage_rc(tid * 16 + i * 8192, R, C); const int Rb = Epi::PERM ? ((R & ~31) + perm32(R & 31)) : R;
        voffA[i] = (unsigned)(R * lda + C) * 2u; voffB[i] = (unsigned)(Rb * K + C) * 2u; gR[i] = R; gC[i] = C; }
    unsigned vA0[2] = {0u, 0u}, vA1[2] = {0u, 0u}, nA0[2] = {0u, 0u}, nA1[2] = {0u, 0u};
#define PG8_GOFF(d0, d1, un) do { _Pragma("unroll") for (int _i = 0; _i < 2; ++_i) { const int r_ = (un).pm * BM + ((un).roff > 0 ? (un).roff : 0) + gR[_i]; \
        const int t0_ = r_ < (un).rend ? g.rowtok[(un).rbase + r_] : 0, t1_ = r_ + HALF < (un).rend ? g.rowtok[(un).rbase + r_ + HALF] : 0; \
        d0[_i] = (unsigned)(t0_ * lda + gC[_i]) * 2u; d1[_i] = (unsigned)(t1_ * lda + gC[_i]) * 2u; } } while (0)
    const size_t kstep = (size_t)(BK * 2);
    const size_t hstepA = (size_t)HALF * lda * 2, hstepB = (size_t)HALF * K * 2;
    const unsigned ldsw = (unsigned)wid * 1024u;
    const int aoff = lds_byte(wr * 64 + fr, fq * 8), boff = lds_byte(wc * 32 + fr, fq * 8);
#define PG8_SA(b, h) (((b) * 2 + (h)) * HTB)
#define PG8_SB(b, h) ((4 + (b) * 2 + (h)) * HTB)
#define PG8_STAGE(bufoff, gbase, voff) do { _Pragma("unroll") for (int _i = 0; _i < 2; ++_i) \
        __builtin_amdgcn_global_load_lds((const unsigned*)((const char*)(gbase) + (voff)[_i]), (LAS unsigned*)(lds + (bufoff) + ldsw + _i * 8192), 16, 0, 0); } while (0)
#define PG8_LDA(dst, b, h) do { _Pragma("unroll") for (int m = 0; m < 4; ++m) _Pragma("unroll") for (int k = 0; k < 2; ++k) dst[m][k] = *(const LAS bf16x8*)(lds + PG8_SA(b, h) + aoff + m * 2048 + k * 1024); } while (0)
#define PG8_LDB(dst, b, h) do { _Pragma("unroll") for (int n = 0; n < 2; ++n) _Pragma("unroll") for (int k = 0; k < 2; ++k) dst[n][k] = *(const LAS bf16x8*)(lds + PG8_SB(b, h) + boff + n * 2048 + k * 1024); } while (0)
#define PG8_MMA(ai, bj, At, Bt) do { __builtin_amdgcn_s_setprio(1); _Pragma("unroll") for (int m = 0; m < 4; ++m) _Pragma("unroll") for (int n = 0; n < 2; ++n) _Pragma("unroll") for (int k = 0; k < 2; ++k) \
        acc[ai][bj][m][n] = __builtin_amdgcn_mfma_f32_16x16x32_bf16(Bt[n][k], At[m][k], acc[ai][bj][m][n], 0, 0, 0); __builtin_amdgcn_s_setprio(0); } while (0)
#define PG8_WAIT_V(n) asm volatile("s_waitcnt vmcnt(" #n ")" ::: "memory")
#define PG8_WAIT_L(n) asm volatile("s_waitcnt lgkmcnt(" #n ")" ::: "memory")
#define PG8_BAR __builtin_amdgcn_s_barrier()
#define PG8_SCHED __builtin_amdgcn_sched_barrier(0)
    Unit cur, nxt; int ui = 0;
    if (!S.next(0, cur)) return;
    f32x4 acc[2][2][4][2];
#pragma unroll
    for (int a = 0; a < 2; ++a)
#pragma unroll
        for (int b = 0; b < 2; ++b)
#pragma unroll
            for (int m = 0; m < 4; ++m)
#pragma unroll
                for (int n = 0; n < 2; ++n) acc[a][b][m][n] = (f32x4){0.f, 0.f, 0.f, 0.f};
    bf16x8 At[4][2], B0[2][2], B1[2][2];
    const char* cA = GATHER ? (const char*)g.A : (const char*)g.A + cur.aoff; const char* cB = (const char*)g.Bt + cur.boff;
    if constexpr (GATHER) PG8_GOFF(vA0, vA1, cur);
    PG8_STAGE(PG8_SB(0, 0), cB, voffB); PG8_STAGE(PG8_SB(0, 1), cB + hstepB, voffB);
    if constexpr (GATHER) { PG8_STAGE(PG8_SA(0, 0), cA, vA0); PG8_STAGE(PG8_SA(0, 1), cA, vA1); } else { PG8_STAGE(PG8_SA(0, 0), cA, voffA); PG8_STAGE(PG8_SA(0, 1), cA + hstepA, voffA); }
    if (wr == 1) PG8_BAR;
    PG8_WAIT_V(2); PG8_BAR;
    PG8_STAGE(PG8_SB(1, 0), cB + kstep, voffB);
    if constexpr (GATHER) PG8_STAGE(PG8_SA(1, 0), cA + kstep, vA0); else PG8_STAGE(PG8_SA(1, 0), cA + kstep, voffA);
    PG8_STAGE(PG8_SB(1, 1), cB + hstepB + kstep, voffB);
    PG8_WAIT_V(6); PG8_BAR;
    for (;;) {
        const bool has_next = S.next(ui + 1, nxt);
        const char* nA = GATHER ? cA : (has_next ? (const char*)g.A + nxt.aoff : cA); const char* nB = has_next ? (const char*)g.Bt + nxt.boff : cB;
        if constexpr (GATHER) { if (has_next) PG8_GOFF(nA0, nA1, nxt); else { nA0[0] = vA0[0]; nA0[1] = vA0[1]; nA1[0] = vA1[0]; nA1[1] = vA1[1]; } }
#pragma nounroll
        for (int t = 0; t < nt; t += 2) {
            const bool last = (t == nt - 2);
            const char* a1 = cA + (size_t)(t + 1) * kstep;
            const char* a2 = last ? nA : cA + (size_t)(t + 2) * kstep; const char* b2 = last ? nB : cB + (size_t)(t + 2) * kstep;
            const char* a3 = a2 + kstep; const char* b3 = b2 + kstep;
            unsigned s0[2], s1[2];
            if constexpr (GATHER) { s0[0] = last ? nA0[0] : vA0[0]; s0[1] = last ? nA0[1] : vA0[1]; s1[0] = last ? nA1[0] : vA1[0]; s1[1] = last ? nA1[1] : vA1[1]; }
            PG8_LDB(B0, 0, 0); PG8_LDB(B1, 0, 1); PG8_SCHED; PG8_LDA(At, 0, 0);
            if constexpr (GATHER) PG8_STAGE(PG8_SA(1, 1), a1, vA1); else PG8_STAGE(PG8_SA(1, 1), a1 + hstepA, voffA);
            PG8_WAIT_V(8); PG8_WAIT_L(0); PG8_BAR; PG8_MMA(0, 0, At, B0); PG8_MMA(0, 1, At, B1); PG8_BAR; PG8_SCHED;
            PG8_LDA(At, 0, 1); PG8_STAGE(PG8_SB(0, 0), b2, voffB); PG8_STAGE(PG8_SB(0, 1), b2 + hstepB, voffB);
            if constexpr (GATHER) PG8_STAGE(PG8_SA(0, 0), a2, s0); else PG8_STAGE(PG8_SA(0, 0), a2, voffA);
            PG8_WAIT_V(8); PG8_WAIT_L(0); PG8_BAR; if (!cur.half) { PG8_MMA(1, 0, At, B0); PG8_MMA(1, 1, At, B1); } PG8_BAR; PG8_SCHED;
            PG8_LDB(B0, 1, 0); PG8_LDB(B1, 1, 1); PG8_SCHED; PG8_LDA(At, 1, 0);
            if constexpr (GATHER) PG8_STAGE(PG8_SA(0, 1), a2, s1); else PG8_STAGE(PG8_SA(0, 1), a2 + hstepA, voffA);
            PG8_WAIT_V(8); PG8_WAIT_L(0); PG8_BAR; PG8_MMA(0, 0, At, B0); PG8_MMA(0, 1, At, B1); PG8_BAR; PG8_SCHED;
            PG8_LDA(At, 1, 1); PG8_STAGE(PG8_SB(1, 0), b3, voffB); PG8_STAGE(PG8_SB(1, 1), b3 + hstepB, voffB);
            if constexpr (GATHER) PG8_STAGE(PG8_SA(1, 0), a3, s0); else PG8_STAGE(PG8_SA(1, 0), a3, voffA);
            PG8_WAIT_V(8); PG8_WAIT_L(0); PG8_BAR; if (!cur.half) { PG8_MMA(1, 0, At, B0); PG8_MMA(1, 1, At, B1); } PG8_BAR; PG8_SCHED;
        }
        if (wr == 0) PG8_BAR;
        E(acc, cur, wr, wc, fr, fq);
        if (!has_next) break;
#pragma unroll
        for (int a = 0; a < 2; ++a)
#pragma unroll
            for (int b = 0; b < 2; ++b)
#pragma unroll
                for (int m = 0; m < 4; ++m)
#pragma unroll
                    for (int n = 0; n < 2; ++n) acc[a][b][m][n] = (f32x4){0.f, 0.f, 0.f, 0.f};
        cur = nxt; cA = nA; cB = nB; ++ui;
        if constexpr (GATHER) { vA0[0] = nA0[0]; vA0[1] = nA0[1]; vA1[0] = nA1[0]; vA1[1] = nA1[1]; }
        if (wr == 1) PG8_BAR;
    }
    PG8_WAIT_V(0);
    PG8_BAR;
#undef PG8_GOFF
#undef PG8_SA
#undef PG8_SB
#undef PG8_STAGE
#undef PG8_LDA
#undef PG8_LDB
#undef PG8_MMA
#undef PG8_WAIT_V
#undef PG8_WAIT_L
#undef PG8_BAR
#undef PG8_SCHED
}
}

struct Args { const float* in[32]; float* out; unsigned char* ws; int ph_lo, ph_hi; };
struct Frame {
    LAS unsigned char* lds; int tid, lane, wave, G, bid;
    unsigned char* ws; unsigned* ctl; const float* const* in; float* out;
};

__device__ __forceinline__ void transpose_item(const float* W, int K, int N, bf16* WT, int dst_row0, const float* gain, LAS float* scr, int kb, int nb, int lane) {
    const int k0 = 64 * kb, n0 = 32 * nb, c4 = lane & 7, kr = lane >> 3;
    f32x4 v[8];
#pragma unroll
    for (int i = 0; i < 8; ++i) v[i] = *(const f32x4*)(W + (size_t)(k0 + 8 * i + kr) * N + n0 + 4 * c4);
#pragma unroll
    for (int i = 0; i < 8; ++i) { const int kk = 8 * i + kr; const float gk = gain ? gain[k0 + kk] : 1.f; LAS float* d = scr + kk * 33 + 4 * c4;
        d[0] = v[i][0] * gk; d[1] = v[i][1] * gk; d[2] = v[i][2] * gk; d[3] = v[i][3] * gk; }
    LDS_WAIT(); asm volatile("" ::: "memory");
    const int c = lane & 7;
#pragma unroll
    for (int j = 0; j < 4; ++j) { const int n = (lane >> 3) + 8 * j; const LAS float* s = scr + (8 * c) * 33 + n;
        u32x4 o; o.x = pk2(s[0 * 33], s[1 * 33]); o.y = pk2(s[2 * 33], s[3 * 33]); o.z = pk2(s[4 * 33], s[5 * 33]); o.w = pk2(s[6 * 33], s[7 * 33]);
        *(u32x4*)(WT + (size_t)(dst_row0 + n) * K + k0 + 8 * c) = o; }
    LDS_WAIT(); asm volatile("" ::: "memory");
}
struct ConvMat { const float* W; bf16* WT; const float* gain; int K, N, kind; };
__device__ __forceinline__ void convert_matrix(Frame& F, const ConvMat& m, int& base, int gw, int NGW, LAS float* scr) {
    const int nnb = m.N / 32, nkb = m.K / 64, items = nnb * nkb;
    int first = gw - base; if (first < 0) first += NGW;
    for (int it = first; it < items; it += NGW) {
        const int kb = it / nnb, nb = it % nnb, n0 = nb * 32;
        int r0 = n0; if (m.kind == 1) r0 = (n0 >> 7) * 256 + (n0 & 127); else if (m.kind == 2) r0 = (n0 >> 7) * 256 + 128 + (n0 & 127);
        transpose_item(m.W, m.K, m.N, m.WT, r0 - 0, m.gain, scr, kb, nb, F.lane);
        (void)n0;
    }
    base += items; while (base >= NGW) base -= NGW;
}
__device__ __forceinline__ void p_convert(Frame& F) {
    LAS float* scr = (LAS float*)(F.lds + F.wave * 16384);
    const int gw = F.bid * NWAVES + F.wave, NGW = F.G * NWAVES;
    int base = 0;
    for (int l = 0; l < DEPTH; ++l) {
        unsigned char* wl = F.ws + WS_W + (size_t)l * WL_END;
        { ConvMat m{F.in[5] + (size_t)l * D * INW, (bf16*)(wl + WL_WIN), F.in[4] + (size_t)l * D, D, INW, 0}; convert_matrix(F, m, base, gw, NGW, scr); }
        { ConvMat m{F.in[12] + (size_t)l * 512 * 768, (bf16*)(wl + WL_WUQ), F.in[10] + l * 512, 512, 768, 0}; convert_matrix(F, m, base, gw, NGW, scr); }
        { ConvMat m{F.in[13] + (size_t)l * 256 * 1024, (bf16*)(wl + WL_WUKV), F.in[11] + l * 256, 256, 1024, 0}; convert_matrix(F, m, base, gw, NGW, scr); }
        { ConvMat m{F.in[16] + (size_t)l * D * D, (bf16*)(wl + WL_WOUT), nullptr, D, D, 0}; convert_matrix(F, m, base, gw, NGW, scr); }
        { ConvMat m{F.in[19] + (size_t)l * D * 512, (bf16*)(wl + WL_WMQ), F.in[17] + (size_t)l * D, D, 512, 0}; convert_matrix(F, m, base, gw, NGW, scr); }
        { ConvMat m{F.in[20] + (size_t)l * D * 1024, (bf16*)(wl + WL_WMKV), nullptr, D, 1024, 0}; convert_matrix(F, m, base, gw, NGW, scr); }
        { ConvMat m{F.in[23] + (size_t)l * 512 * D, (bf16*)(wl + WL_WMO), nullptr, 512, D, 0}; convert_matrix(F, m, base, gw, NGW, scr); }
        for (int e = 0; e < NEXP; ++e) {
            bf16* gu = (bf16*)(wl + WL_WGU) + (size_t)e * 1024 * D;
            { ConvMat m{F.in[29] + ((size_t)l * NEXP + e) * D * DEXP, gu, F.in[24] + (size_t)l * D, D, DEXP, 1}; convert_matrix(F, m, base, gw, NGW, scr); }
            { ConvMat m{F.in[30] + ((size_t)l * NEXP + e) * D * DEXP, gu, F.in[24] + (size_t)l * D, D, DEXP, 2}; convert_matrix(F, m, base, gw, NGW, scr); }
            { ConvMat m{F.in[31] + ((size_t)l * NEXP + e) * DEXP * D, (bf16*)(wl + WL_WD) + (size_t)e * D * DEXP, nullptr, DEXP, D, 0}; convert_matrix(F, m, base, gw, NGW, scr); }
        }
        { u32x4* z = (u32x4*)((bf16*)(wl + WL_WIN) + (size_t)INW * D); const int n16 = (UW - INW) * D * 2 / 16;
          for (int i = F.bid * NTHR + F.tid; i < n16; i += F.G * NTHR) z[i] = (u32x4){0u, 0u, 0u, 0u}; }
    }
    for (int i = F.bid * NTHR + F.tid; i < 4096 * 32; i += F.G * NTHR) {
        const int pos = i >> 5, j = i & 31;
        const float inv = ex2(-(float)j * (13.287712379549449f / 32.0f));
        const float ang = (float)pos * inv;
        const double rev = (double)ang * 0.15915494309189535; const float fr = (float)(rev - floor(rev));
        float* rp = (float*)(F.ws + WS_ROPE) + 2 * i; rp[0] = __builtin_amdgcn_cosf(fr); rp[1] = __builtin_amdgcn_sinf(fr);
    }
    for (int i = F.bid * NTHR + F.tid; i < 2 * 80 * D; i += F.G * NTHR) { const int l = i / (80 * D), c = (i / D) % 80, k = i % D;
        float w = 0.f; if (c < 8) w = F.in[25][((size_t)l * D + k) * 8 + c]; else if (c >= 16) w = F.in[27][((size_t)l * D + k) * 64 + c - 16];
        w *= F.in[24][(size_t)l * D + k]; const unsigned hi = f2bf(w), lo = f2bf(w - bf2f(hi));
        bf16* rw = (bf16*)(F.ws + WS_SMALL + SM_RW) + (size_t)l * 2 * 80 * D; rw[(size_t)c * D + k] = (bf16)hi; rw[(size_t)(80 + c) * D + k] = (bf16)lo; }
    for (int i = F.bid * NTHR + F.tid; i < 1024; i += F.G * NTHR) {
        float* lb = (float*)(F.ws + WS_SMALL + SM_LB); const float a0 = F.in[3][i], a1 = F.in[3][1024 + i];
        const float mx = fmaxf(a0, a1), e0 = expf(a0 - mx), e1 = expf(a1 - mx), p0 = e0 / (e0 + e1), p1 = e1 / (e0 + e1);
        lb[i] = p0 - p0; lb[1024 + i] = (p0 + p1) - p0;
    }
}

template <int NR, bool MOE>
__device__ __forceinline__ void norm_rows(const float* const (&xin)[NR], float* const (&xout)[NR], bf16* const (&hn)[NR], const float* gain, const bf16* const (&y0)[NR], const bf16* const (&y1)[NR], const float (&g0)[NR], const float (&g1)[NR], int lane) {
    f32x4 v[NR][8]; u32x2 ya[NR][8], yb[NR][8];
#pragma unroll
    for (int n = 0; n < NR; ++n)
#pragma unroll
        for (int j = 0; j < 8; ++j) { v[n][j] = *((const f32x4*)xin[n] + lane + 64 * j); if constexpr (MOE) { ya[n][j] = *((const u32x2*)y0[n] + lane + 64 * j); yb[n][j] = *((const u32x2*)y1[n] + lane + 64 * j); } }
#pragma unroll
    for (int n = 0; n < NR; ++n) { float ss = 0.f;
#pragma unroll
        for (int j = 0; j < 8; ++j) {
            if constexpr (MOE) { const u32x2 a = ya[n][j], b = yb[n][j];
                v[n][j][0] += g0[n] * bflo(a.x) + g1[n] * bflo(b.x); v[n][j][1] += g0[n] * bfhi(a.x) + g1[n] * bfhi(b.x); v[n][j][2] += g0[n] * bflo(a.y) + g1[n] * bflo(b.y); v[n][j][3] += g0[n] * bfhi(a.y) + g1[n] * bfhi(b.y); }
            ss += (v[n][j][0] * v[n][j][0] + v[n][j][1] * v[n][j][1]) + (v[n][j][2] * v[n][j][2] + v[n][j][3] * v[n][j][3]); }
        if (xout[n]) {
#pragma unroll
            for (int j = 0; j < 8; ++j) *((f32x4*)xout[n] + lane + 64 * j) = v[n][j]; }
        if (hn[n]) {
            const float rstd = __builtin_amdgcn_rsqf(wave_sum(ss) * (1.f / D) + EPS);
#pragma unroll
            for (int j = 0; j < 8; ++j) { const f32x4 gv = *((const f32x4*)gain + lane + 64 * j);
                u32x2 o; o.x = pk2(v[n][j][0] * rstd * gv[0], v[n][j][1] * rstd * gv[1]); o.y = pk2(v[n][j][2] * rstd * gv[2], v[n][j][3] * rstd * gv[3]);
                *((u32x2*)hn[n] + lane + 64 * j) = o; }
        } }
}
__device__ __forceinline__ void norm_row(const float* xin, float* xout, bf16* hn, const float* gain, const bf16* y0, const bf16* y1, float g0, float g1, int lane) {
    const float* const xi[1] = {xin}; float* const xo[1] = {xout}; bf16* const h[1] = {hn}; const bf16* const a[1] = {y0}; const bf16* const b[1] = {y1}; const float ga[1] = {g0}, gb[1] = {g1};
    if (y0) norm_rows<1, true>(xi, xo, h, gain, a, b, ga, gb, lane); else norm_rows<1, false>(xi, xo, h, gain, a, b, ga, gb, lane);
}
template <int NR, bool MOE, bool IN16>
__device__ __forceinline__ void stream_rows(const void* const (&xin)[NR], bf16* const (&x16)[NR], float* const (&xf)[NR], float* const (&rs)[NR], const bf16* const (&y0)[NR], const bf16* const (&y1)[NR], const float (&g0)[NR], const float (&g1)[NR], int lane) {
    f32x4 v[NR][8]; u32x2 ya[NR][8], yb[NR][8];
#pragma unroll
    for (int n = 0; n < NR; ++n)
#pragma unroll
        for (int j = 0; j < 8; ++j) {
            if constexpr (IN16) { const u32x2 w = *((const u32x2*)xin[n] + lane + 64 * j); v[n][j] = (f32x4){bflo(w.x), bfhi(w.x), bflo(w.y), bfhi(w.y)}; }
            else v[n][j] = *((const f32x4*)xin[n] + lane + 64 * j);
            if constexpr (MOE) { ya[n][j] = *((const u32x2*)y0[n] + lane + 64 * j); yb[n][j] = *((const u32x2*)y1[n] + lane + 64 * j); } }
#pragma unroll
    for (int n = 0; n < NR; ++n) { float ss = 0.f;
#pragma unroll
        for (int j = 0; j < 8; ++j) {
            if constexpr (MOE) { const u32x2 a = ya[n][j], b = yb[n][j];
                v[n][j][0] += g0[n] * bflo(a.x) + g1[n] * bflo(b.x); v[n][j][1] += g0[n] * bfhi(a.x) + g1[n] * bfhi(b.x); v[n][j][2] += g0[n] * bflo(a.y) + g1[n] * bflo(b.y); v[n][j][3] += g0[n] * bfhi(a.y) + g1[n] * bfhi(b.y); }
            ss += (v[n][j][0] * v[n][j][0] + v[n][j][1] * v[n][j][1]) + (v[n][j][2] * v[n][j][2] + v[n][j][3] * v[n][j][3]); }
        if (xf[n]) {
#pragma unroll
            for (int j = 0; j < 8; ++j) *((f32x4*)xf[n] + lane + 64 * j) = v[n][j]; }
        if (x16[n]) {
#pragma unroll
            for (int j = 0; j < 8; ++j) { u32x2 o; o.x = pk2(v[n][j][0], v[n][j][1]); o.y = pk2(v[n][j][2], v[n][j][3]); *((u32x2*)x16[n] + lane + 64 * j) = o; } }
        if (rs[n]) { const float r = __builtin_amdgcn_rsqf(wave_sum(ss) * (1.f / D) + EPS); if (lane == 0) *rs[n] = r; } }
}
struct AttnU { const bf16* Q; const bf16* K; const bf16* VT; bf16* O; int qs, ks, vts, os, q0, t_lo, t_hi; float* dbg; int qh, oh; float sinkb; };
constexpr int AT_ML = 98304;
template <int DQK, int DV, int MODE, bool QNORM, bool ALLSTAGE = false, bool PIPE3 = false, bool PAIR = false, bool ROT = false>
__device__ __forceinline__ void attn_unit(LAS unsigned char* lds, const int tid, const AttnU u, const float scl2, const float* qgain, const float sink2, const LAS float* biasT) {
    constexpr int NBUF = ALLSTAGE ? 4 : (PIPE3 ? 3 : 2);
    constexpr int KROW = DQK * 2, VROW = 128, KBUF = 64 * KROW, VBUF = DV * VROW, KOFF = 0, VOFF = NBUF * KBUF;
    constexpr int KCH = DQK / 8, NKC = 64 * KCH / 512, NVC = DV * 8 / 512, ND0 = DQK / 16, NDB = DV / 32;
    constexpr int ML = (NBUF * KBUF + NBUF * VBUF <= AT_ML) ? AT_ML : LDS_WORK + 1024;
    static_assert(NBUF * KBUF + NBUF * VBUF <= ML && 4 * 32 * DV * 4 <= ML && ML + 3072 <= LDS_BYTES, "attention LDS map");
    constexpr int NLD = 64 * (DQK / 8) / 512 + DV * 8 / 512;
#define AT_KSWZ(row) (KCH == 16 ? ((row) & 15) : (((row) >> 1) & 7))
    const int wid = __builtin_amdgcn_readfirstlane(tid >> 6), lane = tid & 63, r32 = lane & 31, hi = lane >> 5, g = wid & 3, kh = wid >> 2;
    const LAS float* bT = PAIR ? biasT + kh * 128 : biasT; (void)bT;
    LAS float* Ms = (LAS float*)(lds + ML);
    LAS float* Ls = Ms + 256;
    LAS float* Al = Ls + 256 + wid * 32;
    LAS float* OM = (LAS float*)lds;
    bf16x8 qr[ND0];
    { const bf16* qp = u.Q + (PAIR ? kh * u.qh : 0) + (size_t)(32 * g + r32) * u.qs + 8 * hi;
#pragma unroll
      for (int d0 = 0; d0 < ND0; ++d0) qr[d0] = *(const bf16x8*)(qp + 16 * d0);
      if constexpr (QNORM) {
          float ss = 0.f;
#pragma unroll
          for (int d0 = 0; d0 < ND0; ++d0)
#pragma unroll
              for (int j = 0; j < 8; ++j) { const float v = bf2f((unsigned short)qr[d0][j]); ss += v * v; }
          ss = swap_sum(ss);
          const float rstd = __builtin_amdgcn_rsqf(ss * (1.f / DQK) + EPS);
#pragma unroll
          for (int d0 = 0; d0 < ND0; ++d0) { const f32x4 g0 = *(const f32x4*)(qgain + 16 * d0 + 8 * hi), g1 = *(const f32x4*)(qgain + 16 * d0 + 8 * hi + 4);
              u32x4 w; w.x = pk2(bf2f((unsigned short)qr[d0][0]) * rstd * g0[0], bf2f((unsigned short)qr[d0][1]) * rstd * g0[1]); w.y = pk2(bf2f((unsigned short)qr[d0][2]) * rstd * g0[2], bf2f((unsigned short)qr[d0][3]) * rstd * g0[3]);
              w.z = pk2(bf2f((unsigned short)qr[d0][4]) * rstd * g1[0], bf2f((unsigned short)qr[d0][5]) * rstd * g1[1]); w.w = pk2(bf2f((unsigned short)qr[d0][6]) * rstd * g1[2], bf2f((unsigned short)qr[d0][7]) * rstd * g1[3]);
              qr[d0] = __builtin_bit_cast(bf16x8, w); }
      } }
    unsigned kvo[NKC], vvo[NVC];
#pragma unroll
    for (int i = 0; i < NKC; ++i) { const int p = tid + 512 * i, row = p / KCH, cp = p % KCH; kvo[i] = (unsigned)(row * u.ks + ((cp ^ AT_KSWZ(row)) << 3)); }
#pragma unroll
    for (int i = 0; i < NVC; ++i) { const int p = tid + 512 * i, d = p >> 3, cp = p & 7; vvo[i] = (unsigned)(d * u.vts + ((cp ^ ((d >> 1) & 7)) << 3)); }
#define AT_STAGE(t, bf) do { const bf16* kt_ = u.K + (size_t)(64 * (t)) * u.ks; const bf16* vt_ = u.VT + 64 * (t); \
        _Pragma("unroll") for (int i_ = 0; i_ < NKC; ++i_) __builtin_amdgcn_global_load_lds((const unsigned*)(kt_ + kvo[i_]), (LAS unsigned*)(lds + KOFF + (bf) * KBUF + (512 * i_ + wid * 64) * 16), 16, 0, 0); \
        _Pragma("unroll") for (int i_ = 0; i_ < NVC; ++i_) __builtin_amdgcn_global_load_lds((const unsigned*)(vt_ + vvo[i_]), (LAS unsigned*)(lds + VOFF + (bf) * VBUF + (512 * i_ + wid * 64) * 16), 16, 0, 0); } while (0)
#define AT_STAGE_K(t, bf) do { const bf16* kt_ = u.K + (size_t)(64 * (t)) * u.ks; \
        _Pragma("unroll") for (int i_ = 0; i_ < NKC; ++i_) __builtin_amdgcn_global_load_lds((const unsigned*)(kt_ + kvo[i_]), (LAS unsigned*)(lds + KOFF + (bf) * KBUF + (512 * i_ + wid * 64) * 16), 16, 0, 0); } while (0)
#define AT_STAGE_V(t, bf) do { const bf16* vt_ = u.VT + 64 * (t); \
        _Pragma("unroll") for (int i_ = 0; i_ < NVC; ++i_) __builtin_amdgcn_global_load_lds((const unsigned*)(vt_ + vvo[i_]), (LAS unsigned*)(lds + VOFF + (bf) * VBUF + (512 * i_ + wid * 64) * 16), 16, 0, 0); } while (0)
    float m_run = -1e30f, l_run = 0.f;
    f32x16 o[NDB];
#pragma unroll
    for (int i = 0; i < NDB; ++i)
#pragma unroll
        for (int r = 0; r < 16; ++r) o[i][r] = 0.f;
    const int qa = u.q0 + 32 * g;
    const int qpos = qa + r32;
    const int vswz = (r32 >> 1) & 7;
    int buf = 0;
    if constexpr (ALLSTAGE) {
#pragma unroll
        for (int i = 0; i < 4; ++i) if (u.t_lo + i < u.t_hi) AT_STAGE(u.t_lo + i, i);
        VM_WAIT(); __syncthreads();
    } else if constexpr (PIPE3) {
        AT_STAGE(u.t_lo, 0);
        if (ROT) { if (u.t_lo + 1 < u.t_hi) { AT_STAGE_K(u.t_lo + 1, 1); asm volatile("s_waitcnt vmcnt(%0)" :: "i"(NKC) : "memory"); } else VM_WAIT(); }
        else if (u.t_lo + 1 < u.t_hi) { AT_STAGE(u.t_lo + 1, 1); asm volatile("s_waitcnt vmcnt(%0)" :: "i"(NLD) : "memory"); } else VM_WAIT();
        asm volatile("s_waitcnt lgkmcnt(0)" ::: "memory"); __builtin_amdgcn_s_barrier(); asm volatile("" ::: "memory");
    } else { AT_STAGE(u.t_lo, 0); VM_WAIT(); __syncthreads(); }
    const bool rotw = ROT && kh == 1;
    bf16x8 pa0, pa1; bool pend = false; int pbuf = 0;
#define AT_PV(bi, khx, a0_, a1_) do { int vsw_ = vswz; asm volatile("" : "+v"(vsw_)); const LAS unsigned char* vb_ = lds + VOFF + (bi) * VBUF + r32 * VROW; \
        _Pragma("unroll") for (int ib = 0; ib < NDB; ib += 2) { bf16x8 vf_[2][2]; \
        _Pragma("unroll") for (int i = 0; i < 2; ++i) { vf_[i][0] = *(const LAS bf16x8*)(vb_ + (ib + i) * 32 * VROW + (((4 * (khx) + hi) ^ vsw_) << 4)); vf_[i][1] = *(const LAS bf16x8*)(vb_ + (ib + i) * 32 * VROW + (((4 * (khx) + 2 + hi) ^ vsw_) << 4)); } \
        SBAR(); \
        _Pragma("unroll") for (int i = 0; i < 2; ++i) { o[ib + i] = __builtin_amdgcn_mfma_f32_32x32x16_bf16(a0_, vf_[i][0], o[ib + i], 0, 0, 0); o[ib + i] = __builtin_amdgcn_mfma_f32_32x32x16_bf16(a1_, vf_[i][1], o[ib + i], 0, 0, 0); } \
        SBAR(); } } while (0)
    for (int t = u.t_lo; t < u.t_hi; ++t) {
        if constexpr (PIPE3 && ROT) { if (t + 1 < u.t_hi) AT_STAGE_V(t + 1, buf == 2 ? 0 : buf + 1); if (t + 2 < u.t_hi) AT_STAGE_K(t + 2, buf >= 1 ? buf - 1 : 2); if (rotw && pend) { SBAR(); AT_PV(pbuf, kh, pa0, pa1); SBAR(); } }
        else if constexpr (PIPE3) { if (t + 2 < u.t_hi) AT_STAGE(t + 2, buf >= 1 ? buf - 1 : 2); }
        else if constexpr (!ALLSTAGE) { if (t + 1 < u.t_hi) AT_STAGE(t + 1, buf ^ 1); }
        SBAR();
#pragma unroll
        for (int kk = 0; kk < (PAIR ? 2 : 1); ++kk) {
        const int khv = PAIR ? kk : kh;
        const int krow = 32 * khv + r32, kswz = AT_KSWZ(krow);
        const int kb0 = 64 * t + 32 * khv;
        bool act = true;
#ifndef MK_NOSKIP
        if constexpr (MODE == 1) act = kb0 <= qa + 31;
        if constexpr (MODE == 2) act = (qa + 31 - kb0 >= 0) && (qa - (kb0 + 31) <= 127);
#endif
        if (act) {
            f32x16 p;
#pragma unroll
            for (int r = 0; r < 16; ++r) p[r] = 0.f;
            int ksw = kswz, vsw = vswz; asm volatile("" : "+v"(ksw), "+v"(vsw));
            const LAS unsigned char* kb = lds + KOFF + buf * KBUF + krow * KROW;
            if constexpr (ROT) {
#pragma unroll
              for (int hb = 0; hb < ND0 / 4; ++hb) { bf16x8 kf[4];
#pragma unroll
                for (int d0 = 0; d0 < 4; ++d0) kf[d0] = *(const LAS bf16x8*)(kb + (((2 * (d0 + hb * 4) + hi) ^ ksw) << 4));
                SBAR();
#pragma unroll
                for (int d0 = 0; d0 < 4; ++d0) p = __builtin_amdgcn_mfma_f32_32x32x16_bf16(kf[d0], qr[d0 + hb * 4], p, 0, 0, 0);
                SBAR(); }
            } else
            { bf16x8 kf[ND0];
#pragma unroll
              for (int d0 = 0; d0 < ND0; ++d0) kf[d0] = *(const LAS bf16x8*)(kb + (((2 * d0 + hi) ^ ksw) << 4));
              SBAR();
#pragma unroll
              for (int d0 = 0; d0 < ND0; ++d0) p = __builtin_amdgcn_mfma_f32_32x32x16_bf16(kf[d0], qr[d0], p, 0, 0, 0); }
            const int dq = qpos - kb0 - 4 * hi;
            float pmax = -1e30f, esc = 1.f;
            if (MODE == 1 && kb0 + 31 <= qa) {
#pragma unroll
                for (int r = 0; r < 16; ++r) pmax = fmaxf(pmax, p[r]);
                pmax *= scl2; esc = scl2;
            } else {
#pragma unroll
            for (int r = 0; r < 16; ++r) { const int c = (r & 3) + 8 * (r >> 2); float s = p[r] * scl2;
                if constexpr (MODE == 1) { if (dq - c < 0) s = -__builtin_inff(); }
                if constexpr (MODE == 2) { const int dist = dq - c; const bool ok = (unsigned)dist < 128u; const float bv = bT[ok ? dist : 0]; s = ok ? s + bv : -__builtin_inff(); }
                p[r] = s; pmax = fmaxf(pmax, s); }
            }
#if MK_DEBUG
            if (u.dbg && t == u.t_lo) { for (int r = 0; r < 16; ++r) u.dbg[(wid * 64 + lane) * 16 + r] = p[r]; }
#endif
            const bool keep = __all(pmax - m_run <= 11.5f) != 0;
            float m_new = m_run, alpha = 1.f;
            if (!keep) { pmax = swap_max(pmax); m_new = fmaxf(m_run, pmax); alpha = ex2(m_run - m_new); }
            float ps = 0.f;
#pragma unroll
            for (int r = 0; r < 16; ++r) { p[r] = ex2(__builtin_fmaf(p[r], esc, -m_new)); ps += p[r]; }
            l_run = l_run * alpha + ps; m_run = m_new;
            if (!keep && __any(alpha < 1.f)) {
                if (hi == 0) Al[r32] = alpha;
                LDS_WAIT();
#pragma unroll
                for (int r = 0; r < 16; ++r) { const float a = Al[crow(r, hi)];
#pragma unroll
                    for (int i = 0; i < NDB; ++i) o[i][r] *= a; }
                LDS_WAIT();
            }
            PK4(p, 0, pa0); PK4(p, 8, pa1);
            SBAR();
            if (!rotw) {
            const LAS unsigned char* vb = lds + VOFF + buf * VBUF + r32 * VROW;
            { bf16x8 vf[NDB][2];
#pragma unroll
              for (int i = 0; i < NDB; ++i) { vf[i][0] = *(const LAS bf16x8*)(vb + i * 32 * VROW + (((4 * khv + hi) ^ vsw) << 4)); vf[i][1] = *(const LAS bf16x8*)(vb + i * 32 * VROW + (((4 * khv + 2 + hi) ^ vsw) << 4)); }
              SBAR();
#pragma unroll
              for (int i = 0; i < NDB; ++i) { o[i] = __builtin_amdgcn_mfma_f32_32x32x16_bf16(pa0, vf[i][0], o[i], 0, 0, 0); o[i] = __builtin_amdgcn_mfma_f32_32x32x16_bf16(pa1, vf[i][1], o[i], 0, 0, 0); } }
            }
        }
        if (rotw) { pend = act; pbuf = buf; }
        SBAR();
        }
        if constexpr (ALLSTAGE) { buf += 1; }
        else if constexpr (PIPE3) {
            if (ROT) { if (t + 2 < u.t_hi) asm volatile("s_waitcnt vmcnt(%0)" :: "i"(NKC) : "memory"); else VM_WAIT(); }
            else if (t + 2 < u.t_hi) asm volatile("s_waitcnt vmcnt(%0)" :: "i"(NLD) : "memory"); else VM_WAIT();
            asm volatile("s_waitcnt lgkmcnt(0)" ::: "memory"); __builtin_amdgcn_s_barrier(); asm volatile("" ::: "memory");
            buf = buf == 2 ? 0 : buf + 1; }
        else { VM_WAIT(); __syncthreads(); buf ^= 1; }
    }
    if constexpr (ROT) { if (rotw && pend) AT_PV(pbuf, kh, pa0, pa1); __syncthreads(); }
    if constexpr (ALLSTAGE && !PAIR) __syncthreads();
#undef AT_PV
#undef AT_STAGE_K
#undef AT_STAGE_V
#undef AT_STAGE
#undef AT_KSWZ
#if MK_DEBUG
    if (u.dbg) { u.dbg[8192 + (wid * 64 + lane) * 2] = m_run; u.dbg[8192 + (wid * 64 + lane) * 2 + 1] = l_run;
        for (int i = 0; i < NDB; ++i) for (int r = 0; r < 16; ++r) u.dbg[16384 + ((wid * 64 + lane) * 4 + i) * 16 + r] = o[i][r]; }
#endif
    l_run = swap_sum(l_run);
    if constexpr (PAIR) {
        if (hi == 0) { Ms[wid * 32 + r32] = m_run; Ls[wid * 32 + r32] = l_run; }
        LDS_WAIT();
        const float sk = kh ? u.sinkb : sink2;
#pragma unroll
        for (int r = 0; r < 16; ++r) { const int q = crow(r, hi);
            float L = Ls[wid * 32 + q]; if constexpr (MODE == 2) L += ex2(sk - Ms[wid * 32 + q]);
            const float inv = 1.f / L;
            bf16* orow = u.O + kh * u.oh + (size_t)(32 * g + q) * u.os;
#pragma unroll
            for (int i = 0; i < NDB; ++i) { const float v = o[i][r] * inv; const float vn = __shfl_xor(v, 1);
                if ((r32 & 1) == 0) *(unsigned*)(orow + 32 * i + r32) = pk2(v, vn); }
            SBAR(); }
        __syncthreads();
        return;
    }
    if (hi == 0) { Ms[wid * 32 + r32] = m_run; Ls[wid * 32 + r32] = l_run; }
    if (kh == 1) {
#pragma unroll
        for (int i = 0; i < NDB; ++i)
#pragma unroll
            for (int r = 0; r < 16; ++r) OM[(g * 32 + crow(r, hi)) * DV + 32 * i + r32] = o[i][r];
    }
    LDS_WAIT(); __syncthreads();
    if (kh == 0) {
#pragma unroll
        for (int r = 0; r < 16; ++r) { const int q = crow(r, hi);
            const float m0 = Ms[g * 32 + q], m1 = Ms[(4 + g) * 32 + q], l0 = Ls[g * 32 + q], l1 = Ls[(4 + g) * 32 + q];
            const float mm = fmaxf(m0, m1), a0 = ex2(m0 - mm), a1 = ex2(m1 - mm);
            float L = l0 * a0 + l1 * a1; if constexpr (MODE == 2) L += ex2(sink2 - mm);
            const float inv = 1.f / L;
            bf16* orow = u.O + (size_t)(32 * g + q) * u.os;
#pragma unroll
            for (int i = 0; i < NDB; ++i) { const float v = (o[i][r] * a0 + OM[(g * 32 + q) * DV + 32 * i + r32] * a1) * inv; const float vn = __shfl_xor(v, 1);
                if ((r32 & 1) == 0) *(unsigned*)(orow + 32 * i + r32) = pk2(v, vn); }
            SBAR(); }
    }
    __syncthreads();
}

template <int NC>
__device__ __forceinline__ void transpose_tile64(LAS unsigned char* lds, const bf16* src, int sstr, const float* rowscale, bf16* dst, size_t dstr, int tid) {
    constexpr int CPT = NC / 8;
    const int row = tid >> 3, c0 = (tid & 7) * CPT;
    const float sc = rowscale ? rowscale[row] : 1.f;
#pragma unroll
    for (int i = 0; i < CPT / 8; ++i) { const u32x4 w = *(const u32x4*)(src + (size_t)row * sstr + c0 + 8 * i); const unsigned ww[4] = {w.x, w.y, w.z, w.w};
#pragma unroll
        for (int j = 0; j < 4; ++j) { unsigned lo = ww[j] & 0xffffu, hi = ww[j] >> 16; if (rowscale) { lo = f2bf(bf2f(lo) * sc); hi = f2bf(bf2f(hi) * sc); }
            *(LAS unsigned short*)(lds + (c0 + 8 * i + 2 * j) * 144 + row * 2) = (unsigned short)lo; *(LAS unsigned short*)(lds + (c0 + 8 * i + 2 * j + 1) * 144 + row * 2) = (unsigned short)hi; } }
    LDS_WAIT(); __syncthreads();
    if constexpr (NC == 512) { const int col = tid;
#pragma unroll
        for (int i = 0; i < 8; ++i) *(u32x4*)(dst + (size_t)col * dstr + 8 * i) = *(const LAS u32x4*)(lds + col * 144 + 16 * i); }
    else { const int col = tid >> 2, ch = (tid & 3) * 2;
#pragma unroll
        for (int i = 0; i < 2; ++i) *(u32x4*)(dst + (size_t)col * dstr + 8 * (ch + i)) = *(const LAS u32x4*)(lds + col * 144 + 16 * (ch + i)); }
    __syncthreads();
}

__device__ __forceinline__ void transpose4_tile64x128(LAS unsigned char* lds, const bf16* src, size_t sgap, int sstr, const float* rowscale, bf16* dst, size_t dgap, size_t dstr, int tid) {
    const int row = tid >> 3, c0 = (tid & 7) * 16; const float sc = rowscale ? rowscale[row] : 1.f;
    u32x4 w[4][2];
#pragma unroll
    for (int hh = 0; hh < 4; ++hh)
#pragma unroll
        for (int i = 0; i < 2; ++i) w[hh][i] = *(const u32x4*)(src + hh * sgap + (size_t)row * sstr + c0 + 8 * i);
#pragma unroll
    for (int hh = 0; hh < 4; ++hh)
#pragma unroll
        for (int i = 0; i < 2; ++i) { const unsigned ww[4] = {w[hh][i].x, w[hh][i].y, w[hh][i].z, w[hh][i].w};
#pragma unroll
            for (int j = 0; j < 4; ++j) { unsigned lo = ww[j] & 0xffffu, hi = ww[j] >> 16; if (rowscale) { lo = f2bf(bf2f(lo) * sc); hi = f2bf(bf2f(hi) * sc); }
                *(LAS unsigned short*)(lds + hh * 18432 + (c0 + 8 * i + 2 * j) * 144 + row * 2) = (unsigned short)lo; *(LAS unsigned short*)(lds + hh * 18432 + (c0 + 8 * i + 2 * j + 1) * 144 + row * 2) = (unsigned short)hi; } }
    LDS_WAIT(); __syncthreads();
    const int col = tid >> 2, ch = (tid & 3) * 2;
#pragma unroll
    for (int hh = 0; hh < 4; ++hh)
#pragma unroll
        for (int i = 0; i < 2; ++i) *(u32x4*)(dst + hh * dgap + (size_t)col * dstr + 8 * (ch + i)) = *(const LAS u32x4*)(lds + hh * 18432 + col * 144 + 16 * (ch + i));
    __syncthreads();
}

__device__ __forceinline__ void p_prep(Frame& F, int l) {
    bf16* U = (bf16*)(F.ws + WS_OVL + OV_U); bf16* SVT = (bf16*)(F.ws + WS_OVL + OV_SVT);
    float* rcq = (float*)(F.ws + WS_SMALL + SM_RSTDCQ); float* rckv = (float*)(F.ws + WS_SMALL + SM_RSTDCKV);
    const float* gq = F.in[6] + l * 64; const float* gk = F.in[7] + l * 64;
    const int lane = F.lane;
    for (int tile = F.bid; tile < NTOK / 64; tile += F.G) {
        {
            const int rowb = tile * 64 + F.wave * 8; const int l16 = lane & 15;
            u32x4 wq[8], wk[8], wc[8]; u32x2 wv[8];
#pragma unroll
            for (int rr = 0; rr < 8; ++rr) { const bf16* up = U + (size_t)(rowb + rr) * UW;
                wq[rr] = *(const u32x4*)(up + C_SQ + 8 * lane); wk[rr] = *(const u32x4*)(up + C_SK + 8 * l16); wc[rr] = *(const u32x4*)(up + C_CQ + 8 * lane); wv[rr] = *(const u32x2*)(up + C_CKV + 4 * lane); }
#pragma unroll
            for (int rr = 0; rr < 8; ++rr) { const int row = rowb + rr; bf16* up = U + (size_t)row * UW;
                { const unsigned ww[4] = {wq[rr].x, wq[rr].y, wq[rr].z, wq[rr].w}; float v[8]; float ss = 0.f;
#pragma unroll
                  for (int j = 0; j < 4; ++j) { v[2 * j] = bflo(ww[j]); v[2 * j + 1] = bfhi(ww[j]); ss += v[2 * j] * v[2 * j] + v[2 * j + 1] * v[2 * j + 1]; }
                  ss += __shfl_xor(ss, 1); ss += __shfl_xor(ss, 2); ss += __shfl_xor(ss, 4);
                  const float rstd = __builtin_amdgcn_rsqf(ss * (1.f / 64) + EPS); const float* gp = gq + (lane & 7) * 8;
                  u32x4 o; o.x = pk2(v[0] * rstd * gp[0], v[1] * rstd * gp[1]); o.y = pk2(v[2] * rstd * gp[2], v[3] * rstd * gp[3]); o.z = pk2(v[4] * rstd * gp[4], v[5] * rstd * gp[5]); o.w = pk2(v[6] * rstd * gp[6], v[7] * rstd * gp[7]);
                  *(u32x4*)(up + C_SQ + 8 * lane) = o; }
                { const unsigned ww[4] = {wk[rr].x, wk[rr].y, wk[rr].z, wk[rr].w}; float v[8]; float ss = 0.f;
#pragma unroll
                  for (int j = 0; j < 4; ++j) { v[2 * j] = bflo(ww[j]); v[2 * j + 1] = bfhi(ww[j]); ss += v[2 * j] * v[2 * j] + v[2 * j + 1] * v[2 * j + 1]; }
                  ss += __shfl_xor(ss, 1); ss += __shfl_xor(ss, 2); ss += __shfl_xor(ss, 4);
                  const float rstd = __builtin_amdgcn_rsqf(ss * (1.f / 64) + EPS); const float* gp = gk + (lane & 7) * 8;
                  u32x4 o; o.x = pk2(v[0] * rstd * gp[0], v[1] * rstd * gp[1]); o.y = pk2(v[2] * rstd * gp[2], v[3] * rstd * gp[3]); o.z = pk2(v[4] * rstd * gp[4], v[5] * rstd * gp[5]); o.w = pk2(v[6] * rstd * gp[6], v[7] * rstd * gp[7]);
                  if (lane < 16) *(u32x4*)(up + C_SK + 8 * l16) = o; }
                { const unsigned ww[4] = {wc[rr].x, wc[rr].y, wc[rr].z, wc[rr].w}; float ss = 0.f;
#pragma unroll
                  for (int j = 0; j < 4; ++j) { const float a_ = bflo(ww[j]), b_ = bfhi(ww[j]); ss += a_ * a_ + b_ * b_; }
                  ss = wave_sum(ss); if (lane == 0) rcq[row] = __builtin_amdgcn_rsqf(ss * (1.f / 512) + EPS); }
                { const u32x2 w = wv[rr]; float ss = bflo(w.x) * bflo(w.x) + bfhi(w.x) * bfhi(w.x) + bflo(w.y) * bflo(w.y) + bfhi(w.y) * bfhi(w.y);
                  ss = wave_sum(ss); if (lane == 0) rckv[row] = __builtin_amdgcn_rsqf(ss * (1.f / 256) + EPS); }
            }
        }
        const int b = tile >> 6, s0 = (tile & 63) * 64;
        transpose_tile64<128>(F.lds, U + (size_t)tile * 64 * UW + C_SV, UW, nullptr, SVT + (size_t)b * 128 * SEQ + s0, SEQ, F.tid);
    }
}

__device__ __forceinline__ void p_mla_post(Frame& F, int l) {
    const bf16* U = (const bf16*)(F.ws + WS_OVL + OV_U); const bf16* QM = (const bf16*)(F.ws + WS_OVL + OV_QM); const bf16* KVM = (const bf16*)(F.ws + WS_OVL + OV_KVM);
    bf16* QF = (bf16*)(F.ws + WS_OVL + OV_QF); bf16* KF = (bf16*)(F.ws + WS_OVL + OV_KF); bf16* VT = (bf16*)(F.ws + WS_OVL + OV_VT);
    const float* rcq = (const float*)(F.ws + WS_SMALL + SM_RSTDCQ); const float* rckv = (const float*)(F.ws + WS_SMALL + SM_RSTDCKV);
    const float* rope = (const float*)(F.ws + WS_ROPE);
    const float* gq = F.in[14] + l * 192; const float* gk = F.in[15] + l * 192;
    const int lane = F.lane, h = lane >> 4, lh = lane & 15;
    for (int tile = F.bid; tile < NTOK / 64; tile += F.G) {
        for (int r4 = 0; r4 < 8; r4 += 4) {
            const int rowb = tile * 64 + F.wave * 8 + r4;
            f32x4 csv[4]; u32x4 wn[4][2]; unsigned ra[4][2], rb[4][2]; float scq[4], sck[4];
#pragma unroll
            for (int rr = 0; rr < 4; ++rr) { const int row = rowb + rr, s = row & 4095;
                csv[rr] = *(const f32x4*)(rope + ((size_t)s * 32 + 2 * lh) * 2);
                const bf16* qp = QM + (size_t)row * 768 + h * 192; const bf16* kp = KVM + (size_t)row * 1024 + h * 256; const bf16* kr = U + (size_t)row * UW + C_KR;
                wn[rr][0] = *(const u32x4*)(qp + 8 * lh); wn[rr][1] = *(const u32x4*)(kp + 8 * lh);
                ra[rr][0] = *(const unsigned*)(qp + 128 + 2 * lh); rb[rr][0] = *(const unsigned*)(qp + 160 + 2 * lh);
                ra[rr][1] = *(const unsigned*)(kr + 2 * lh); rb[rr][1] = *(const unsigned*)(kr + 32 + 2 * lh);
                scq[rr] = rcq[row]; sck[rr] = rckv[row]; }
#pragma unroll
            for (int rr = 0; rr < 4; ++rr) { const int row = rowb + rr, b = row >> 12, s = row & 4095; const f32x4 cs = csv[rr];
#pragma unroll
            for (int which = 0; which < 2; ++which) {
                const float sc = which == 0 ? scq[rr] : sck[rr], scr = which == 0 ? sc : 1.f;
                const float* gg = which == 0 ? gq : gk;
                const u32x4 w = wn[rr][which]; const unsigned ww[4] = {w.x, w.y, w.z, w.w};
                const unsigned r1 = ra[rr][which], r2 = rb[rr][which];
                float v[8]; float ss = 0.f;
#pragma unroll
                for (int j = 0; j < 4; ++j) { v[2 * j] = bflo(ww[j]) * sc; v[2 * j + 1] = bfhi(ww[j]) * sc; ss += v[2 * j] * v[2 * j] + v[2 * j + 1] * v[2 * j + 1]; }
                float x1a = bflo(r1) * scr, x1b = bfhi(r1) * scr, x2a = bflo(r2) * scr, x2b = bfhi(r2) * scr;
                ss += x1a * x1a + x1b * x1b + x2a * x2a + x2b * x2b;
                ss += __shfl_xor(ss, 1); ss += __shfl_xor(ss, 2); ss += __shfl_xor(ss, 4); ss += __shfl_xor(ss, 8);
                const float rstd = __builtin_amdgcn_rsqf(ss * (1.f / 192) + EPS);
                const float* g8 = gg + 8 * lh;
                u32x4 o; o.x = pk2(v[0] * rstd * g8[0], v[1] * rstd * g8[1]); o.y = pk2(v[2] * rstd * g8[2], v[3] * rstd * g8[3]); o.z = pk2(v[4] * rstd * g8[4], v[5] * rstd * g8[5]); o.w = pk2(v[6] * rstd * g8[6], v[7] * rstd * g8[7]);
                x1a *= rstd * gg[128 + 2 * lh]; x1b *= rstd * gg[128 + 2 * lh + 1]; x2a *= rstd * gg[160 + 2 * lh]; x2b *= rstd * gg[160 + 2 * lh + 1];
                const float o1a = x1a * cs[0] - x2a * cs[1], o2a = x1a * cs[1] + x2a * cs[0], o1b = x1b * cs[2] - x2b * cs[3], o2b = x1b * cs[3] + x2b * cs[2];
                bf16* op = (which == 0 ? QF : KF) + ((size_t)(b * 4 + h) * SEQ + s) * 192;
                *(u32x4*)(op + 8 * lh) = o; *(unsigned*)(op + 128 + 2 * lh) = pk2(o1a, o1b); *(unsigned*)(op + 160 + 2 * lh) = pk2(o2a, o2b);
            } } }
        const int b = tile >> 6, s0 = (tile & 63) * 64;
        transpose4_tile64x128(F.lds, KVM + (size_t)tile * 64 * 1024 + 128, 256, 1024, rckv + tile * 64, VT + ((size_t)(b * 4) * 128) * SEQ + s0, (size_t)128 * SEQ, SEQ, F.tid);
    }
}

__device__ __forceinline__ void p_mem_post(Frame& F) {
    const int lane = F.lane, h = lane >> 4, lh = lane & 15;
    for (int unit = F.bid; unit < 32; unit += F.G) { const int l = unit >> 4, tile = unit & 15;
        const bf16* MKV = (const bf16*)(F.ws + WS_MKV) + (size_t)l * 1024 * 1024; bf16* MK = (bf16*)(F.ws + WS_MK) + (size_t)l * 1024 * 512; bf16* MVT = (bf16*)(F.ws + WS_MVT) + (size_t)l * 1024 * 512;
        const float* gk = F.in[22] + l * 128;
        for (int rr = 0; rr < 8; ++rr) { const int row = tile * 64 + F.wave * 8 + rr, b = row >> 8, m = row & 255;
            const u32x4 w = *(const u32x4*)(MKV + (size_t)row * 1024 + h * 128 + 8 * lh); const unsigned ww[4] = {w.x, w.y, w.z, w.w}; float v[8]; float ss = 0.f;
#pragma unroll
            for (int j = 0; j < 4; ++j) { v[2 * j] = bflo(ww[j]); v[2 * j + 1] = bfhi(ww[j]); ss += v[2 * j] * v[2 * j] + v[2 * j + 1] * v[2 * j + 1]; }
            ss += __shfl_xor(ss, 1); ss += __shfl_xor(ss, 2); ss += __shfl_xor(ss, 4); ss += __shfl_xor(ss, 8);
            const float rstd = __builtin_amdgcn_rsqf(ss * (1.f / 128) + EPS); const float* g8 = gk + 8 * lh;
            u32x4 o; o.x = pk2(v[0] * rstd * g8[0], v[1] * rstd * g8[1]); o.y = pk2(v[2] * rstd * g8[2], v[3] * rstd * g8[3]); o.z = pk2(v[4] * rstd * g8[4], v[5] * rstd * g8[5]); o.w = pk2(v[6] * rstd * g8[6], v[7] * rstd * g8[7]);
            *(u32x4*)(MK + ((size_t)(b * 4 + h) * 256 + m) * 128 + 8 * lh) = o; }
        const int b = tile >> 2, m0 = (tile & 3) * 64;
        for (int hh = 0; hh < 4; ++hh)
            transpose_tile64<128>(F.lds, MKV + (size_t)tile * 64 * 1024 + 512 + hh * 128, 1024, nullptr, MVT + ((size_t)(b * 4 + hh) * 128) * 256 + m0, 256, F.tid);
    }
}

constexpr int HG_QH = 0, HG_KH = 64 * 272, HG_KT = 2 * 64 * 272, HG_VT = HG_KT + 128 * 144, HG_TOT = HG_VT + 128 * 144;
__device__ __forceinline__ void p_hgrn1(Frame& F, int l) {
    const bf16* U = (const bf16*)(F.ws + WS_OVL + OV_U); bf16* QT = (bf16*)(F.ws + WS_OVL + OV_QT); bf16* INTRA = (bf16*)(F.ws + WS_OVL + OV_INTRA); bf16* UT = (bf16*)(F.ws + WS_OVL + OV_UT);
    float* DEC = (float*)(F.ws + WS_OVL + OV_DEC); const float* lb = (const float*)(F.ws + WS_SMALL + SM_LB) + l * 1024;
    LAS unsigned char* lds = F.lds; LAS float* tot = (LAS float*)(lds + HG_TOT);
    const int tid = F.tid, lane = F.lane, wid = F.wave, r32 = lane & 31, hi = lane >> 5;
    const int cp = tid & 63, part = tid >> 6;
    unsigned fw[8], qw[8], vw[8];
#define H1_LOAD(un) do { const int b_ = (un) >> 9, h_ = ((un) >> 6) & 7, c_ = (un) & 63; const bf16* base = U + (size_t)(b_ * SEQ + 64 * c_ + 8 * part) * UW + h_ * 128 + 2 * cp; \
        _Pragma("unroll") for (int i = 0; i < 8; ++i) { fw[i] = *(const unsigned*)(base + (size_t)i * UW + C_HF); qw[i] = *(const unsigned*)(base + (size_t)i * UW + C_HQ); vw[i] = *(const unsigned*)(base + (size_t)i * UW + C_HI); } } while (0)
    if (F.bid < 2048) H1_LOAD(F.bid);
    for (int unit = F.bid; unit < 2048; unit += F.G) {
        const int b = unit >> 9, h = (unit >> 6) & 7, c = unit & 63, row0 = b * SEQ + 64 * c;
        const float lb0 = lb[h * 128 + 2 * cp], lb1 = lb[h * 128 + 2 * cp + 1];
        float cs0[8], cs1[8], kin0[8], kin1[8]; float run0 = 0.f, run1 = 0.f;
#pragma unroll
        for (int i = 0; i < 8; ++i) { const float f0 = bflo(fw[i]), f1 = bfhi(fw[i]);
            const float sg0 = __builtin_amdgcn_rcpf(1.f + fexp(-f0)), sg1 = __builtin_amdgcn_rcpf(1.f + fexp(-f1));
            run0 += flog(lb0 + (1.f - lb0) * sg0); run1 += flog(lb1 + (1.f - lb1) * sg1); cs0[i] = run0; cs1[i] = run1;
            kin0[i] = (1.f - lb0) * (1.f - sg0); kin1[i] = (1.f - lb1) * (1.f - sg1); }
        tot[part * 128 + 2 * cp] = run0; tot[part * 128 + 2 * cp + 1] = run1;
        BAR_LDS();
        float off0 = 0.f, off1 = 0.f, rr0 = 0.f, rr1 = 0.f, bt0 = 0.f, bt1 = 0.f;
#pragma unroll
        for (int p = 0; p < 8; ++p) { const float t0 = tot[p * 128 + 2 * cp], t1 = tot[p * 128 + 2 * cp + 1];
            if (p < part) { off0 += t0; off1 += t1; } if (p < 4) { rr0 += t0; rr1 += t1; } bt0 += t0; bt1 += t1; }
        const float er0 = fexp(rr0), er1 = fexp(rr1), eb0 = fexp(bt0 - rr0), eb1 = fexp(bt1 - rr1);
        unsigned ktw0[4], ktw1[4], vtw0[4], vtw1[4]; float kp0 = 0.f, kp1 = 0.f; unsigned vp0 = 0u, vp1 = 0u;
#pragma unroll
        for (int i = 0; i < 8; ++i) { const int s = 8 * part + i;
            const float E0 = fexp(off0 + cs0[i] - rr0), E1 = fexp(off1 + cs1[i] - rr1), I0 = __builtin_amdgcn_rcpf(E0), I1 = __builtin_amdgcn_rcpf(E1);
            const float qh0 = bflo(qw[i]) * E0, qh1 = bfhi(qw[i]) * E1, kh0 = kin0[i] * I0, kh1 = kin1[i] * I1;
            *(LAS unsigned*)(lds + HG_QH + s * 272 + cp * 4) = pk2(qh0, qh1);
            *(LAS unsigned*)(lds + HG_KH + s * 272 + cp * 4) = pk2(kh0, kh1);
            *(unsigned*)(QT + (size_t)(row0 + s) * 1024 + h * 128 + 2 * cp) = pk2(qh0 * er0, qh1 * er1);
            const float kt0 = kh0 * eb0, kt1 = kh1 * eb1; const unsigned v0 = vw[i] & 0xffffu, v1 = vw[i] >> 16;
            if (i & 1) { ktw0[i >> 1] = pk2(kp0, kt0); ktw1[i >> 1] = pk2(kp1, kt1); vtw0[i >> 1] = vp0 | (v0 << 16); vtw1[i >> 1] = vp1 | (v1 << 16); }
            else { kp0 = kt0; kp1 = kt1; vp0 = v0; vp1 = v1; } }
        SBAR();
        if (unit + F.G < 2048) H1_LOAD(unit + F.G);
        SBAR();
        *(LAS u32x4*)(lds + HG_KT + (2 * cp) * 144 + part * 16) = (u32x4){ktw0[0], ktw0[1], ktw0[2], ktw0[3]};
        *(LAS u32x4*)(lds + HG_KT + (2 * cp + 1) * 144 + part * 16) = (u32x4){ktw1[0], ktw1[1], ktw1[2], ktw1[3]};
        *(LAS u32x4*)(lds + HG_VT + (2 * cp) * 144 + part * 16) = (u32x4){vtw0[0], vtw0[1], vtw0[2], vtw0[3]};
        *(LAS u32x4*)(lds + HG_VT + (2 * cp + 1) * 144 + part * 16) = (u32x4){vtw1[0], vtw1[1], vtw1[2], vtw1[3]};
        if (part == 0) { DEC[unit * 128 + 2 * cp] = er0 * eb0; DEC[unit * 128 + 2 * cp + 1] = er1 * eb1; }
        BAR_LDS();
        const int tb = wid >> 2, vb = wid & 3;
        bf16x8 pa[2][2];
#pragma unroll
        for (int sb = 0; sb < 2; ++sb) {
            if (sb <= tb) {
                f32x16 p;
#pragma unroll
                for (int r = 0; r < 16; ++r) p[r] = 0.f;
#pragma unroll
                for (int d0 = 0; d0 < 8; ++d0) { const bf16x8 a = *(const LAS bf16x8*)(lds + HG_KH + (32 * sb + r32) * 272 + (16 * d0 + 8 * hi) * 2), bq = *(const LAS bf16x8*)(lds + HG_QH + (32 * tb + r32) * 272 + (16 * d0 + 8 * hi) * 2);
                    p = __builtin_amdgcn_mfma_f32_32x32x16_bf16(a, bq, p, 0, 0, 0); }
#pragma unroll
                for (int r = 0; r < 16; ++r) { const int s = 32 * sb + crow(r, hi), t = 32 * tb + r32; if (s > t) p[r] = 0.f; }
                PK4(p, 0, pa[sb][0]); PK4(p, 8, pa[sb][1]);
            }
        }
        { f32x16 o;
#pragma unroll
          for (int r = 0; r < 16; ++r) o[r] = 0.f;
#pragma unroll
          for (int sb = 0; sb < 2; ++sb) if (sb <= tb) {
#pragma unroll
              for (int ks = 0; ks < 2; ++ks) { const bf16x8 bv = *(const LAS bf16x8*)(lds + HG_VT + (32 * vb + r32) * 144 + (32 * sb + 16 * ks + 8 * hi) * 2);
                  o = __builtin_amdgcn_mfma_f32_32x32x16_bf16(pa[sb][ks], bv, o, 0, 0, 0); } }
#pragma unroll
          for (int r = 0; r < 16; ++r) { const int t = 32 * tb + crow(r, hi); const float v = o[r], vn = __shfl_xor(v, 1);
              if ((r32 & 1) == 0) *(unsigned*)(INTRA + (size_t)(row0 + t) * 1024 + h * 128 + 32 * vb + r32) = pk2(v, vn); } }
#pragma unroll
        for (int j = 0; j < 2; ++j) { const int kbk = 2 * tb + j; f32x16 a2;
#pragma unroll
            for (int r = 0; r < 16; ++r) a2[r] = 0.f;
#pragma unroll
            for (int ks = 0; ks < 4; ++ks) { const bf16x8 av = *(const LAS bf16x8*)(lds + HG_VT + (32 * vb + r32) * 144 + (16 * ks + 8 * hi) * 2), bk = *(const LAS bf16x8*)(lds + HG_KT + (32 * kbk + r32) * 144 + (16 * ks + 8 * hi) * 2);
                a2 = __builtin_amdgcn_mfma_f32_32x32x16_bf16(av, bk, a2, 0, 0, 0); }
#pragma unroll
            for (int r = 0; r < 16; ++r) { const int v = 32 * vb + crow(r, hi); const float x = a2[r], xn = __shfl_xor(x, 1);
                if ((r32 & 1) == 0) *(unsigned*)(UT + ((size_t)unit * 128 + v) * 128 + 32 * kbk + r32) = pk2(x, xn); } }
        BAR_LDS();
    }
}
__device__ __forceinline__ void p_hgrn2(Frame& F) {
    bf16* UT = (bf16*)(F.ws + WS_OVL + OV_UT); const float* DEC = (const float*)(F.ws + WS_OVL + OV_DEC);
    for (int id = F.bid * NTHR + F.tid; id < 32 * 4096; id += F.G * NTHR) {
        const int bh = id >> 12, rem = id & 4095, v = rem >> 5, k4 = rem & 31;
        float st[4] = {0.f, 0.f, 0.f, 0.f};
        for (int c0 = 0; c0 < 64; c0 += 8) {
            u32x2 uu[8]; f32x4 dd[8];
#pragma unroll
            for (int j = 0; j < 8; ++j) { const size_t un = (size_t)bh * 64 + c0 + j; uu[j] = *(const u32x2*)(UT + (un * 128 + v) * 128 + 4 * k4); dd[j] = *(const f32x4*)(DEC + un * 128 + 4 * k4); }
#pragma unroll
            for (int j = 0; j < 8; ++j) { const size_t un = (size_t)bh * 64 + c0 + j;
                u32x2 o; o.x = pk2(st[0], st[1]); o.y = pk2(st[2], st[3]); *(u32x2*)(UT + (un * 128 + v) * 128 + 4 * k4) = o;
                st[0] = st[0] * dd[j][0] + bflo(uu[j].x); st[1] = st[1] * dd[j][1] + bfhi(uu[j].x); st[2] = st[2] * dd[j][2] + bflo(uu[j].y); st[3] = st[3] * dd[j][3] + bfhi(uu[j].y); }
        }
    }
}
__device__ __forceinline__ void p_hgrn3(Frame& F, int l) {
    const bf16* U = (const bf16*)(F.ws + WS_OVL + OV_U); const bf16* QT = (const bf16*)(F.ws + WS_OVL + OV_QT); const bf16* INTRA = (const bf16*)(F.ws + WS_OVL + OV_INTRA); const bf16* UT = (const bf16*)(F.ws + WS_OVL + OV_UT);
    bf16* MIX = (bf16*)(F.ws + WS_OVL + OV_MIX); const float* gout = F.in[9] + l * 128;
    LAS float* OL = (LAS float*)F.lds;
    const int tid = F.tid, lane = F.lane, wid = F.wave, r32 = lane & 31, hi = lane >> 5, tb = wid >> 2, vb = wid & 3;
    bf16x8 fa[8], fb[8];
#define H3_FRAGS(unit_) do { const int b_ = (unit_) >> 9, h_ = ((unit_) >> 6) & 7, c_ = (unit_) & 63, row0_ = b_ * SEQ + 64 * c_; \
        const bf16* ap_ = QT + (size_t)(row0_ + 32 * tb + r32) * 1024 + h_ * 128 + 8 * hi; const bf16* bp_ = UT + ((size_t)(unit_) * 128 + 32 * vb + r32) * 128 + 8 * hi; \
        _Pragma("unroll") for (int ks = 0; ks < 8; ++ks) { fa[ks] = *(const bf16x8*)(ap_ + 16 * ks); fb[ks] = *(const bf16x8*)(bp_ + 16 * ks); } } while (0)
    if (F.bid < 2048) H3_FRAGS(F.bid);
    for (int unit = F.bid; unit < 2048; unit += F.G) {
        const int b = unit >> 9, h = (unit >> 6) & 7, c = unit & 63, row0 = b * SEQ + 64 * c;
        const int t = tid >> 3, j = tid & 7; const size_t row = (size_t)(row0 + t);
        const u32x4 i0 = *(const u32x4*)(INTRA + row * 1024 + h * 128 + 16 * j), i1 = *(const u32x4*)(INTRA + row * 1024 + h * 128 + 16 * j + 8);
        const u32x4 g0 = *(const u32x4*)(U + row * UW + C_HG + h * 128 + 16 * j), g1 = *(const u32x4*)(U + row * UW + C_HG + h * 128 + 16 * j + 8);
        f32x16 acc;
#pragma unroll
        for (int r = 0; r < 16; ++r) acc[r] = 0.f;
#pragma unroll
        for (int ks = 0; ks < 8; ++ks) acc = __builtin_amdgcn_mfma_f32_32x32x16_bf16(fa[ks], fb[ks], acc, 0, 0, 0);
#pragma unroll
        for (int r = 0; r < 16; ++r) OL[(32 * tb + crow(r, hi)) * 132 + 32 * vb + r32] = acc[r];
        SBAR();
        if (unit + F.G < 2048) H3_FRAGS(unit + F.G);
        SBAR();
        BAR_LDS();
        { const unsigned iw[8] = {i0.x, i0.y, i0.z, i0.w, i1.x, i1.y, i1.z, i1.w}, gw[8] = {g0.x, g0.y, g0.z, g0.w, g1.x, g1.y, g1.z, g1.w};
          float o[16]; float ss = 0.f;
#pragma unroll
          for (int i = 0; i < 4; ++i) { const f32x4 x = *(const LAS f32x4*)(OL + t * 132 + 16 * j + 4 * i);
              o[4 * i] = x[0] + bflo(iw[2 * i]); o[4 * i + 1] = x[1] + bfhi(iw[2 * i]); o[4 * i + 2] = x[2] + bflo(iw[2 * i + 1]); o[4 * i + 3] = x[3] + bfhi(iw[2 * i + 1]); }
#pragma unroll
          for (int i = 0; i < 16; ++i) ss += o[i] * o[i];
          ss += __shfl_xor(ss, 1); ss += __shfl_xor(ss, 2); ss += __shfl_xor(ss, 4);
          const float rstd = __builtin_amdgcn_rsqf(ss * (1.f / 128) + EPS);
          unsigned ow[8];
#pragma unroll
          for (int i = 0; i < 8; ++i) { const float ga = bflo(gw[i]), gb = bfhi(gw[i]);
              const float ya = o[2 * i] * rstd * gout[16 * j + 2 * i] * ga * __builtin_amdgcn_rcpf(1.f + fexp(-ga)), yb = o[2 * i + 1] * rstd * gout[16 * j + 2 * i + 1] * gb * __builtin_amdgcn_rcpf(1.f + fexp(-gb));
              ow[i] = pk2(ya, yb); }
          bf16* op = MIX + row * D + 512 + h * 128 + 16 * j;
          *(u32x4*)op = (u32x4){ow[0], ow[1], ow[2], ow[3]}; *(u32x4*)(op + 8) = (u32x4){ow[4], ow[5], ow[6], ow[7]}; }
        BAR_LDS();
    }
#undef H3_FRAGS
}

constexpr int RT_CK = 128, RT_ROWB = RT_CK * 2 + 16, RT_WBUF = 2 * 80 * RT_ROWB, RT_LG = 2 * RT_WBUF;
__device__ __forceinline__ void p_router(Frame& F, int l) {
    const bf16* x = (const bf16*)(F.ws + WS_HN); const float* bgr = F.in[26] + l * 8; const float* ber = F.in[28] + l * 64;
    const bf16* rw = (const bf16*)(F.ws + WS_SMALL + SM_RW) + (size_t)l * 2 * 80 * D;
    float* rstdo = (float*)(F.ws + WS_SMALL + SM_RSTDFFN); int* eidx = (int*)(F.ws + WS_SMALL + SM_EIDX); float* gate = (float*)(F.ws + WS_SMALL + SM_GATE); int* slot = (int*)(F.ws + WS_SMALL + SM_SLOT);
    unsigned* cnt = F.ctl + CW_CNT + l * 64 * 64; int* rt2 = (int*)(F.ws + WS_OVL + OV_XG); float* rs2 = (float*)(F.ws + WS_OVL + OV_XG + RS2_OFF);
    LAS unsigned char* WB = F.lds; LAS float* LG = (LAS float*)(F.lds + RT_LG + F.wave * (16 * 84 * 4));
    const int tid = F.tid, lane = F.lane, c = lane & 15, q = lane >> 4, wv = F.wave;
    const int srow = tid >> 4, sck = tid & 15;
    for (int tg = F.bid; tg < NTOK / 64; tg += F.G) {
        u32x4 wA[5], wB[5];
#define RT_WLOAD(w_, ch) do { _Pragma("unroll") for (int e = 0; e < 5; ++e) w_[e] = *(const u32x4*)(rw + (size_t)(srow + 32 * e) * D + RT_CK * (ch) + sck * 8); } while (0)
#define RT_WSTORE(w_, bf) do { _Pragma("unroll") for (int e = 0; e < 5; ++e) *(LAS u32x4*)(WB + (bf) * RT_WBUF + (srow + 32 * e) * RT_ROWB + sck * 16) = w_[e]; } while (0)
#define RT_XLOAD(x_, ch) do { if (wv < 4) { _Pragma("unroll") for (int i = 0; i < 4; ++i) x_[i] = *(const bf16x8*)(xp + RT_CK * (ch) + 32 * i); } } while (0)
        f32x4 acc[5];
#pragma unroll
        for (int i = 0; i < 5; ++i) acc[i] = (f32x4){0.f, 0.f, 0.f, 0.f};
        float ss = 0.f;
        const bf16* xp = x + (size_t)(tg * 64 + (wv & 3) * 16 + c) * D + 8 * q;
        bf16x8 xv[4], xA[4], xB[4];
        RT_WLOAD(wB, 0); RT_XLOAD(xv, 0);
        RT_WLOAD(wA, 1); RT_XLOAD(xA, 1);
        SBAR();
        RT_WSTORE(wB, 0); BAR_LDS();
#define RT_COMPUTE(bf) do { if (wv < 4) { const LAS unsigned char* wb = WB + (bf) * RT_WBUF + c * RT_ROWB + q * 16; \
            _Pragma("unroll") for (int i = 0; i < 4; ++i) { \
                _Pragma("unroll") for (int j = 0; j < 8; ++j) { const float xf = bf2f((unsigned short)xv[i][j]); ss += xf * xf; } \
                bf16x8 bh[5], bl[5]; \
                _Pragma("unroll") for (int ct = 0; ct < 5; ++ct) { bh[ct] = *(const LAS bf16x8*)(wb + (16 * ct) * RT_ROWB + i * 64); bl[ct] = *(const LAS bf16x8*)(wb + (80 + 16 * ct) * RT_ROWB + i * 64); } \
                SBAR(); \
                _Pragma("unroll") for (int ct = 0; ct < 5; ++ct) { acc[ct] = __builtin_amdgcn_mfma_f32_16x16x32_bf16(xv[i], bh[ct], acc[ct], 0, 0, 0); acc[ct] = __builtin_amdgcn_mfma_f32_16x16x32_bf16(xv[i], bl[ct], acc[ct], 0, 0, 0); } \
                SBAR(); } } } while (0)
#pragma nounroll
        for (int ch = 0; ch < D / RT_CK; ch += 2) {
            if (ch + 2 < D / RT_CK) { RT_WLOAD(wB, ch + 2); RT_XLOAD(xB, ch + 2); }
            SBAR();
            RT_COMPUTE(0);
            SBAR();
            RT_WSTORE(wA, 1);
            if (wv < 4) {
#pragma unroll
                for (int i = 0; i < 4; ++i) xv[i] = xA[i]; }
            BAR_LDS();
            if (ch + 3 < D / RT_CK) { RT_WLOAD(wA, ch + 3); RT_XLOAD(xA, ch + 3); }
            SBAR();
            RT_COMPUTE(1);
            SBAR();
            if (ch + 2 < D / RT_CK) { RT_WSTORE(wB, 0);
                if (wv < 4) {
#pragma unroll
                    for (int i = 0; i < 4; ++i) xv[i] = xB[i]; } }
            BAR_LDS();
        }
#undef RT_COMPUTE
#undef RT_XLOAD
#undef RT_WLOAD
#undef RT_WSTORE
        if (wv < 4) {
            ss += __shfl_xor(ss, 16); ss += __shfl_xor(ss, 32);
            const float rstd = __builtin_amdgcn_rsqf(ss * (1.f / D) + EPS);
#pragma unroll
            for (int ct = 0; ct < 5; ++ct)
#pragma unroll
                for (int r = 0; r < 4; ++r) LG[(4 * q + r) * 84 + 16 * ct + c] = acc[ct][r];
            LDS_WAIT();
            if (lane < 16) {
                const int tok = tg * 64 + wv * 16 + lane; const LAS float* lg = LG + lane * 84;
                float gl[8]; float gm = -3.4e38f; int grp = 0;
#pragma unroll
                for (int j = 0; j < 8; ++j) { gl[j] = lg[j] * rstd + bgr[j]; if (gl[j] > gm) { gm = gl[j]; grp = j; } }
                float gs = 0.f;
#pragma unroll
                for (int j = 0; j < 8; ++j) gs += expf(gl[j] - gm);
                const float pgrp = 1.f / gs;
                float el[8]; float e1 = -3.4e38f; int i1 = 0;
#pragma unroll
                for (int j = 0; j < 8; ++j) { el[j] = lg[16 + grp * 8 + j] * rstd + ber[grp * 8 + j]; if (el[j] > e1) { e1 = el[j]; i1 = j; } }
                float e2 = -3.4e38f; int i2 = 0;
#pragma unroll
                for (int j = 0; j < 8; ++j) if (j != i1 && el[j] > e2) { e2 = el[j]; i2 = j; }
                const float r21 = expf(e2 - e1), g1 = pgrp / (1.f + r21), g2 = pgrp * r21 / (1.f + r21);
                const int ex1 = grp * 8 + i1, ex2_ = grp * 8 + i2;
                const int s1 = (int)atomicAdd(cnt + ex1 * 64, 1u), s2 = (int)atomicAdd(cnt + ex2_ * 64, 1u);
                rt2[ex1 * RT_CAP + s1] = tok; rt2[ex2_ * RT_CAP + s2] = tok; rs2[ex1 * RT_CAP + s1] = rstd; rs2[ex2_ * RT_CAP + s2] = rstd;
                rstdo[tok] = rstd; eidx[2 * tok] = ex1; eidx[2 * tok + 1] = ex2_; gate[2 * tok] = g1; gate[2 * tok + 1] = g2; slot[2 * tok] = s1; slot[2 * tok + 1] = s2;
            }
            LDS_WAIT();
        }
        __syncthreads();
    }
}
__device__ __forceinline__ void p_gather(Frame& F, int l) {
    const int* eidx = (const int*)(F.ws + WS_SMALL + SM_EIDX); const int* slot = (const int*)(F.ws + WS_SMALL + SM_SLOT);
    int* arow = (int*)(F.ws + WS_SMALL + SM_AROW); int* rowtok = (int*)(F.ws + WS_SMALL + SM_ROWTOK);
    const unsigned* cnt = F.ctl + CW_CNT + l * 64 * 64;
    LAS int* OFF = (LAS int*)F.lds;
    LAS int* CN = OFF + 128;
    if (F.tid < 64) {
        const int cn = (int)__hip_atomic_load(cnt + F.tid * 64, __ATOMIC_RELAXED, __HIP_MEMORY_SCOPE_AGENT); const int pd = (cn + 255) & ~255;
        int inc = pd;
#pragma unroll
        for (int o = 1; o < 64; o <<= 1) { const int t = __shfl_up(inc, o); if (F.lane >= o) inc += t; }
        CN[F.tid] = cn; OFF[F.tid] = inc - pd; if (F.tid == 63) OFF[64] = inc;
        if (F.bid == 0) {
            const int e = F.tid, o0 = inc - pd; int n = o0 >> 8;
            for (int r = o0; r < inc; r += 256) { F.ctl[CW_MTE + l * 256 + n] = (unsigned)e; F.ctl[CW_MTR + l * 256 + n] = (unsigned)r | ((o0 + cn - r <= 128) ? 0x80000000u : 0u); ++n; }
            if (e == 63) F.ctl[CW_NMT + l] = (unsigned)(inc >> 8); }
    }
    LDS_WAIT(); __syncthreads();
    for (int tok = F.bid * NTHR + F.tid; tok < NTOK; tok += F.G * NTHR) {
        const int r0 = OFF[eidx[2 * tok]] + slot[2 * tok], r1 = OFF[eidx[2 * tok + 1]] + slot[2 * tok + 1];
        arow[2 * tok] = r0; arow[2 * tok + 1] = r1; rowtok[r0] = tok; rowtok[r1] = tok; }
    for (int e = F.bid; e < 64; e += F.G)
        for (int r = OFF[e] + CN[e] + F.tid; r < OFF[e + 1]; r += NTHR) rowtok[r] = 0;
    __syncthreads();
}

__device__ __forceinline__ int moe_tables(Frame& F, int l) {
    const unsigned* cnt = F.ctl + CW_CNT + l * 64 * 64;
    LAS int* tb = (LAS int*)(F.lds + MT_LDS);
    if (F.tid < 64) {
        const int cn = (int)__hip_atomic_load(cnt + F.tid * 64, __ATOMIC_RELAXED, __HIP_MEMORY_SCOPE_AGENT); const int pd = (cn + 255) & ~255;
        int inc = pd;
#pragma unroll
        for (int o = 1; o < 64; o <<= 1) { const int t = __shfl_up(inc, o); if (F.lane >= o) inc += t; }
        const int e = F.tid, o0 = inc - pd; int n = o0 >> 8;
        tb[MT_CN + e] = cn; tb[MT_OFF + e] = o0; if (e == 63) tb[MT_OFF + 64] = inc;
        for (int r = o0; r < inc; r += 256) { tb[MT_E + n] = e; tb[MT_R + n] = (int)((unsigned)r | ((o0 + cn - r <= 128) ? 0x80000000u : 0u)); tb[MT_B + n] = e * RT_CAP - o0; tb[MT_N + n] = o0 + cn; ++n; }
    }
    LDS_WAIT(); __syncthreads();
    return __builtin_amdgcn_readfirstlane(tb[MT_OFF + 64]) >> 8;
}

constexpr int PH_PER_LAYER = 14, PH_BASE = 1, N_PHASES = PH_BASE + DEPTH * PH_PER_LAYER;
__global__ void __launch_bounds__(NTHR, 2) mk_fwd(Args args) {
    extern __shared__ __attribute__((aligned(16))) unsigned char lds_raw[];
    Frame F; F.lds = (LAS unsigned char*)lds_raw; F.tid = threadIdx.x; F.lane = F.tid & 63; F.wave = __builtin_amdgcn_readfirstlane(F.tid >> 6);
    F.G = gridDim.x; F.bid = blockIdx.x; F.ws = args.ws; F.ctl = (unsigned*)(args.ws + WS_CTL); F.in = args.in; F.out = args.out;
    volatile LAS unsigned* MISC = (volatile LAS unsigned*)(F.lds + MISC_OFF);
    if (F.tid < 64) MISC[F.tid] = 0u;
    __syncthreads();
    XcdBarrier bar = xcd_barrier_post(F.ctl + CW_BAR, MISC + 8);
    const int lo = args.ph_lo, hi = args.ph_hi;
#if MK_STAMP
    if (blockIdx.x == 0 && threadIdx.x == 0) ((unsigned long long*)(F.ctl + CW_STAMPS))[0] = wall_clock64();
#endif
#ifndef MK_PHMASK
#define MK_PHMASK 0xFFFFFFFFu
#endif
#ifndef MK_STOP
#define MK_STOP 1000
#endif
#define IN(k) (lo <= (k) && (k) < hi && ((k) < MK_STOP || (k) >= N_PHASES))
#define EN(j) (((MK_PHMASK) >> (j)) & 1u)
#if MK_STAMP
#define SEAM(k) do { if (IN((k) + 1)) xcd_barrier(bar, P.tid == 0); if (P.bid == 0 && P.tid == 0) ((unsigned long long*)(P.ctl + CW_STAMPS))[(k) + 1] = wall_clock64(); } while (0)
#else
#define SEAM(k) do { if (IN((k) + 1)) xcd_barrier(bar, P.tid == 0); } while (0)
#endif
#define LAUNDER(v) asm volatile("" : "+s"(v))
#define PHASE_FRAME() Frame P = F; int z_ = 0; LAUNDER(z_); asm volatile("v_mbcnt_lo_u32_b32 %0, -1, 0\n\tv_mbcnt_hi_u32_b32 %0, -1, %0" : "=v"(P.tid)); P.tid |= (F.wave << 6) + z_; P.lane = P.tid & 63; P.wave = __builtin_amdgcn_readfirstlane(P.tid >> 6); P.ws = F.ws + z_; P.ctl = F.ctl + z_; P.in = F.in + z_; P.out = F.out + z_; P.G = F.G + z_; P.bid = F.bid + z_; unsigned char* ws = P.ws; (void)ws
    if (EN(14) && IN(0)) {
        PHASE_FRAME();
        p_convert(P);
        const int gw = P.bid * NWAVES + P.wave, NGW = P.G * NWAVES;
        for (int r = gw; r < 2 * 1024; r += NGW) { const int l = r >> 10, row = r & 1023;
            norm_row(P.in[1] + (size_t)row * D, nullptr, (bf16*)(ws + WS_MEMN) + (size_t)r * D, P.in[18] + l * D, nullptr, nullptr, 0.f, 0.f, P.lane); }
        for (int r = gw; r < NTOK; r += 2 * NGW) { const int r2 = r + NGW, rb = r2 < NTOK ? r2 : r;
            float* const rsb = (float*)(ws + WS_SMALL + SM_RS);
            const void* const xi[2] = {P.in[0] + (size_t)r * D, P.in[0] + (size_t)rb * D}; bf16* const x16[2] = {(bf16*)(ws + WS_HN) + (size_t)r * D, (bf16*)(ws + WS_HN) + (size_t)rb * D};
            float* const xf[2] = {nullptr, nullptr}; float* const rs[2] = {rsb + r, rsb + rb}; const bf16* const ya[2] = {nullptr, nullptr}; const float gg[2] = {0.f, 0.f};
            stream_rows<2, false, false>(xi, x16, xf, rs, ya, ya, gg, gg, P.lane); }
        SEAM(0);
    }
    for (int l_ = 0; l_ < DEPTH; ++l_) {
        const int pb = PH_BASE + l_ * PH_PER_LAYER;
#define LAYER_FRAME() PHASE_FRAME(); int l = l_ + z_; const int vcu = (P.G % 8 == 0) ? (P.bid % 8) * (P.G / 8) + P.bid / 8 : P.bid; (void)vcu; unsigned char* wl = ws + WS_W + (size_t)l * WL_END; (void)wl; \
        bf16* U = (bf16*)(ws + WS_OVL + OV_U); bf16* MIX = (bf16*)(ws + WS_OVL + OV_MIX); bf16* HN = (bf16*)(ws + WS_HN); (void)U; (void)MIX; (void)HN
        if (EN(0) && IN(pb + 0)) {
            LAYER_FRAME();
            pg8::Gemm g{HN, (const bf16*)(wl + WL_WIN), D, D}; pg8::EpiBf16 E{U, UW, nullptr, (const float*)(ws + WS_SMALL + SM_RS)};
            pg8::WinPlusExtra S; S.base.init(NTOK, UW, D, D, P.G, P.bid); S.nx = l == 0 ? 32 : 0;
            S.xa = (long)((ws + WS_MEMN) - (ws + WS_HN)); S.xa_l = (long)1024 * D * 2; S.xb = (long)((ws + WS_W + WL_WMKV) - (wl + WL_WIN)); S.xb_l = (long)WL_END;
            S.xo = (bf16*)(ws + WS_MKV); S.xo_l = (size_t)1024 * 1024;
            pg8::gemm_phase(P.lds, P.tid, g, S, E);
            SEAM(pb + 0);
        }
        if (EN(1) && IN(pb + 1)) {
            LAYER_FRAME();
            { pg8::Gemm g{U + C_CQ, (const bf16*)(wl + WL_WUQ), UW, 512}; pg8::StaticOrder S; S.init(NTOK, 768, UW, 512, P.G, P.bid); pg8::EpiBf16 E{(bf16*)(ws + WS_OVL + OV_QM), 768, nullptr, nullptr};
              pg8::gemm_phase(P.lds, P.tid, g, S, E); }
            { pg8::Gemm g{U + C_CKV, (const bf16*)(wl + WL_WUKV), UW, 256}; pg8::StaticOrder S; S.init(NTOK, 1024, UW, 256, P.G, P.bid); pg8::EpiBf16 E{(bf16*)(ws + WS_OVL + OV_KVM), 1024, nullptr, nullptr};
              pg8::gemm_phase(P.lds, P.tid, g, S, E); }
            if (l == 0) p_mem_post(P);
            p_prep(P, l);
            p_hgrn1(P, l);
            SEAM(pb + 1);
        }
        if (EN(2) && IN(pb + 2)) {
            LAYER_FRAME();
            p_mla_post(P, l);
            p_hgrn2(P);
            { LAS float* bias = (LAS float*)(P.lds + AT_ML + 4096);
              for (int i = P.tid; i < 1024; i += NTHR) { const int h = i >> 7, d = i & 127; int bk = d;
                  if (d >= 16) { bk = 16 + (int)(logf((float)d / 16.f) / 2.0794415416798357f * 16.f); if (bk > 31) bk = 31; }
                  bias[i] = P.in[2][bk * 8 + h] * LOG2E; }
              LDS_WAIT(); __syncthreads();
              const bf16* SVT = (const bf16*)(ws + WS_OVL + OV_SVT);
              for (int un = vcu; un < 512; un += P.G) { const int b = un >> 7, h = 2 * ((un >> 5) & 3), qb = un & 31;
                  AttnU a; a.Q = U + (size_t)(b * SEQ + qb * 128) * UW + C_SQ + h * 64; a.qs = UW; a.K = U + (size_t)(b * SEQ) * UW + C_SK + (h >> 2) * 64; a.ks = UW;
                  a.VT = SVT + (size_t)((b * 2 + (h >> 2)) * 64) * SEQ; a.vts = SEQ; a.O = MIX + (size_t)(b * SEQ + qb * 128) * D + h * 64; a.os = D; a.q0 = qb * 128;
                  a.t_lo = qb > 0 ? 2 * qb - 2 : 0; a.t_hi = 2 * qb + 2; a.dbg = nullptr; a.qh = 64; a.oh = 64; a.sinkb = P.in[8][l * 8 + h + 1] * LOG2E;
                  attn_unit<64, 64, 2, false, true, false, true>(P.lds, P.tid, a, 0.125f * LOG2E, nullptr, P.in[8][l * 8 + h] * LOG2E, bias + h * 128); }
            }
            SEAM(pb + 2);
        }
        if (EN(3) && IN(pb + 3)) {
            LAYER_FRAME();
            { const bf16* QF = (const bf16*)(ws + WS_OVL + OV_QF); const bf16* KF = (const bf16*)(ws + WS_OVL + OV_KF); const bf16* VT = (const bf16*)(ws + WS_OVL + OV_VT);
              for (int it = vcu; it < 512; it += P.G) { const int pair = it & 255, bh = pair >> 4, j = pair & 15, qb = it < 256 ? 31 - j : j;
                  AttnU a; a.Q = QF + ((size_t)bh * SEQ + qb * 128) * 192; a.qs = 192; a.K = KF + (size_t)bh * SEQ * 192; a.ks = 192; a.VT = VT + (size_t)bh * 128 * SEQ; a.vts = SEQ;
                  a.O = MIX + ((size_t)(bh >> 2) * SEQ + qb * 128) * D + 1536 + (bh & 3) * 128; a.os = D; a.q0 = qb * 128; a.t_lo = 0; a.t_hi = 2 * qb + 2; a.dbg = nullptr;
                  attn_unit<192, 128, 1, false, false, true, false, true>(P.lds, P.tid, a, 0.07216878364870322f * LOG2E, nullptr, 0.f, nullptr); }
 }
#ifndef MK_NOH3
            p_hgrn3(P, l);
#endif
            SEAM(pb + 3);
        }
        if (EN(4) && IN(pb + 4)) {
            LAYER_FRAME();
            pg8::Gemm g{MIX, (const bf16*)(wl + WL_WOUT), D, D}; pg8::StaticOrder S; S.init(NTOK, D, D, D, P.G, P.bid); pg8::EpiResid16 E{HN, D, (float*)(ws + WS_SMALL + SM_ROWSS)};
            pg8::gemm_phase(P.lds, P.tid, g, S, E);
            SEAM(pb + 4);
        }
        if (EN(6) && IN(pb + 6)) {
            LAYER_FRAME();
            pg8::Gemm g{HN, (const bf16*)(wl + WL_WMQ), D, D}; pg8::HalfOrder S; S.base.init(NTOK, 512, D, D, P.G, P.bid); pg8::EpiBf16 E{(bf16*)(ws + WS_MQ), 512, (const float*)(ws + WS_SMALL + SM_ROWSS), nullptr};
            pg8::gemm_phase(P.lds, P.tid, g, S, E);
            SEAM(pb + 6);
        }
        if (EN(7) && IN(pb + 7)) {
            LAYER_FRAME();
            const bf16* MQ = (const bf16*)(ws + WS_MQ); bf16* MO = (bf16*)(ws + WS_MO);
            const bf16* MK = (const bf16*)(ws + WS_MK) + (size_t)l * 1024 * 512; const bf16* MVT = (const bf16*)(ws + WS_MVT) + (size_t)l * 1024 * 512;
            for (int un = vcu; un < 256; un += P.G) { const int b = un >> 6, h = (un >> 4) & 3, qb = 2 * (un & 15);
                AttnU a; a.Q = MQ + (size_t)(b * SEQ + qb * 128) * 512 + h * 128; a.qs = 512; a.K = MK + (size_t)((b * 4 + h) * 256) * 128; a.ks = 128; a.VT = MVT + (size_t)((b * 4 + h) * 128) * 256; a.vts = 256;
                a.O = MO + (size_t)(b * SEQ + qb * 128) * 512 + h * 128; a.os = 512; a.q0 = 0; a.t_lo = 0; a.t_hi = 4; a.dbg = nullptr; a.qh = 128 * 512; a.oh = 128 * 512; a.sinkb = 0.f;
                attn_unit<128, 128, 0, true, false, true, true>(P.lds, P.tid, a, 0.08838834764831845f * LOG2E, P.in[21] + l * 128, 0.f, nullptr); }
            SEAM(pb + 7);
        }
        if (EN(8) && IN(pb + 8)) {
            LAYER_FRAME();
            pg8::Gemm g{(const bf16*)(ws + WS_MO), (const bf16*)(wl + WL_WMO), 512, 512}; pg8::StaticOrder S; S.init(NTOK, D, 512, 512, P.G, P.bid); pg8::EpiResid16 E{HN, D, nullptr};
            pg8::gemm_phase(P.lds, P.tid, g, S, E);
            SEAM(pb + 8);
        }
        if (EN(9) && IN(pb + 9)) { LAYER_FRAME(); p_router(P, l); SEAM(pb + 9); }
        if (EN(11) && IN(pb + 11)) {
            LAYER_FRAME();
            const int nmt = moe_tables(P, l);
            pg8::Gemm g{HN, (const bf16*)(wl + WL_WGU), D, D, (const int*)(ws + WS_OVL + OV_XG)};
            pg8::GroupedOrder S{(const LAS int*)(P.lds + MT_LDS), nmt, 4, P.G, vcu, D, D, (size_t)1024 * D * 2};
            pg8::EpiGateUp E{(bf16*)(ws + WS_OVL + OV_HMID), 512, (const int*)(ws + WS_OVL + OV_XG), (const float*)(ws + WS_OVL + OV_XG + RS2_OFF)};
            pg8::gemm_phase<pg8::EpiGateUp, pg8::GroupedOrder, true>(P.lds, P.tid, g, S, E);
            SEAM(pb + 11);
        }
        if (EN(12) && IN(pb + 12)) {
            LAYER_FRAME();
            const int nmt = (lo == pb + 12) ? moe_tables(P, l) : (__builtin_amdgcn_readfirstlane(((const LAS int*)(P.lds + MT_LDS))[MT_OFF + 64]) >> 8);
            pg8::Gemm g{(const bf16*)(ws + WS_OVL + OV_HMID), (const bf16*)(wl + WL_WD), 512, 512};
            pg8::GroupedOrder S{(const LAS int*)(P.lds + MT_LDS), nmt, 8, P.G, vcu, 512, 512, (size_t)D * 512 * 2};
            pg8::EpiBf16 E{(bf16*)(ws + WS_OVL + OV_YB), D, nullptr, nullptr};
            pg8::gemm_phase(P.lds, P.tid, g, S, E);
            SEAM(pb + 12);
        }
        if (EN(13) && IN(pb + 13)) {
            LAYER_FRAME();
            const int gw = P.bid * NWAVES + P.wave, NGW = P.G * NWAVES;
            if (lo == pb + 13) (void)moe_tables(P, l); const LAS int* OFFT = (const LAS int*)(P.lds + MT_LDS) + MT_OFF;
            const int* eidx = (const int*)(ws + WS_SMALL + SM_EIDX); const int* slot = (const int*)(ws + WS_SMALL + SM_SLOT);
#define AROW(i) (OFFT[eidx[i]] + slot[i])
            const float* gate = (const float*)(ws + WS_SMALL + SM_GATE); const bf16* YB = (const bf16*)(ws + WS_OVL + OV_YB);
            float* const rsb = (float*)(ws + WS_SMALL + SM_RS); const bool lastl = l + 1 >= DEPTH;
            static_assert(NTOK % 2 == 0, "row pairs");
            int ca0 = 0, ca1 = 0, cb0 = 0, cb1 = 0; float cg0 = 0.f, cg1 = 0.f, ch0 = 0.f, ch1 = 0.f;
#define CI_LOAD(rr, rr2) do { ca0 = AROW(2 * (rr)); ca1 = AROW(2 * (rr2)); cb0 = AROW(2 * (rr) + 1); cb1 = AROW(2 * (rr2) + 1); cg0 = gate[2 * (rr)]; cg1 = gate[2 * (rr2)]; ch0 = gate[2 * (rr) + 1]; ch1 = gate[2 * (rr2) + 1]; } while (0)
            if (gw + NGW < NTOK) CI_LOAD(gw, gw + NGW);
            for (int r = gw; r < NTOK; r += 2 * NGW) { const int r2 = r + NGW;
                if (r2 < NTOK) {
                    const void* const xi[2] = {HN + (size_t)r * D, HN + (size_t)r2 * D}; bf16* const x16[2] = {lastl ? nullptr : HN + (size_t)r * D, lastl ? nullptr : HN + (size_t)r2 * D};
                    float* const xf[2] = {lastl ? P.out + (size_t)r * D : nullptr, lastl ? P.out + (size_t)r2 * D : nullptr}; float* const rs[2] = {lastl ? nullptr : rsb + r, lastl ? nullptr : rsb + r2};
                    const bf16* const ya[2] = {YB + (size_t)ca0 * D, YB + (size_t)ca1 * D}; const bf16* const yb[2] = {YB + (size_t)cb0 * D, YB + (size_t)cb1 * D};
                    const float ga[2] = {cg0, cg1}, gb[2] = {ch0, ch1};
                    if (r2 + 2 * NGW < NTOK) CI_LOAD(r + 2 * NGW, r2 + 2 * NGW);
                    SBAR();
                    stream_rows<2, true, true>(xi, x16, xf, rs, ya, yb, ga, gb, P.lane);
                } else {
                    const void* const xi[1] = {HN + (size_t)r * D}; bf16* const x16[1] = {lastl ? nullptr : HN + (size_t)r * D}; float* const xf[1] = {lastl ? P.out + (size_t)r * D : nullptr}; float* const rs[1] = {lastl ? nullptr : rsb + r};
                    const bf16* const ya[1] = {YB + (size_t)AROW(2 * r) * D}; const bf16* const yb[1] = {YB + (size_t)AROW(2 * r + 1) * D}; const float ga[1] = {gate[2 * r]}, gb[1] = {gate[2 * r + 1]};
                    stream_rows<1, true, true>(xi, x16, xf, rs, ya, yb, ga, gb, P.lane); } }
#undef CI_LOAD
            SEAM(pb + 13);
        }
    }
#if MK_SANITIZE
    if (IN(N_PHASES)) { PHASE_FRAME(); for (size_t i = (size_t)P.bid * NTHR + P.tid; i < (size_t)NTOK * D; i += (size_t)P.G * NTHR) { float v = P.out[i]; if (!(fabsf(v) < 1e30f)) P.out[i] = 0.f; } }
#endif
#undef IN
#undef SEAM
}

#if MK_DEBUG
constexpr int CW_DBG = 12288;
__device__ __forceinline__ unsigned dh(unsigned x) { x ^= x >> 16; x *= 0x7feb352du; x ^= x >> 15; x *= 0x846ca68bu; x ^= x >> 16; return x; }
__device__ __forceinline__ void dbg_put(unsigned* ctl, int k, float got, float want, float scale) {
    float e = fabsf(got - want) / (fabsf(want) + scale); if (!(e == e) || !(fabsf(got) < 1e30f)) e = 1e9f;
    atomicMax(ctl + CW_DBG + k, __builtin_bit_cast(unsigned, e));
}
__device__ double dcos2pi(double fr, bool want_sin) {
    double th = (fr - 0.5) * 6.283185307179586;
    double t2 = th * th, c = 1.0, s = th, tc = 1.0, ts = th;
    for (int n = 1; n < 16; ++n) { tc *= -t2 / ((2.0 * n - 1.0) * (2.0 * n)); c += tc; ts *= -t2 / ((2.0 * n) * (2.0 * n + 1.0)); s += ts; }
    return want_sin ? -s : -c;
}
__global__ void __launch_bounds__(256) dbg_kernel(Args args, int stage, int l) {
    const float* const* in = args.in; unsigned char* ws = args.ws; unsigned* ctl = (unsigned*)(ws + WS_CTL);
    const int gid = blockIdx.x * 256 + threadIdx.x, NT = gridDim.x * 256;
    unsigned char* wl = ws + WS_W + (size_t)l * WL_END;
    const bf16* HN = (const bf16*)(ws + WS_HN); const bf16* U = (const bf16*)(ws + WS_OVL + OV_U); const bf16* MIX = (const bf16*)(ws + WS_OVL + OV_MIX);
    const bf16* WIN = (const bf16*)(wl + WL_WIN);
    if (stage == 1) {
        for (int s = gid; s < 8192; s += NT) { const unsigned h = dh(s * 2654435761u + 12345u);
            { const int n = h % INW, k = (h >> 13) % D; dbg_put(ctl, 1, bf2f(WIN[(size_t)n * D + k]), in[5][((size_t)l * D + k) * INW + n], 1e-3f); }
            { const int n = INW + h % (UW - INW), k = (h >> 13) % D; dbg_put(ctl, 1, bf2f(WIN[(size_t)n * D + k]), 0.f, 1e-3f); }
            { const int n = h % 768, k = (h >> 13) % 512; dbg_put(ctl, 1, bf2f(((const bf16*)(wl + WL_WUQ))[(size_t)n * 512 + k]), in[12][((size_t)l * 512 + k) * 768 + n] * in[10][l * 512 + k], 1e-3f); }
            { const int n = h % 1024, k = (h >> 13) % 256; dbg_put(ctl, 1, bf2f(((const bf16*)(wl + WL_WUKV))[(size_t)n * 256 + k]), in[13][((size_t)l * 256 + k) * 1024 + n] * in[11][l * 256 + k], 1e-3f); }
            { const int n = h % D, k = (h >> 13) % D; dbg_put(ctl, 1, bf2f(((const bf16*)(wl + WL_WOUT))[(size_t)n * D + k]), in[16][((size_t)l * D + k) * D + n], 1e-3f); }
            { const int n = h % 512, k = (h >> 13) % D; dbg_put(ctl, 1, bf2f(((const bf16*)(wl + WL_WMQ))[(size_t)n * D + k]), in[19][((size_t)l * D + k) * 512 + n], 1e-3f); }
            { const int n = h % 1024, k = (h >> 13) % D; dbg_put(ctl, 1, bf2f(((const bf16*)(wl + WL_WMKV))[(size_t)n * D + k]), in[20][((size_t)l * D + k) * 1024 + n], 1e-3f); }
            { const int n = h % D, k = (h >> 13) % 512; dbg_put(ctl, 1, bf2f(((const bf16*)(wl + WL_WMO))[(size_t)n * 512 + k]), in[23][((size_t)l * 512 + k) * D + n], 1e-3f); }
            { const int e = (h >> 3) % NEXP, n = h % DEXP, k = (h >> 13) % D; const bf16* gu = (const bf16*)(wl + WL_WGU) + (size_t)e * 1024 * D;
              dbg_put(ctl, 1, bf2f(gu[(size_t)((n >> 7) * 256 + (n & 127)) * D + k]), in[29][(((size_t)l * NEXP + e) * D + k) * DEXP + n], 1e-3f);
              dbg_put(ctl, 1, bf2f(gu[(size_t)((n >> 7) * 256 + 128 + (n & 127)) * D + k]), in[30][(((size_t)l * NEXP + e) * D + k) * DEXP + n], 1e-3f); }
            { const int e = (h >> 3) % NEXP, n = h % D, k = (h >> 13) % DEXP; dbg_put(ctl, 1, bf2f(((const bf16*)(wl + WL_WD))[((size_t)e * D + n) * DEXP + k]), in[31][(((size_t)l * NEXP + e) * DEXP + k) * D + n], 1e-3f); }
        }
    }
    if (stage == 2) {
        for (int s = gid; s < 512; s += NT) { const unsigned h = dh(s * 977u + 7u); const int r = (s < 4) ? (s & 1 ? NTOK - 1 : 0) : h % NTOK, c = (h >> 15) % D;
            const float* xr = in[0] + (size_t)r * D; float ss = 0.f; for (int k = 0; k < D; ++k) ss += xr[k] * xr[k];
            dbg_put(ctl, 2, bf2f(HN[(size_t)r * D + c]), xr[c] * rsqrtf(ss / D + EPS) * in[4][c], 1e-2f); dbg_put(ctl, 2, args.out[(size_t)r * D + c], xr[c], 1e-6f); }
    }
    if (stage == 3) {
        for (int s = gid; s < 4096; s += NT) { const unsigned h = dh(s * 31u + 99u); const int r = (s < 64) ? ((s & 1) ? NTOK - 1 - (s >> 1) : (s >> 1)) : h % NTOK; const int n = (s & 2) ? (UW - 1 - (h >> 14) % 512) : (h >> 14) % UW;
            float a = 0.f; for (int k = 0; k < D; ++k) a += bf2f(HN[(size_t)r * D + k]) * bf2f(WIN[(size_t)n * D + k]);
            dbg_put(ctl, 3, bf2f(U[(size_t)r * UW + n]), a, 0.05f); }
    }
    if (stage == 4) {
        const bf16* QM = (const bf16*)(ws + WS_OVL + OV_QM); const bf16* KVM = (const bf16*)(ws + WS_OVL + OV_KVM);
        for (int s = gid; s < 4096; s += NT) { const unsigned h = dh(s * 131u + 5u); const int r = h % NTOK;
            { const int n = (h >> 14) % 768; float a = 0.f; for (int k = 0; k < 512; ++k) a += bf2f(U[(size_t)r * UW + C_CQ + k]) * bf2f(((const bf16*)(wl + WL_WUQ))[(size_t)n * 512 + k]); dbg_put(ctl, 4, bf2f(QM[(size_t)r * 768 + n]), a, 0.05f); }
            { const int n = (h >> 14) % 1024; float a = 0.f; for (int k = 0; k < 256; ++k) a += bf2f(U[(size_t)r * UW + C_CKV + k]) * bf2f(((const bf16*)(wl + WL_WUKV))[(size_t)n * 256 + k]); dbg_put(ctl, 5, bf2f(KVM[(size_t)r * 1024 + n]), a, 0.05f); } }
    }
    if (stage == 6) {
        const float* rcq = (const float*)(ws + WS_SMALL + SM_RSTDCQ); const float* rckv = (const float*)(ws + WS_SMALL + SM_RSTDCKV); const bf16* SVT = (const bf16*)(ws + WS_OVL + OV_SVT);
        for (int s = gid; s < 256; s += NT) { const unsigned h = dh(s * 733u + 3u); const int r = h % NTOK, hd = (h >> 14) % 10, d = (h >> 20) % 64;
            const int c0 = hd < 8 ? C_SQ + hd * 64 : C_SK + (hd - 8) * 64; float ss = 0.f, mine = 0.f;
            for (int j = 0; j < 64; ++j) { float a = 0.f; for (int k = 0; k < D; ++k) a += bf2f(HN[(size_t)r * D + k]) * bf2f(WIN[(size_t)(c0 + j) * D + k]); a = bf2f(f2bf(a)); ss += a * a; if (j == d) mine = a; }
            dbg_put(ctl, 6, bf2f(U[(size_t)r * UW + c0 + d]), mine * rsqrtf(ss / 64 + EPS) * (hd < 8 ? in[6][l * 64 + d] : in[7][l * 64 + d]), 0.03f);
            float s1 = 0.f; for (int k = 0; k < 512; ++k) { const float a = bf2f(U[(size_t)r * UW + C_CQ + k]); s1 += a * a; } dbg_put(ctl, 6, rcq[r], rsqrtf(s1 / 512 + EPS), 1e-3f);
            float s2 = 0.f; for (int k = 0; k < 256; ++k) { const float a = bf2f(U[(size_t)r * UW + C_CKV + k]); s2 += a * a; } dbg_put(ctl, 6, rckv[r], rsqrtf(s2 / 256 + EPS), 1e-3f);
            const int b = r >> 12, sp = r & 4095, cc = (h >> 9) % 128; dbg_put(ctl, 7, bf2f(SVT[((size_t)b * 128 + cc) * SEQ + sp]), bf2f(U[(size_t)r * UW + C_SV + cc]), 1e-6f); }
    }
    if (stage == 8) {
        const bf16* QM = (const bf16*)(ws + WS_OVL + OV_QM); const bf16* KVM = (const bf16*)(ws + WS_OVL + OV_KVM); const bf16* QF = (const bf16*)(ws + WS_OVL + OV_QF); const bf16* KF = (const bf16*)(ws + WS_OVL + OV_KF); const bf16* VT = (const bf16*)(ws + WS_OVL + OV_VT);
        const float* rcq = (const float*)(ws + WS_SMALL + SM_RSTDCQ); const float* rckv = (const float*)(ws + WS_SMALL + SM_RSTDCKV);
        for (int s = gid; s < 2048; s += NT) { const unsigned h = dh(s * 3571u + 11u); const int r = h % NTOK, hh = (h >> 14) & 3, d = (h >> 16) % 192, b = r >> 12, sp = r & 4095;
            for (int which = 0; which < 2; ++which) {
                float ss = 0.f;
                for (int j = 0; j < 192; ++j) { float a; if (which == 0) a = bf2f(QM[(size_t)r * 768 + hh * 192 + j]) * rcq[r]; else a = j < 128 ? bf2f(KVM[(size_t)r * 1024 + hh * 256 + j]) * rckv[r] : bf2f(U[(size_t)r * UW + C_KR + j - 128]); ss += a * a; }
                const float rstd = rsqrtf(ss / 192 + EPS); const float* gg = which == 0 ? in[14] + l * 192 : in[15] + l * 192;
                auto el = [&](int j) { float a; if (which == 0) a = bf2f(QM[(size_t)r * 768 + hh * 192 + j]) * rcq[r]; else a = j < 128 ? bf2f(KVM[(size_t)r * 1024 + hh * 256 + j]) * rckv[r] : bf2f(U[(size_t)r * UW + C_KR + j - 128]); return a * rstd * gg[j]; };
                float want;
                if (d < 128) want = el(d);
                else { const int i = (d - 128) & 31; const float inv = powf(10000.f, -(float)i / 32.f); const float ang = (float)sp * inv; const double rev = (double)ang * 0.15915494309189535, fr = rev - floor(rev);
                    const float c = (float)dcos2pi(fr, false), sn = (float)dcos2pi(fr, true); const float x1 = el(128 + i), x2 = el(160 + i); want = d < 160 ? x1 * c - x2 * sn : x1 * sn + x2 * c; }
                dbg_put(ctl, 8 + which, bf2f((which == 0 ? QF : KF)[((size_t)(b * 4 + hh) * SEQ + sp) * 192 + d]), want, 0.03f);
            }
            const int dv = d & 127; dbg_put(ctl, 10, bf2f(VT[((size_t)(b * 4 + hh) * 128 + dv) * SEQ + sp]), bf2f(KVM[(size_t)r * 1024 + hh * 256 + 128 + dv]) * rckv[r], 0.01f); }
    }
    if (stage == 11) {
        for (int s = gid; s < 1024; s += NT) { const unsigned h = dh((s >> 4) * 7919u + 13u); const int cls = (s >> 4) % 3; const int r = cls == 0 ? (h % 4) * 4096 + (h >> 5) % 32 : cls == 1 ? (h % 4) * 4096 + 32 + (h >> 5) % 96 : h % NTOK, hq = (h >> 14) & 7, d = ((h >> 17) & 48) + (s & 15), b = r >> 12, t = r & 4095, hkv = hq >> 2;
            const float sink = in[8][l * 8 + hq]; float mx = sink;
            const int s_lo = t - 127 > 0 ? t - 127 : 0;
            for (int pass = 0; pass < 2; ++pass) { float den = 0.f, num = 0.f;
                for (int sk = s_lo; sk <= t; ++sk) { float sc = 0.f; for (int j = 0; j < 64; ++j) sc += bf2f(U[(size_t)r * UW + C_SQ + hq * 64 + j]) * bf2f(U[(size_t)(b * SEQ + sk) * UW + C_SK + hkv * 64 + j]);
                    const int dist = t - sk; int bk = dist; if (dist >= 16) { bk = 16 + (int)(logf((float)dist / 16.f) / 2.0794415416798357f * 16.f); if (bk > 31) bk = 31; }
                    sc = sc * 0.125f + in[2][bk * 8 + hq];
                    if (pass == 0) mx = fmaxf(mx, sc); else { const float p = expf(sc - mx); den += p; num += p * bf2f(U[(size_t)(b * SEQ + sk) * UW + C_SV + hkv * 64 + d]); } }
                if (pass == 1) { den += expf(sink - mx); dbg_put(ctl, 11, bf2f(MIX[(size_t)r * D + hq * 64 + d]), num / den, 0.2f); dbg_put(ctl, t < 32 ? 16 : t < 128 ? 17 : 18, bf2f(MIX[(size_t)r * D + hq * 64 + d]), num / den, 0.2f); } } }
    }
    if (stage == 12) {
        const bf16* QF = (const bf16*)(ws + WS_OVL + OV_QF); const bf16* KF = (const bf16*)(ws + WS_OVL + OV_KF); const bf16* VT = (const bf16*)(ws + WS_OVL + OV_VT);
        for (int s = gid; s < 512; s += NT) { const unsigned h = dh((s >> 3) * 104729u + 17u); const int cls = (s >> 3) % 4; const int r = cls == 0 ? (h % 4) * 4096 + (h >> 5) % 128 : cls == 1 ? (h % 4) * 4096 + 3968 + (h >> 5) % 128 : cls == 2 ? (h % 4) * 4096 + 128 + (h >> 5) % 128 : h % NTOK, hh = (h >> 14) & 3, d = ((h >> 16) & 120) + (s & 7), b = r >> 12, t = r & 4095;
            const bf16* q = QF + ((size_t)(b * 4 + hh) * SEQ + t) * 192; float mx = -1e30f;
            for (int pass = 0; pass < 2; ++pass) { float den = 0.f, num = 0.f;
                for (int sk = 0; sk <= t; ++sk) { const bf16* kk = KF + ((size_t)(b * 4 + hh) * SEQ + sk) * 192; float sc = 0.f; for (int j = 0; j < 192; ++j) sc += bf2f(q[j]) * bf2f(kk[j]); sc *= 0.07216878364870322f;
                    if (pass == 0) mx = fmaxf(mx, sc); else { const float p = expf(sc - mx); den += p; num += p * bf2f(VT[((size_t)(b * 4 + hh) * 128 + d) * SEQ + sk]); } }
                if (pass == 1) { dbg_put(ctl, 12, bf2f(MIX[(size_t)r * D + 1536 + hh * 128 + d]), num / den, 0.1f); dbg_put(ctl, t < 128 ? 19 : t >= 3968 ? 20 : t < 256 ? 21 : 22, bf2f(MIX[(size_t)r * D + 1536 + hh * 128 + d]), num / den, 0.1f); } } }
    }
    if (stage == 24) {
        const bf16* QF = (const bf16*)(ws + WS_OVL + OV_QF); const bf16* KF = (const bf16*)(ws + WS_OVL + OV_KF); const bf16* VT = (const bf16*)(ws + WS_OVL + OV_VT); const float* DB = (const float*)(ws + WS_MQ);
        const float sc2 = 0.07216878364870322f * LOG2E;
        for (int tl = gid; tl < 512; tl += NT) { const int wid = tl >> 6, lane = tl & 63, r32 = lane & 31, hi = lane >> 5, g = wid & 3, kh = wid >> 2, q = 32 * g + r32;
            float sv[32]; float mx = -1e30f;
            for (int kk = 0; kk < 32; ++kk) { const int key = 32 * kh + kk; float a = 0.f; for (int j = 0; j < 192; ++j) a += bf2f(QF[(size_t)q * 192 + j]) * bf2f(KF[(size_t)key * 192 + j]); a *= sc2; mx = fmaxf(mx, a);
                for (int r = 0; r < 16; ++r) if (crow(r, hi) == kk) dbg_put(ctl, 24, DB[(wid * 64 + lane) * 16 + r], a, 0.5f); }
            float l = 0.f; for (int kk = 0; kk < 32; ++kk) { const int key = 32 * kh + kk; float a = 0.f; for (int j = 0; j < 192; ++j) a += bf2f(QF[(size_t)q * 192 + j]) * bf2f(KF[(size_t)key * 192 + j]); a *= sc2; l += exp2f(a - mx); }
            dbg_put(ctl, 25, DB[8192 + (wid * 64 + lane) * 2], mx, 0.5f); dbg_put(ctl, 26, DB[8192 + (wid * 64 + lane) * 2 + 1], l, 0.5f);
            for (int i = 0; i < 4; ++i) for (int r = 0; r < 16; r += 5) { const int qq = 32 * g + crow(r, hi), d = 32 * i + r32; float m2 = -1e30f, acc = 0.f;
                for (int pass = 0; pass < 2; ++pass) for (int kk = 0; kk < 32; ++kk) { const int key = 32 * kh + kk; float a = 0.f; for (int j = 0; j < 192; ++j) a += bf2f(QF[(size_t)qq * 192 + j]) * bf2f(KF[(size_t)key * 192 + j]); a *= sc2;
                    if (pass == 0) m2 = fmaxf(m2, a); else acc += exp2f(a - m2) * bf2f(VT[(size_t)d * SEQ + key]); }
                dbg_put(ctl, 27, DB[16384 + ((wid * 64 + lane) * 4 + i) * 16 + r], acc, 0.3f); }
            (void)sv; }
    }
    if (stage == 13) {
        __shared__ float so[128]; const float* lb = (const float*)(ws + WS_SMALL + SM_LB) + l * 1024;
        for (int smp = blockIdx.x; smp < 64; smp += gridDim.x) { const unsigned h = dh(smp * 15485863u + 19u); const int r = smp < 4 ? ((smp & 1) ? 4096 + 63 + (smp >> 1) * 64 : (smp >> 1) * 70) : h % NTOK, hh = (h >> 14) & 7, b = r >> 12, t = r & 4095; const int v = threadIdx.x & 127;
            float o = 0.f;
            if (threadIdx.x < 128) {
                for (int k = 0; k < 128; ++k) { const float lbv = lb[hh * 128 + k]; const float q = bf2f(U[(size_t)r * UW + C_HQ + hh * 128 + k]); float dcy = 1.f, acc = 0.f;
                    for (int sk = t; sk >= 0 && dcy > 1e-12f; --sk) { const size_t rr = (size_t)(b * SEQ + sk) * UW; const float f = bf2f(U[rr + C_HF + hh * 128 + k]); const float sig = 1.f / (1.f + expf(-f)); const float fv = lbv + (1.f - lbv) * sig;
                        acc += dcy * (1.f - lbv) * (1.f - sig) * bf2f(U[rr + C_HI + hh * 128 + v]); dcy *= fv; }
                    o += q * acc; }
                so[v] = o; }
            __syncthreads();
            if (threadIdx.x < 128) { float ss = 0.f; for (int j = 0; j < 128; ++j) ss += so[j] * so[j]; const float gv = bf2f(U[(size_t)r * UW + C_HG + hh * 128 + v]);
                dbg_put(ctl, 13, bf2f(MIX[(size_t)r * D + 512 + hh * 128 + v]), o * rsqrtf(ss / 128 + EPS) * in[9][l * 128 + v] * gv / (1.f + expf(-gv)), 0.3f); }
            __syncthreads(); }
    }
    if (stage == 14) {
        for (int s = gid; s < 2048; s += NT) { const unsigned h = dh(s * 193u + 23u); const int r = h % NTOK, c = (h >> 14) % D; float a = in[0][(size_t)r * D + c];
            for (int k = 0; k < D; ++k) a += bf2f(MIX[(size_t)r * D + k]) * bf2f(((const bf16*)(wl + WL_WOUT))[(size_t)c * D + k]);
            dbg_put(ctl, 14, args.out[(size_t)r * D + c], a, 1.0f); }
    }
}
__global__ void dbg_final(Args args, float tol, int first, int count) {
    const unsigned* ctl = (const unsigned*)(args.ws + WS_CTL); float c = 1.f; int mask = 0;
    if (count > 0) { for (int k = 0; k < count; ++k) { const float e = __builtin_bit_cast(float, ctl[CW_DBG + first + k]); if (e > tol) mask |= 1 << k; } }
    else { for (int k = 0; k < -count; ++k) { const float e = __builtin_bit_cast(float, ctl[CW_DBG + first + k]);
        const int lv = e <= 0.05f ? 0 : e <= 0.2f ? 1 : e <= 1.f ? 2 : e <= 5.f ? 3 : e <= 100.f ? 4 : e <= 1e6f ? 5 : e < 1e9f ? 6 : 7; mask |= lv << (3 * k); } }
    if (mask) c = 2.f + 0.5f * mask;
    for (size_t i = (size_t)blockIdx.x * 256 + threadIdx.x; i < (size_t)NTOK * D; i += (size_t)gridDim.x * 256) args.out[i] = c * args.in[0][i];
}
#endif

#if MK_STAMP
__global__ void stamp_final(Args args, int pa, int pb) {
    const unsigned long long* st = (const unsigned long long*)((const unsigned*)(args.ws + WS_CTL) + CW_STAMPS);
    long long da = (long long)(st[pa + 1] - st[pa]) / 1000, db = (long long)(st[pb + 1] - st[pb]) / 1000;
    if (da < 0) da = 0; if (da > 99) da = 99; if (db < 0) db = 0; if (db > 99) db = 99;
    const float c = 2.f + 0.1f * (float)da, V = 100.f + 10.f * (float)db;
    for (size_t i = (size_t)blockIdx.x * 256 + threadIdx.x; i < (size_t)NTOK * D; i += (size_t)gridDim.x * 256) args.out[i] = i == 0 ? V : c * args.in[0][i];
}
#endif
extern "C" void kernel_launch(void* const* d_in, const int* in_sizes, int n_in, void* d_out, int out_size, void* d_ws, size_t ws_size, hipStream_t stream) {
    static int grid = 0;
    if (grid == 0) {
        if (n_in != 32 || out_size != NTOK * D || ws_size < WS_END) { fprintf(stderr, "kernel_launch: unexpected shapes (n_in %d out %d ws %zu need %zu)\n", n_in, out_size, ws_size, (size_t)WS_END); grid = -1; return; }
        int dev = 0, cus = 0, per_cu = 0;
        if (hipGetDevice(&dev) != hipSuccess || hipDeviceGetAttribute(&cus, hipDeviceAttributeMultiprocessorCount, dev) != hipSuccess) { grid = -1; return; }
        if (hipFuncSetAttribute((const void*)mk_fwd, hipFuncAttributeMaxDynamicSharedMemorySize, LDS_BYTES) != hipSuccess) { fprintf(stderr, "kernel_launch: hipFuncSetAttribute failed\n"); grid = -1; return; }
        if (hipOccupancyMaxActiveBlocksPerMultiprocessor(&per_cu, (const void*)mk_fwd, NTHR, LDS_BYTES) != hipSuccess || per_cu < 1) { fprintf(stderr, "kernel_launch: occupancy query says %d\n", per_cu); (void)hipGetLastError(); }
        grid = cus;
    }
    if (grid < 0) return;
    (void)hipMemsetAsync((char*)d_ws + WS_CTL, 0, CTL_BYTES, stream);
    Args a{};
    for (int i = 0; i < 32; ++i) a.in[i] = (const float*)d_in[i];
    a.out = (float*)d_out; a.ws = (unsigned char*)d_ws;
#if MK_ONE_LAUNCH
    a.ph_lo = 0; a.ph_hi = N_PHASES + MK_SANITIZE;
    hipLaunchKernelGGL(mk_fwd, dim3(grid), dim3(NTHR), LDS_BYTES, stream, a);
#if MK_STAMP
    hipLaunchKernelGGL(stamp_final, dim3(1024), dim3(256), 0, stream, a, MK_STAMP_A, MK_STAMP_B);
#endif
#else
    for (int p = 0; p < N_PHASES + MK_SANITIZE; ++p) { a.ph_lo = p; a.ph_hi = p + 1; hipLaunchKernelGGL(mk_fwd, dim3(grid), dim3(NTHR), LDS_BYTES, stream, a);
#if MK_DEBUG
        const int pb0 = PH_BASE;
        if (p == 0) { hipLaunchKernelGGL(dbg_kernel, dim3(64), dim3(256), 0, stream, a, 1, 0); hipLaunchKernelGGL(dbg_kernel, dim3(64), dim3(256), 0, stream, a, 2, 0); }
        if (p == pb0 + 0) hipLaunchKernelGGL(dbg_kernel, dim3(64), dim3(256), 0, stream, a, 3, 0);
        if (p == pb0 + 1) { hipLaunchKernelGGL(dbg_kernel, dim3(64), dim3(256), 0, stream, a, 4, 0); hipLaunchKernelGGL(dbg_kernel, dim3(64), dim3(256), 0, stream, a, 6, 0); }
        if (p == pb0 + 2) { hipLaunchKernelGGL(dbg_kernel, dim3(64), dim3(256), 0, stream, a, 8, 0); hipLaunchKernelGGL(dbg_kernel, dim3(64), dim3(256), 0, stream, a, 11, 0); }
        if (p == pb0 + 3) { hipLaunchKernelGGL(dbg_kernel, dim3(64), dim3(256), 0, stream, a, 12, 0); hipLaunchKernelGGL(dbg_kernel, dim3(64), dim3(256), 0, stream, a, 13, 0); }
        if (p == pb0 + 4) { hipLaunchKernelGGL(dbg_kernel, dim3(64), dim3(256), 0, stream, a, 14, 0); hipLaunchKernelGGL(dbg_final, dim3(1024), dim3(256), 0, stream, a, 0.05f, 11, 4); break; }
#endif
    }
#endif
}
```

```cpp
#include <hip/hip_runtime.h>
#include <cstdio>
#include <cstdint>

#ifndef MK_DEBUG
#define MK_DEBUG 0
#endif
#ifndef MK_STAMP
#define MK_STAMP 0
#endif
#ifndef MK_STAMP_A
#define MK_STAMP_A 0
#define MK_STAMP_B 1
#endif
#ifndef MK_DUP
#define MK_DUP 0
#endif
#define DUP(g) for (int dup_ = 0; dup_ < 1 + ((MK_DUP >> (g)) & 1); ++dup_)
#ifndef MK_SANITIZE
#define MK_SANITIZE 0
#endif
#ifndef MK_ONE_LAUNCH
#define MK_ONE_LAUNCH 1
#endif

#define GAS __attribute__((address_space(1)))
#define LAS __attribute__((address_space(3)))
typedef unsigned short bf16;
typedef short bf16x8 __attribute__((ext_vector_type(8)));
typedef float f32x4 __attribute__((ext_vector_type(4)));
typedef float f32x16 __attribute__((ext_vector_type(16)));
typedef unsigned u32x4 __attribute__((ext_vector_type(4)));
typedef unsigned u32x2 __attribute__((ext_vector_type(2)));

constexpr int D = 2048, NB = 4, SEQ = 4096, NTOK = NB * SEQ, DEPTH = 2;
constexpr int UW = 5888;
constexpr int C_SQ = 0, C_SK = 512, C_SV = 640, C_HQ = 768, C_HF = 1792, C_HI = 2816, C_HG = 3840, C_CQ = 4864, C_CKV = 5376, C_KR = 5632, INW = 5696;
constexpr int NEXP = 64, DEXP = 512, MAXROWS = 49152;
constexpr float EPS = 1e-6f;
constexpr float LOG2E = 1.4426950408889634f;

constexpr size_t MiB = 1u << 20;
constexpr size_t WS_CTL = 0, CTL_BYTES = 1 * MiB;
constexpr size_t SZ_WIN = (size_t)UW * D * 2, SZ_WUQ = 768 * 512 * 2, SZ_WUKV = 1024 * 256 * 2, SZ_WOUT = (size_t)D * D * 2, SZ_WMQ = 512 * (size_t)D * 2,
                 SZ_WMKV = 1024 * (size_t)D * 2, SZ_WMO = (size_t)D * 512 * 2, SZ_WGU = (size_t)NEXP * 1024 * D * 2, SZ_WD = (size_t)NEXP * D * 512 * 2;
constexpr size_t WL_WIN = 0, WL_WUQ = WL_WIN + SZ_WIN, WL_WUKV = WL_WUQ + SZ_WUQ, WL_WOUT = WL_WUKV + SZ_WUKV, WL_WMQ = WL_WOUT + SZ_WOUT, WL_WMKV = WL_WMQ + SZ_WMQ,
                 WL_WMO = WL_WMKV + SZ_WMKV, WL_WGU = WL_WMO + SZ_WMO, WL_WD = WL_WGU + SZ_WGU, WL_END = WL_WD + SZ_WD;
constexpr size_t WS_W = 1 * MiB;
constexpr size_t WS_PERS = WS_W + 2 * WL_END;
constexpr size_t WS_HN = WS_PERS;
constexpr size_t WS_MEMN = WS_HN + (size_t)NTOK * D * 2;
constexpr size_t WS_MKV = WS_MEMN + 2 * 1024 * (size_t)D * 2;
constexpr size_t WS_MK = WS_MKV + 2 * 1024 * 1024 * 2;
constexpr size_t WS_MVT = WS_MK + 2 * 1024 * 512 * 2;
constexpr size_t WS_ROPE = WS_MVT + 2 * 1024 * 512 * 2;
constexpr size_t WS_MQ = WS_ROPE + 4096 * 32 * 8;
constexpr size_t WS_MO = WS_MQ + (size_t)NTOK * 512 * 2;
constexpr size_t WS_SMALL = WS_MO + (size_t)NTOK * 512 * 2;
constexpr size_t SM_RSTDCQ = 0, SM_RSTDCKV = SM_RSTDCQ + NTOK * 4, SM_RSTDFFN = SM_RSTDCKV + NTOK * 4, SM_EIDX = SM_RSTDFFN + NTOK * 4, SM_GATE = SM_EIDX + NTOK * 8,
                 SM_SLOT = SM_GATE + NTOK * 8, SM_AROW = SM_SLOT + NTOK * 8, SM_LB = SM_AROW + NTOK * 8, SM_ROWTOK = SM_LB + 2 * 1024 * 4, SM_ROWSS = (SM_ROWTOK + (size_t)MAXROWS * 4 + 15) / 16 * 16, SM_RS = SM_ROWSS + (size_t)NTOK * 32 * 4, SM_RW = SM_RS + NTOK * 4, SM_END = SM_RW + (size_t)2 * 2 * 80 * D * 2;
constexpr size_t WS_OVL = (WS_SMALL + SM_END + 4095) / 4096 * 4096;
constexpr size_t OV_U = 0;
constexpr size_t OV_QM = OV_U + (size_t)NTOK * UW * 2;
constexpr size_t OV_KVM = OV_QM + (size_t)NTOK * 768 * 2;
constexpr size_t OV_QF = OV_KVM + (size_t)NTOK * 1024 * 2;
constexpr size_t OV_KF = OV_QF + (size_t)NTOK * 768 * 2;
constexpr size_t OV_VT = OV_KF + (size_t)NTOK * 768 * 2;
constexpr size_t OV_SVT = OV_VT + (size_t)NTOK * 512 * 2;
constexpr size_t OV_QT = OV_SVT + (size_t)NTOK * 128 * 2;
constexpr size_t OV_INTRA = OV_QT + (size_t)NTOK * 1024 * 2;
constexpr size_t OV_UT = OV_INTRA + (size_t)NTOK * 1024 * 2;
constexpr size_t OV_DEC = OV_UT + (size_t)2048 * 128 * 128 * 2;
constexpr size_t OV_MIX = OV_DEC + 2048 * 128 * 4;
constexpr size_t OV_MIXEND = OV_MIX + (size_t)NTOK * D * 2;
constexpr size_t OV_XG = 0;
constexpr size_t OV_HMID = OV_XG + (size_t)MAXROWS * D * 2;
constexpr size_t OV_YB = OV_HMID + (size_t)MAXROWS * 512 * 2;
constexpr size_t OV_MOEEND = OV_YB + (size_t)MAXROWS * D * 2;
constexpr size_t WS_END = WS_OVL + (OV_MIXEND > OV_MOEEND ? OV_MIXEND : OV_MOEEND);
static_assert(WS_END <= (size_t)2048 * MiB, "workspace map must fit 2 GiB");
constexpr int CW_BAR = 4096;
constexpr int CW_CNT = 32768;
constexpr int CW_NMT = 8192 + 128;
constexpr int CW_MTE = 8192 + 256;
constexpr int CW_MTR = 8192 + 768;
constexpr int CW_STAMPS = 14336;

constexpr int LDS_WORK = 131072;
constexpr int MISC_OFF = LDS_WORK;
constexpr int LDS_BYTES = 147456;
constexpr int NWAVES = 8, NTHR = 512;
constexpr int MT_OFF = 0, MT_CN = 80, MT_E = 160, MT_R = 416, MT_B = 672, MT_N = 928, MT_WORDS = 1184, MT_LDS = MISC_OFF + 2048;
constexpr size_t RS2_OFF = (size_t)8 << 20;
constexpr int RT_CAP = 16384;

#define LDS_WAIT() asm volatile("s_waitcnt lgkmcnt(0)" ::: "memory")
#define VM_WAIT() asm volatile("s_waitcnt vmcnt(0)" ::: "memory")
#define BAR_LDS() do { asm volatile("s_waitcnt lgkmcnt(0)" ::: "memory"); __builtin_amdgcn_s_barrier(); asm volatile("" ::: "memory"); } while (0)
#define SBAR() __builtin_amdgcn_sched_barrier(0)
__device__ __forceinline__ unsigned f2bf(float f) { unsigned u = __builtin_bit_cast(unsigned, f); return (u + 0x7fffu + ((u >> 16) & 1u)) >> 16; }
__device__ __forceinline__ unsigned pk2(float lo, float hi) { return f2bf(lo) | (f2bf(hi) << 16); }
__device__ __forceinline__ float bf2f(unsigned b) { return __builtin_bit_cast(float, b << 16); }
__device__ __forceinline__ float bflo(unsigned w) { return __builtin_bit_cast(float, w << 16); }
__device__ __forceinline__ float bfhi(unsigned w) { return __builtin_bit_cast(float, w & 0xffff0000u); }
__device__ __forceinline__ unsigned cvtpk(float lo, float hi) { unsigned r; asm volatile("v_cvt_pk_bf16_f32 %0, %1, %2" : "=v"(r) : "v"(lo), "v"(hi)); return r; }
__device__ __forceinline__ float ex2(float x) { return __builtin_amdgcn_exp2f(x); }
__device__ __forceinline__ float fexp(float x) { return __builtin_amdgcn_exp2f(x * LOG2E); }
__device__ __forceinline__ float flog(float x) { return __builtin_amdgcn_logf(x) * 0.6931471805599453f; }
__device__ __forceinline__ float wave_sum(float v) {
#pragma unroll
    for (int o = 1; o < 64; o <<= 1) v += __shfl_xor(v, o);
    return v;
}
__device__ __forceinline__ int crow(int r, int hi) { return (r & 3) + 8 * (r >> 2) + 4 * hi; }
#define PK4(P, B_, OUT) do { unsigned a0_ = cvtpk(P[B_ + 0], P[B_ + 1]), a1_ = cvtpk(P[B_ + 2], P[B_ + 3]), b0_ = cvtpk(P[B_ + 4], P[B_ + 5]), b1_ = cvtpk(P[B_ + 6], P[B_ + 7]); \
        auto r0_ = __builtin_amdgcn_permlane32_swap(a0_, b0_, false, false); auto r1_ = __builtin_amdgcn_permlane32_swap(a1_, b1_, false, false); \
        u32x4 w_ = {r0_[0], r1_[0], r0_[1], r1_[1]}; OUT = __builtin_bit_cast(bf16x8, w_); } while (0)
__device__ __forceinline__ float swap_max(float v) { return fmaxf(v, __shfl_xor(v, 32)); }
__device__ __forceinline__ float swap_sum(float v) { return v + __shfl_xor(v, 32); }

#define XB_TMO      128
#define XB_XCNT(j)  (256  + 64 * (j))
#define XB_XSUB(j)  (1280 + 64 * (j))
#define XB_XGEN(j)  (2304 + 64 * (j))
#define XB_TOP      3328
#define XB_TOPGEN   3392
#define XCD_BAR_WORDS 3456
#define XB_SPIN_CAP (1u << 22)
__device__ __forceinline__ unsigned xb_ld(unsigned* p)              { return __hip_atomic_load(p, __ATOMIC_RELAXED, __HIP_MEMORY_SCOPE_AGENT); }
__device__ __forceinline__ unsigned xb_add(unsigned* p, unsigned v) { return __hip_atomic_fetch_add(p, v, __ATOMIC_RELAXED, __HIP_MEMORY_SCOPE_AGENT); }
__device__ __forceinline__ unsigned xb_xcc_id() { return (unsigned)__builtin_amdgcn_s_getreg((3 << 11) | 20) & 0xFu; }
#define XB_SPIN(cond, bar) do { unsigned _sp = 0; while (cond) { __builtin_amdgcn_s_sleep(1); \
    if ((++_sp & 255u) == 0u) { if (xb_ld(&(bar)[XB_TMO])) break; if (_sp > XB_SPIN_CAP) { atomicAdd(&(bar)[XB_TMO], 1u); break; } } } } while (0)
struct XcdBarrier { unsigned* bar; unsigned x; volatile LAS unsigned* st; };
__device__ __forceinline__ XcdBarrier xcd_barrier_post(unsigned* bar, volatile LAS unsigned* st) {
    XcdBarrier b; b.bar = bar; b.x = xb_xcc_id(); b.st = st;
    if (threadIdx.x == 0) (void)xb_add(&bar[XB_XCNT(b.x)], 1u);
    return b;
}
__device__ __forceinline__ void xcd_barrier_complete(unsigned* bar, unsigned x, unsigned& nloc, unsigned& nx) {
    const unsigned G = gridDim.x * gridDim.y * gridDim.z;
    unsigned sum, cnt, mine, sp = 0u;
    for (;;) {
        sum = 0u; cnt = 0u; mine = 0u;
#pragma unroll
        for (unsigned j = 0; j < 16; ++j) { const unsigned c = xb_ld(&bar[XB_XCNT(j)]); sum += c; cnt += (c > 0u) ? 1u : 0u; mine = (j == x) ? c : mine; }
        if (sum == G) break;
        __builtin_amdgcn_s_sleep(1);
        if ((++sp & 255u) == 0u) { if (xb_ld(&bar[XB_TMO])) break; if (sp > XB_SPIN_CAP) { atomicAdd(&bar[XB_TMO], 1u); break; } }
    }
    nloc = mine > 0u ? mine : 1u; nx = cnt > 0u ? cnt : 1u;
}
__device__ __forceinline__ void xcd_barrier(const XcdBarrier& b, const bool leader) {
    asm volatile("s_waitcnt vmcnt(0)" ::: "memory");
    __syncthreads();
    if (leader) {
        unsigned* bar = b.bar;
        __builtin_amdgcn_s_waitcnt(0);
        unsigned nloc = b.st[0], nx = b.st[1];
        if (nloc == 0u) { xcd_barrier_complete(bar, b.x, nloc, nx); b.st[0] = nloc; b.st[1] = nx; }
        const unsigned old = xb_add(&bar[XB_XSUB(b.x)], 1u);
        const unsigned gen = old / nloc;
        if (old + 1u == (gen + 1u) * nloc) {
            __builtin_amdgcn_fence(__ATOMIC_RELEASE, "agent");
            asm volatile("s_waitcnt vmcnt(0)" ::: "memory");
            const unsigned og = xb_add(&bar[XB_TOP], 1u);
            const unsigned tg = og / nx;
            if (og + 1u == (tg + 1u) * nx) xb_add(&bar[XB_TOPGEN], 1u);
            else XB_SPIN(xb_ld(&bar[XB_TOPGEN]) == tg, bar);
            __builtin_amdgcn_fence(__ATOMIC_ACQUIRE, "agent");
            xb_add(&bar[XB_XGEN(b.x)], 1u);
            asm volatile("s_waitcnt vmcnt(0)" ::: "memory");
        } else {
            XB_SPIN(xb_ld(&bar[XB_XGEN(b.x)]) == gen, bar);
            __builtin_amdgcn_fence(__ATOMIC_ACQUIRE, "agent");
            asm volatile("s_waitcnt vmcnt(0)" ::: "memory");
        }
    }
    __syncthreads();
}

namespace pg8 {
constexpr int BM = 256, BK = 64, HALF = 128, HTB = HALF * BK * 2, STAGE_BYTES = 8 * HTB, NXCD = 8, WGM = 8;
__host__ __device__ __forceinline__ int lds_byte(int r, int c) { const int st = (r >> 4) * 2 + (c >> 5), rr = r & 15, cc = c & 31, ob = rr * 64 + cc * 2; return st * 1024 + (ob ^ (((ob >> 9) & 1) << 5)); }
__host__ __device__ __forceinline__ void stage_rc(int b, int& R, int& C) { const int st = b / 1024, sb = b % 1024, swz = sb ^ (((sb >> 9) & 1) << 5); R = (st >> 1) * 16 + swz / 64; C = (st & 1) * 32 + (swz % 64) / 2; }
__host__ __device__ __forceinline__ int perm32(int rho) { const int n = rho >> 4, i = rho & 15; return 8 * (i >> 2) + 4 * n + (i & 3); }

struct Unit { int pm, pn; size_t aoff, boff; bf16* obase; int oldc; int half; int roff; int rbase, rend; };
struct Gemm { const bf16* A; const bf16* Bt; int lda, K; const int* rowtok; };

struct StaticOrder {
    int nM, nN, nwg, G, c, lda, K;
    __device__ __forceinline__ void init(int M, int N, int lda_, int K_, int G_, int c_) { nM = M / BM; nN = N / BM; nwg = nM * nN; G = G_; c = c_; lda = lda_; K = K_; }
    __device__ __forceinline__ bool next(int i, Unit& u) const {
        const long L = (long)i * G + c; if (L >= nwg) return false;
        int wgid = (int)L; { const int q = nwg / NXCD, r = nwg % NXCD, xcd = wgid % NXCD, off = wgid / NXCD; wgid = (xcd < r ? xcd * (q + 1) : r * (q + 1) + (xcd - r) * q) + off; }
        const int nig = WGM * nN, gid = wgid / nig, fm = gid * WGM, gsz = (nM - fm) < WGM ? (nM - fm) : WGM;
        u.pm = fm + ((wgid % nig) % gsz); u.pn = (wgid % nig) / gsz;
        u.aoff = (size_t)u.pm * BM * lda * 2; u.boff = (size_t)u.pn * BM * K * 2; u.obase = nullptr; u.oldc = 0; u.half = 0; u.roff = -1; u.rbase = 0; u.rend = 0; return true;
    }
};
struct HalfOrder {
    StaticOrder base;
    __device__ __forceinline__ bool next(int i, Unit& u) const {
        const long L = (long)i * base.G + base.c; if (L >= 2L * base.nwg) return false;
        StaticOrder b2 = base; b2.c = (int)(L >> 1); b2.G = 0;
        if (!b2.next(0, u)) return false;
        const int mh = (int)(L & 1); u.aoff += (size_t)mh * HALF * base.lda * 2; u.half = 1; u.roff = mh * HALF; return true;
    }
};
struct WinPlusExtra {
    StaticOrder base; int nx; long xa, xb; long xa_l, xb_l; bf16* xo; size_t xo_l;
    __device__ __forceinline__ bool next(int i, Unit& u) const {
        const long L = (long)i * base.G + base.c;
        if (L < base.nwg) return base.next(i, u);
        const long m = L - base.nwg; if (m >= nx) return false;
        const int ll = (int)(m >> 4), t = (int)(m & 15); u.pm = t >> 2; u.pn = t & 3;
        u.aoff = (size_t)(xa + ll * xa_l + (long)u.pm * BM * base.lda * 2); u.boff = (size_t)(xb + ll * xb_l + (long)u.pn * BM * base.K * 2);
        u.obase = xo + (size_t)ll * xo_l; u.oldc = 1024; u.half = 0; u.roff = -1; u.rbase = 0; u.rend = 0; return true;
    }
};
struct GroupedOrder {
    const LAS int* tb; int nmt, nN, G, c, lda, K; size_t bstride;
    __device__ __forceinline__ bool next(int i, Unit& u) const {
        const int n = nmt * nN, nfull = n / G * G, rem = n - nfull;
        int L = i * G + c, mh = -1;
        if (2 * rem <= G && L >= nfull) { const int p = L - nfull; if (p >= 2 * rem) return false; L = nfull + (p >> 1); mh = p & 1; }
        else if (L >= n) return false;
        const int mt = L / nN; u.pn = L % nN;
        const unsigned e = (unsigned)__builtin_amdgcn_readfirstlane(tb[MT_E + mt]), rw_ = (unsigned)__builtin_amdgcn_readfirstlane(tb[MT_R + mt]), r0 = rw_ & 0x7fffffffu;
        u.rbase = __builtin_amdgcn_readfirstlane(tb[MT_B + mt]); u.rend = __builtin_amdgcn_readfirstlane(tb[MT_N + mt]);
        u.pm = (int)(r0 >> 8); u.aoff = (size_t)r0 * lda * 2; u.boff = (size_t)e * bstride + (size_t)u.pn * BM * K * 2; u.obase = nullptr; u.oldc = 0; u.half = (int)(rw_ >> 31); u.roff = -1;
        if (mh >= 0) { u.half = 1; u.roff = mh * HALF; u.aoff += (size_t)mh * HALF * lda * 2; }
        return true;
    }
};

struct EpiBf16 {
    static constexpr bool PERM = true;
    bf16* O; int ldc; const float* rowss; const float* rstd;
    __device__ __forceinline__ void operator()(const f32x4 (&acc)[2][2][4][2], const Unit& u, int wr, int wc, int fr, int fq) const {
        const int row0 = u.pm * BM + (u.roff > 0 ? u.roff : 0) + wr * 64 + fr, col0 = u.pn * BM + wc * 32 + 8 * fq;
        bf16* const Ob = u.obase ? u.obase : O; const int ld = u.obase ? u.oldc : ldc;
#pragma unroll
        for (int ai = 0; ai < 2; ++ai) { if (ai == 1 && u.roff >= 0) break;
#pragma unroll
            for (int m = 0; m < 4; ++m) { bf16* rowp = Ob + (size_t)(row0 + ai * HALF + m * 16) * ld + col0;
                float sr = 1.f;
                if (rowss) { const f32x4* sp = (const f32x4*)(rowss + (size_t)(row0 + ai * HALF + m * 16) * 32); f32x4 t = sp[0];
#pragma unroll
                    for (int k = 1; k < 8; ++k) t = t + sp[k];
                    sr = __builtin_amdgcn_rsqf(((t[0] + t[1]) + (t[2] + t[3])) * (1.f / 2048.f) + 1e-6f); }
                if (rstd && !u.obase) sr = rstd[row0 + ai * HALF + m * 16];
#pragma unroll
                for (int bj = 0; bj < 2; ++bj) { const f32x4 v0 = acc[ai][bj][m][0] * sr, v1 = acc[ai][bj][m][1] * sr;
                    u32x4 w; w.x = cvtpk(v0[0], v0[1]); w.y = cvtpk(v0[2], v0[3]); w.z = cvtpk(v1[0], v1[1]); w.w = cvtpk(v1[2], v1[3]);
                    *(u32x4*)(rowp + bj * HALF) = w; } } }
    }
};
struct EpiResid {
    static constexpr bool PERM = true;
    const float* B; float* X; int ldc; bf16* XB; float* rowss;
    __device__ __forceinline__ void operator()(const f32x4 (&acc)[2][2][4][2], const Unit& u, int wr, int wc, int fr, int fq) const {
        const int row0 = u.pm * BM + wr * 64 + fr, col0 = u.pn * BM + wc * 32 + 8 * fq;
#pragma unroll
        for (int ai = 0; ai < 2; ++ai)
#pragma unroll
            for (int m = 0; m < 4; ++m) { const size_t ro = (size_t)(row0 + ai * HALF + m * 16) * ldc + col0; float* rowp = X + ro; const float* bp = B + ro;
                f32x4 b[2][2];
#pragma unroll
                for (int bj = 0; bj < 2; ++bj)
#pragma unroll
                    for (int n = 0; n < 2; ++n) b[bj][n] = *(const f32x4*)(bp + bj * HALF + n * 4);
                float ssq = 0.f;
#pragma unroll
                for (int bj = 0; bj < 2; ++bj) {
#pragma unroll
                    for (int n = 0; n < 2; ++n) { b[bj][n] = b[bj][n] + acc[ai][bj][m][n]; *(f32x4*)(rowp + bj * HALF + n * 4) = b[bj][n]; }
                    if (XB) { const f32x4 v0 = b[bj][0], v1 = b[bj][1]; ssq += (v0[0] * v0[0] + v0[1] * v0[1]) + (v0[2] * v0[2] + v0[3] * v0[3]) + (v1[0] * v1[0] + v1[1] * v1[1]) + (v1[2] * v1[2] + v1[3] * v1[3]);
                        u32x4 w; w.x = cvtpk(v0[0], v0[1]); w.y = cvtpk(v0[2], v0[3]); w.z = cvtpk(v1[0], v1[1]); w.w = cvtpk(v1[2], v1[3]); *(u32x4*)(XB + ro + bj * HALF) = w; } }
                if (XB) { ssq += __shfl_xor(ssq, 16); ssq += __shfl_xor(ssq, 32); if (fq == 0) rowss[(size_t)(row0 + ai * HALF + m * 16) * 32 + u.pn * 4 + wc] = ssq; }
                asm volatile("" ::: "memory"); }
    }
};
struct EpiResid16 {
    static constexpr bool PERM = true;
    bf16* X; int ldc; float* rowss;
    __device__ __forceinline__ void operator()(const f32x4 (&acc)[2][2][4][2], const Unit& u, int wr, int wc, int fr, int fq) const {
        const int row0 = u.pm * BM + wr * 64 + fr, col0 = u.pn * BM + wc * 32 + 8 * fq;
#pragma unroll
        for (int ai = 0; ai < 2; ++ai)
#pragma unroll
            for (int m = 0; m < 4; ++m) { bf16* rowp = X + (size_t)(row0 + ai * HALF + m * 16) * ldc + col0;
                u32x4 b[2];
#pragma unroll
                for (int bj = 0; bj < 2; ++bj) b[bj] = *(const u32x4*)(rowp + bj * HALF);
                float ssq = 0.f;
#pragma unroll
                for (int bj = 0; bj < 2; ++bj) { const f32x4 a0 = acc[ai][bj][m][0], a1 = acc[ai][bj][m][1];
                    const float v0 = bflo(b[bj].x) + a0[0], v1 = bfhi(b[bj].x) + a0[1], v2 = bflo(b[bj].y) + a0[2], v3 = bfhi(b[bj].y) + a0[3];
                    const float v4 = bflo(b[bj].z) + a1[0], v5 = bfhi(b[bj].z) + a1[1], v6 = bflo(b[bj].w) + a1[2], v7 = bfhi(b[bj].w) + a1[3];
                    ssq += ((v0 * v0 + v1 * v1) + (v2 * v2 + v3 * v3)) + ((v4 * v4 + v5 * v5) + (v6 * v6 + v7 * v7));
                    u32x4 w; w.x = cvtpk(v0, v1); w.y = cvtpk(v2, v3); w.z = cvtpk(v4, v5); w.w = cvtpk(v6, v7); *(u32x4*)(rowp + bj * HALF) = w; }
                if (rowss) { ssq += __shfl_xor(ssq, 16); ssq += __shfl_xor(ssq, 32); if (fq == 0) rowss[(size_t)(row0 + ai * HALF + m * 16) * 32 + u.pn * 4 + wc] = ssq; }
                asm volatile("" ::: "memory"); }
    }
};
struct EpiGateUp {
    static constexpr bool PERM = true;
    bf16* H; int ldc; const int* rowtok; const float* rstd;
    __device__ __forceinline__ void operator()(const f32x4 (&acc)[2][2][4][2], const Unit& u, int wr, int wc, int fr, int fq) const {
        const int row0 = u.pm * BM + (u.roff > 0 ? u.roff : 0) + wr * 64 + fr, col0 = u.pn * HALF + wc * 32 + 8 * fq;
        float sc[2][4];
#pragma unroll
        for (int ai = 0; ai < 2; ++ai)
#pragma unroll
            for (int m = 0; m < 4; ++m) { const int r_ = row0 + ai * HALF + m * 16; sc[ai][m] = r_ < u.rend ? rstd[u.rbase + r_] : 0.f; }
#pragma unroll
        for (int ai = 0; ai < 2; ++ai) { if (ai == 1 && u.roff >= 0) break;
#pragma unroll
            for (int m = 0; m < 4; ++m) { bf16* rowp = H + (size_t)(row0 + ai * HALF + m * 16) * ldc + col0;
                float h[8];
#pragma unroll
                for (int n = 0; n < 2; ++n)
#pragma unroll
                    for (int j = 0; j < 4; ++j) { const float g = acc[ai][0][m][n][j] * sc[ai][m], up = acc[ai][1][m][n][j] * sc[ai][m]; h[n * 4 + j] = g * __builtin_amdgcn_rcpf(1.f + fexp(-g)) * up; }
                u32x4 w; w.x = cvtpk(h[0], h[1]); w.y = cvtpk(h[2], h[3]); w.z = cvtpk(h[4], h[5]); w.w = cvtpk(h[6], h[7]);
                *(u32x4*)rowp = w; } }
    }
};

template <class Epi, class Sched, bool GATHER = false>
__device__ __forceinline__ void gemm_phase(LAS unsigned char* lds, const int tid, const Gemm g, const Sched& S, const Epi& E) {
    const int wid = __builtin_amdgcn_readfirstlane(tid >> 6), lane = tid & 63, wr = wid >> 2, wc = wid & 3, fr = lane & 15, fq = lane >> 4;
    const int K = g.K, nt = K / BK, lda = g.lda;
    unsigned voffA[2], voffB[2]; int gR[2], gC[2];
#pragma unroll
    for (int i = 0; i < 2; ++i) { int R, C; stage_rc(tid * 16 + i * 8192, R, C); const int Rb = Epi::PERM ? ((R & ~31) + perm32(R & 31)) : R;
        voffA[i] = (unsigned)(R * lda + C) * 2u; voffB[i] = (unsigned)(Rb * K + C) * 2u; gR[i] = R; gC[i] = C; }
    unsigned vA0[2] = {0u, 0u}, vA1[2] = {0u, 0u}, nA0[2] = {0u, 0u}, nA1[2] = {0u, 0u};
#define PG8_GOFF(d0, d1, un) do { _Pragma("unroll") for (int _i = 0; _i < 2; ++_i) { const int r_ = (un).pm * BM + ((un).roff > 0 ? (un).roff : 0) + gR[_i]; \
        const int t0_ = r_ < (un).rend ? g.rowtok[(un).rbase + r_] : 0, t1_ = r_ + HALF < (un).rend ? g.rowtok[(un).rbase + r_ + HALF] : 0; \
        d0[_i] = (unsigned)(t0_ * lda + gC[_i]) * 2u; d1[_i] = (unsigned)(t1_ * lda + gC[_i]) * 2u; } } while (0)
    const size_t kstep = (size_t)(BK * 2);
    const size_t hstepA = (size_t)HALF * lda * 2, hstepB = (size_t)HALF * K * 2;
    const unsigned ldsw = (unsigned)wid * 1024u;
    const int aoff = lds_byte(wr * 64 + fr, fq * 8), boff = lds_byte(wc * 32 + fr, fq * 8);
#define PG8_SA(b, h) (((b) * 2 + (h)) * HTB)
#define PG8_SB(b, h) ((4 + (b) * 2 + (h)) * HTB)
#define PG8_STAGE(bufoff, gbase, voff) do { _Pragma("unroll") for (int _i = 0; _i < 2; ++_i) \
        __builtin_amdgcn_global_load_lds((const unsigned*)((const char*)(gbase) + (voff)[_i]), (LAS unsigned*)(lds + (bufoff) + ldsw + _i * 8192), 16, 0, 0); } while (0)
#define PG8_LDA(dst, b, h) do { _Pragma("unroll") for (int m = 0; m < 4; ++m) _Pragma("unroll") for (int k = 0; k < 2; ++k) dst[m][k] = *(const LAS bf16x8*)(lds + PG8_SA(b, h) + aoff + m * 2048 + k * 1024); } while (0)
#define PG8_LDB(dst, b, h) do { _Pragma("unroll") for (int n = 0; n < 2; ++n) _Pragma("unroll") for (int k = 0; k < 2; ++k) dst[n][k] = *(const LAS bf16x8*)(lds + PG8_SB(b, h) + boff + n * 2048 + k * 1024); } while (0)
#define PG8_MMA(ai, bj, At, Bt) do { __builtin_amdgcn_s_setprio(1); _Pragma("unroll") for (int m = 0; m < 4; ++m) _Pragma("unroll") for (int n = 0; n < 2; ++n) _Pragma("unroll") for (int k = 0; k < 2; ++k) \
        acc[ai][bj][m][n] = __builtin_amdgcn_mfma_f32_16x16x32_bf16(Bt[n][k], At[m][k], acc[ai][bj][m][n], 0, 0, 0); __builtin_amdgcn_s_setprio(0); } while (0)
#define PG8_WAIT_V(n) asm volatile("s_waitcnt vmcnt(" #n ")" ::: "memory")
#define PG8_WAIT_L(n) asm volatile("s_waitcnt lgkmcnt(" #n ")" ::: "memory")
#define PG8_BAR __builtin_amdgcn_s_barrier()
#define PG8_SCHED __builtin_amdgcn_sched_barrier(0)
    Unit cur, nxt; int ui = 0;
    if (!S.next(0, cur)) return;
    f32x4 acc[2][2][4][2];
#pragma unroll
    for (int a = 0; a < 2; ++a)
#pragma unroll
        for (int b = 0; b < 2; ++b)
#pragma unroll
            for (int m = 0; m < 4; ++m)
#pragma unroll
                for (int n = 0; n < 2; ++n) acc[a][b][m][n] = (f32x4){0.f, 0.f, 0.f, 0.f};
    bf16x8 At[4][2], B0[2][2], B1[2][2];
    const char* cA = GATHER ? (const char*)g.A : (const char*)g.A + cur.aoff; const char* cB = (const char*)g.Bt + cur.boff;
    if constexpr (GATHER) PG8_GOFF(vA0, vA1, cur);
    PG8_STAGE(PG8_SB(0, 0), cB, voffB); PG8_STAGE(PG8_SB(0, 1), cB + hstepB, voffB);
    if constexpr (GATHER) { PG8_STAGE(PG8_SA(0, 0), cA, vA0); PG8_STAGE(PG8_SA(0, 1), cA, vA1); } else { PG8_STAGE(PG8_SA(0, 0), cA, voffA); PG8_STAGE(PG8_SA(0, 1), cA + hstepA, voffA); }
    if (wr == 1) PG8_BAR;
    PG8_WAIT_V(2); PG8_BAR;
    PG8_STAGE(PG8_SB(1, 0), cB + kstep, voffB);
    if constexpr (GATHER) PG8_STAGE(PG8_SA(1, 0), cA + kstep, vA0); else PG8_STAGE(PG8_SA(1, 0), cA + kstep, voffA);
    PG8_STAGE(PG8_SB(1, 1), cB + hstepB + kstep, voffB);
    PG8_WAIT_V(6); PG8_BAR;
    for (;;) {
        const bool has_next = S.next(ui + 1, nxt);
        const char* nA = GATHER ? cA : (has_next ? (const char*)g.A + nxt.aoff : cA); const char* nB = has_next ? (const char*)g.Bt + nxt.boff : cB;
        if constexpr (GATHER) { if (has_next) PG8_GOFF(nA0, nA1, nxt); else { nA0[0] = vA0[0]; nA0[1] = vA0[1]; nA1[0] = vA1[0]; nA1[1] = vA1[1]; } }
#pragma nounroll
        for (int t = 0; t < nt; t += 2) {
            const bool last = (t == nt - 2);
            const char* a1 = cA + (size_t)(t + 1) * kstep;
            const char* a2 = last ? nA : cA + (size_t)(t + 2) * kstep; const char* b2 = last ? nB : cB + (size_t)(t + 2) * kstep;
            const char* a3 = a2 + kstep; const char* b3 = b2 + kstep;
            unsigned s0[2], s1[2];
            if constexpr (GATHER) { s0[0] = last ? nA0[0] : vA0[0]; s0[1] = last ? nA0[1] : vA0[1]; s1[0] = last ? nA1[0] : vA1[0]; s1[1] = last ? nA1[1] : vA1[1]; }
            PG8_LDB(B0, 0, 0); PG8_LDB(B1, 0, 1); PG8_SCHED; PG8_LDA(At, 0, 0);
            if constexpr (GATHER) PG8_STAGE(PG8_SA(1, 1), a1, vA1); else PG8_STAGE(PG8_SA(1, 1), a1 + hstepA, voffA);
            PG8_WAIT_V(8); PG8_WAIT_L(0); PG8_BAR; PG8_MMA(0, 0, At, B0); PG8_MMA(0, 1, At, B1); PG8_BAR; PG8_SCHED;
            PG8_LDA(At, 0, 1); PG8_STAGE(PG8_SB(0, 0), b2, voffB); PG8_STAGE(PG8_SB(0, 1), b2 + hstepB, voffB);
            if constexpr (GATHER) PG8_STAGE(PG8_SA(0, 0), a2, s0); else PG8_STAGE(PG8_SA(0, 0), a2, voffA);
            PG8_WAIT_V(8); PG8_WAIT_L(0); PG8_BAR; if (!cur.half) { PG8_MMA(1, 0, At, B0); PG8_MMA(1, 1, At, B1); } PG8_BAR; PG8_SCHED;
            PG8_LDB(B0, 1, 0); PG8_LDB(B1, 1, 1); PG8_SCHED; PG8_LDA(At, 1, 0);
            if constexpr (GATHER) PG8_STAGE(PG8_SA(0, 1), a2, s1); else PG8_STAGE(PG8_SA(0, 1), a2 + hstepA, voffA);
            PG8_WAIT_V(8); PG8_WAIT_L(0); PG8_BAR; PG8_MMA(0, 0, At, B0); PG8_MMA(0, 1, At, B1); PG8_BAR; PG8_SCHED;
            PG8_LDA(At, 1, 1); PG8_STAGE(PG8_SB(1, 0), b3, voffB); PG8_STAGE(PG8_SB(1, 1), b3 + hstepB, voffB);
            if constexpr (GATHER) PG8_STAGE(PG8_SA(1, 0), a3, s0); else PG8_STAGE(PG8_SA(1, 0), a3, voffA);
            PG8_WAIT_V(8); PG8_WAIT_L(0); PG8_BAR; if (!cur.half) { PG8_MMA(1, 0, At, B0); PG8_MMA(1, 1, At, B1); } PG8_BAR; PG8_SCHED;
        }
        if (wr == 0) PG8_BAR;
        E(acc, cur, wr, wc, fr, fq);
        if (!has_next) break;
#pragma unroll
        for (int a = 0; a < 2; ++a)
#pragma unroll
            for (int b = 0; b < 2; ++b)
#pragma unroll
                for (int m = 0; m < 4; ++m)
#pragma unroll
                    for (int n = 0; n < 2; ++n) acc[a][b][m][n] = (f32x4){0.f, 0.f, 0.f, 0.f};
        cur = nxt; cA = nA; cB = nB; ++ui;
        if constexpr (GATHER) { vA0[0] = nA0[0]; vA0[1] = nA0[1]; vA1[0] = nA1[0]; vA1[1] = nA1[1]; }
        if (wr == 1) PG8_BAR;
    }
    PG8_WAIT_V(0);
    PG8_BAR;
#undef PG8_GOFF
#undef PG8_SA
#undef PG8_SB
#undef PG8_STAGE
#undef PG8_LDA
#undef PG8_LDB
#undef PG8_MMA
#undef PG8_WAIT_V
#undef PG8_WAIT_L
#undef PG8_BAR
#undef PG8_SCHED
}
}

struct Args { const float* in[32]; float* out; unsigned char* ws; int ph_lo, ph_hi; };
struct Frame {
    LAS unsigned char* lds; int tid, lane, wave, G, bid;
    unsigned char* ws; unsigned* ctl; const float* const* in; float* out;
};

__device__ __forceinline__ void transpose_item(const float* W, int K, int N, bf16* WT, int dst_row0, const float* gain, LAS float* scr, int kb, int nb, int lane) {
    const int k0 = 64 * kb, n0 = 32 * nb, c4 = lane & 7, kr = lane >> 3;
    f32x4 v[8];
#pragma unroll
    for (int i = 0; i < 8; ++i) v[i] = *(const f32x4*)(W + (size_t)(k0 + 8 * i + kr) * N + n0 + 4 * c4);
#pragma unroll
    for (int i = 0; i < 8; ++i) { const int kk = 8 * i + kr; const float gk = gain ? gain[k0 + kk] : 1.f; LAS float* d = scr + kk * 33 + 4 * c4;
        d[0] = v[i][0] * gk; d[1] = v[i][1] * gk; d[2] = v[i][2] * gk; d[3] = v[i][3] * gk; }
    LDS_WAIT(); asm volatile("" ::: "memory");
    const int c = lane & 7;
#pragma unroll
    for (int j = 0; j < 4; ++j) { const int n = (lane >> 3) + 8 * j; const LAS float* s = scr + (8 * c) * 33 + n;
        u32x4 o; o.x = pk2(s[0 * 33], s[1 * 33]); o.y = pk2(s[2 * 33], s[3 * 33]); o.z = pk2(s[4 * 33], s[5 * 33]); o.w = pk2(s[6 * 33], s[7 * 33]);
        *(u32x4*)(WT + (size_t)(dst_row0 + n) * K + k0 + 8 * c) = o; }
    LDS_WAIT(); asm volatile("" ::: "memory");
}
struct ConvMat { const float* W; bf16* WT; const float* gain; int K, N, kind; };
__device__ __forceinline__ void convert_matrix(Frame& F, const ConvMat& m, int& base, int gw, int NGW, LAS float* scr) {
    const int nnb = m.N / 32, nkb = m.K / 64, items = nnb * nkb;
    int first = gw - base; if (first < 0) first += NGW;
    for (int it = first; it < items; it += NGW) {
        const int kb = it / nnb, nb = it % nnb, n0 = nb * 32;
        int r0 = n0; if (m.kind == 1) r0 = (n0 >> 7) * 256 + (n0 & 127); else if (m.kind == 2) r0 = (n0 >> 7) * 256 + 128 + (n0 & 127);
        transpose_item(m.W, m.K, m.N, m.WT, r0 - 0, m.gain, scr, kb, nb, F.lane);
        (void)n0;
    }
    base += items; while (base >= NGW) base -= NGW;
}
__device__ __forceinline__ void p_convert(Frame& F) {
    LAS float* scr = (LAS float*)(F.lds + F.wave * 16384);
    const int gw = F.bid * NWAVES + F.wave, NGW = F.G * NWAVES;
    int base = 0;
    for (int l = 0; l < DEPTH; ++l) {
        unsigned char* wl = F.ws + WS_W + (size_t)l * WL_END;
        { ConvMat m{F.in[5] + (size_t)l * D * INW, (bf16*)(wl + WL_WIN), F.in[4] + (size_t)l * D, D, INW, 0}; convert_matrix(F, m, base, gw, NGW, scr); }
        { ConvMat m{F.in[12] + (size_t)l * 512 * 768, (bf16*)(wl + WL_WUQ), F.in[10] + l * 512, 512, 768, 0}; convert_matrix(F, m, base, gw, NGW, scr); }
        { ConvMat m{F.in[13] + (size_t)l * 256 * 1024, (bf16*)(wl + WL_WUKV), F.in[11] + l * 256, 256, 1024, 0}; convert_matrix(F, m, base, gw, NGW, scr); }
        { ConvMat m{F.in[16] + (size_t)l * D * D, (bf16*)(wl + WL_WOUT), nullptr, D, D, 0}; convert_matrix(F, m, base, gw, NGW, scr); }
        { ConvMat m{F.in[19] + (size_t)l * D * 512, (bf16*)(wl + WL_WMQ), F.in[17] + (size_t)l * D, D, 512, 0}; convert_matrix(F, m, base, gw, NGW, scr); }
        { ConvMat m{F.in[20] + (size_t)l * D * 1024, (bf16*)(wl + WL_WMKV), nullptr, D, 1024, 0}; convert_matrix(F, m, base, gw, NGW, scr); }
        { ConvMat m{F.in[23] + (size_t)l * 512 * D, (bf16*)(wl + WL_WMO), nullptr, 512, D, 0}; convert_matrix(F, m, base, gw, NGW, scr); }
        for (int e = 0; e < NEXP; ++e) {
            bf16* gu = (bf16*)(wl + WL_WGU) + (size_t)e * 1024 * D;
            { ConvMat m{F.in[29] + ((size_t)l * NEXP + e) * D * DEXP, gu, F.in[24] + (size_t)l * D, D, DEXP, 1}; convert_matrix(F, m, base, gw, NGW, scr); }
            { ConvMat m{F.in[30] + ((size_t)l * NEXP + e) * D * DEXP, gu, F.in[24] + (size_t)l * D, D, DEXP, 2}; convert_matrix(F, m, base, gw, NGW, scr); }
            { ConvMat m{F.in[31] + ((size_t)l * NEXP + e) * DEXP * D, (bf16*)(wl + WL_WD) + (size_t)e * D * DEXP, nullptr, DEXP, D, 0}; convert_matrix(F, m, base, gw, NGW, scr); }
        }
        { u32x4* z = (u32x4*)((bf16*)(wl + WL_WIN) + (size_t)INW * D); const int n16 = (UW - INW) * D * 2 / 16;
          for (int i = F.bid * NTHR + F.tid; i < n16; i += F.G * NTHR) z[i] = (u32x4){0u, 0u, 0u, 0u}; }
    }
    for (int i = F.bid * NTHR + F.tid; i < 4096 * 32; i += F.G * NTHR) {
        const int pos = i >> 5, j = i & 31;
        const float inv = ex2(-(float)j * (13.287712379549449f / 32.0f));
        const float ang = (float)pos * inv;
        const double rev = (double)ang * 0.15915494309189535; const float fr = (float)(rev - floor(rev));
        float* rp = (float*)(F.ws + WS_ROPE) + 2 * i; rp[0] = __builtin_amdgcn_cosf(fr); rp[1] = __builtin_amdgcn_sinf(fr);
    }
    for (int i = F.bid * NTHR + F.tid; i < 2 * 80 * D; i += F.G * NTHR) { const int l = i / (80 * D), c = (i / D) % 80, k = i % D;
        float w = 0.f; if (c < 8) w = F.in[25][((size_t)l * D + k) * 8 + c]; else if (c >= 16) w = F.in[27][((size_t)l * D + k) * 64 + c - 16];
        w *= F.in[24][(size_t)l * D + k]; const unsigned hi = f2bf(w), lo = f2bf(w - bf2f(hi));
        bf16* rw = (bf16*)(F.ws + WS_SMALL + SM_RW) + (size_t)l * 2 * 80 * D; rw[(size_t)c * D + k] = (bf16)hi; rw[(size_t)(80 + c) * D + k] = (bf16)lo; }
    for (int i = F.bid * NTHR + F.tid; i < 1024; i += F.G * NTHR) {
        float* lb = (float*)(F.ws + WS_SMALL + SM_LB); const float a0 = F.in[3][i], a1 = F.in[3][1024 + i];
        const float mx = fmaxf(a0, a1), e0 = expf(a0 - mx), e1 = expf(a1 - mx), p0 = e0 / (e0 + e1), p1 = e1 / (e0 + e1);
        lb[i] = p0 - p0; lb[1024 + i] = (p0 + p1) - p0;
    }
}

template <int NR, bool MOE>
__device__ __forceinline__ void norm_rows(const float* const (&xin)[NR], float* const (&xout)[NR], bf16* const (&hn)[NR], const float* gain, const bf16* const (&y0)[NR], const bf16* const (&y1)[NR], const float (&g0)[NR], const float (&g1)[NR], int lane) {
    f32x4 v[NR][8]; u32x2 ya[NR][8], yb[NR][8];
#pragma unroll
    for (int n = 0; n < NR; ++n)
#pragma unroll
        for (int j = 0; j < 8; ++j) { v[n][j] = *((const f32x4*)xin[n] + lane + 64 * j); if constexpr (MOE) { ya[n][j] = *((const u32x2*)y0[n] + lane + 64 * j); yb[n][j] = *((const u32x2*)y1[n] + lane + 64 * j); } }
#pragma unroll
    for (int n = 0; n < NR; ++n) { float ss = 0.f;
#pragma unroll
        for (int j = 0; j < 8; ++j) {
            if constexpr (MOE) { const u32x2 a = ya[n][j], b = yb[n][j];
                v[n][j][0] += g0[n] * bflo(a.x) + g1[n] * bflo(b.x); v[n][j][1] += g0[n] * bfhi(a.x) + g1[n] * bfhi(b.x); v[n][j][2] += g0[n] * bflo(a.y) + g1[n] * bflo(b.y); v[n][j][3] += g0[n] * bfhi(a.y) + g1[n] * bfhi(b.y); }
            ss += (v[n][j][0] * v[n][j][0] + v[n][j][1] * v[n][j][1]) + (v[n][j][2] * v[n][j][2] + v[n][j][3] * v[n][j][3]); }
        if (xout[n]) {
#pragma unroll
            for (int j = 0; j < 8; ++j) *((f32x4*)xout[n] + lane + 64 * j) = v[n][j]; }
        if (hn[n]) {
            const float rstd = __builtin_amdgcn_rsqf(wave_sum(ss) * (1.f / D) + EPS);
#pragma unroll
            for (int j = 0; j < 8; ++j) { const f32x4 gv = *((const f32x4*)gain + lane + 64 * j);
                u32x2 o; o.x = pk2(v[n][j][0] * rstd * gv[0], v[n][j][1] * rstd * gv[1]); o.y = pk2(v[n][j][2] * rstd * gv[2], v[n][j][3] * rstd * gv[3]);
                *((u32x2*)hn[n] + lane + 64 * j) = o; }
        } }
}
__device__ __forceinline__ void norm_row(const float* xin, float* xout, bf16* hn, const float* gain, const bf16* y0, const bf16* y1, float g0, float g1, int lane) {
    const float* const xi[1] = {xin}; float* const xo[1] = {xout}; bf16* const h[1] = {hn}; const bf16* const a[1] = {y0}; const bf16* const b[1] = {y1}; const float ga[1] = {g0}, gb[1] = {g1};
    if (y0) norm_rows<1, true>(xi, xo, h, gain, a, b, ga, gb, lane); else norm_rows<1, false>(xi, xo, h, gain, a, b, ga, gb, lane);
}
template <int NR, bool MOE, bool IN16>
__device__ __forceinline__ void stream_rows(const void* const (&xin)[NR], bf16* const (&x16)[NR], float* const (&xf)[NR], float* const (&rs)[NR], const bf16* const (&y0)[NR], const bf16* const (&y1)[NR], const float (&g0)[NR], const float (&g1)[NR], int lane) {
    f32x4 v[NR][8]; u32x2 ya[NR][8], yb[NR][8];
#pragma unroll
    for (int n = 0; n < NR; ++n)
#pragma unroll
        for (int j = 0; j < 8; ++j) {
            if constexpr (IN16) { const u32x2 w = *((const u32x2*)xin[n] + lane + 64 * j); v[n][j] = (f32x4){bflo(w.x), bfhi(w.x), bflo(w.y), bfhi(w.y)}; }
            else v[n][j] = *((const f32x4*)xin[n] + lane + 64 * j);
            if constexpr (MOE) { ya[n][j] = *((const u32x2*)y0[n] + lane + 64 * j); yb[n][j] = *((const u32x2*)y1[n] + lane + 64 * j); } }
#pragma unroll
    for (int n = 0; n < NR; ++n) { float ss = 0.f;
#pragma unroll
        for (int j = 0; j < 8; ++j) {
            if constexpr (MOE) { const u32x2 a = ya[n][j], b = yb[n][j];
                v[n][j][0] += g0[n] * bflo(a.x) + g1[n] * bflo(b.x); v[n][j][1] += g0[n] * bfhi(a.x) + g1[n] * bfhi(b.x); v[n][j][2] += g0[n] * bflo(a.y) + g1[n] * bflo(b.y); v[n][j][3] += g0[n] * bfhi(a.y) + g1[n] * bfhi(b.y); }
            ss += (v[n][j][0] * v[n][j][0] + v[n][j][1] * v[n][j][1]) + (v[n][j][2] * v[n][j][2] + v[n][j][3] * v[n][j][3]); }
        if (xf[n]) {
#pragma unroll
            for (int j = 0; j < 8; ++j) *((f32x4*)xf[n] + lane + 64 * j) = v[n][j]; }
        if (x16[n]) {
#pragma unroll
            for (int j = 0; j < 8; ++j) { u32x2 o; o.x = pk2(v[n][j][0], v[n][j][1]); o.y = pk2(v[n][j][2], v[n][j][3]); *((u32x2*)x16[n] + lane + 64 * j) = o; } }
        if (rs[n]) { const float r = __builtin_amdgcn_rsqf(wave_sum(ss) * (1.f / D) + EPS); if (lane == 0) *rs[n] = r; } }
}
struct AttnU { const bf16* Q; const bf16* K; const bf16* VT; bf16* O; int qs, ks, vts, os, q0, t_lo, t_hi; float* dbg; int qh, oh; float sinkb; };
constexpr int AT_ML = 98304;
template <int DQK, int DV, int MODE, bool QNORM, bool ALLSTAGE = false, bool PIPE3 = false, bool PAIR = false, bool ROT = false>
__device__ __forceinline__ void attn_unit(LAS unsigned char* lds, const int tid, const AttnU u, const float scl2, const float* qgain, const float sink2, const LAS float* biasT) {
    constexpr int NBUF = ALLSTAGE ? 4 : (PIPE3 ? 3 : 2);
    constexpr int KROW = DQK * 2, VROW = 128, KBUF = 64 * KROW, VBUF = DV * VROW, KOFF = 0, VOFF = NBUF * KBUF;
    constexpr int KCH = DQK / 8, NKC = 64 * KCH / 512, NVC = DV * 8 / 512, ND0 = DQK / 16, NDB = DV / 32;
    constexpr int ML = (NBUF * KBUF + NBUF * VBUF <= AT_ML) ? AT_ML : LDS_WORK + 1024;
    static_assert(NBUF * KBUF + NBUF * VBUF <= ML && 4 * 32 * DV * 4 <= ML && ML + 3072 <= LDS_BYTES, "attention LDS map");
    constexpr int NLD = 64 * (DQK / 8) / 512 + DV * 8 / 512;
#define AT_KSWZ(row) (KCH == 16 ? ((row) & 15) : (((row) >> 1) & 7))
    const int wid = __builtin_amdgcn_readfirstlane(tid >> 6), lane = tid & 63, r32 = lane & 31, hi = lane >> 5, g = wid & 3, kh = wid >> 2;
    const LAS float* bT = PAIR ? biasT + kh * 128 : biasT; (void)bT;
    LAS float* Ms = (LAS float*)(lds + ML);
    LAS float* Ls = Ms + 256;
    LAS float* Al = Ls + 256 + wid * 32;
    LAS float* OM = (LAS float*)lds;
    bf16x8 qr[ND0];
    { const bf16* qp = u.Q + (PAIR ? kh * u.qh : 0) + (size_t)(32 * g + r32) * u.qs + 8 * hi;
#pragma unroll
      for (int d0 = 0; d0 < ND0; ++d0) qr[d0] = *(const bf16x8*)(qp + 16 * d0);
      if constexpr (QNORM) {
          float ss = 0.f;
#pragma unroll
          for (int d0 = 0; d0 < ND0; ++d0)
#pragma unroll
              for (int j = 0; j < 8; ++j) { const float v = bf2f((unsigned short)qr[d0][j]); ss += v * v; }
          ss = swap_sum(ss);
          const float rstd = __builtin_amdgcn_rsqf(ss * (1.f / DQK) + EPS);
#pragma unroll
          for (int d0 = 0; d0 < ND0; ++d0) { const f32x4 g0 = *(const f32x4*)(qgain + 16 * d0 + 8 * hi), g1 = *(const f32x4*)(qgain + 16 * d0 + 8 * hi + 4);
              u32x4 w; w.x = pk2(bf2f((unsigned short)qr[d0][0]) * rstd * g0[0], bf2f((unsigned short)qr[d0][1]) * rstd * g0[1]); w.y = pk2(bf2f((unsigned short)qr[d0][2]) * rstd * g0[2], bf2f((unsigned short)qr[d0][3]) * rstd * g0[3]);
              w.z = pk2(bf2f((unsigned short)qr[d0][4]) * rstd * g1[0], bf2f((unsigned short)qr[d0][5]) * rstd * g1[1]); w.w = pk2(bf2f((unsigned short)qr[d0][6]) * rstd * g1[2], bf2f((unsigned short)qr[d0][7]) * rstd * g1[3]);
              qr[d0] = __builtin_bit_cast(bf16x8, w); }
      } }
    unsigned kvo[NKC], vvo[NVC];
#pragma unroll
    for (int i = 0; i < NKC; ++i) { const int p = tid + 512 * i, row = p / KCH, cp = p % KCH; kvo[i] = (unsigned)(row * u.ks + ((cp ^ AT_KSWZ(row)) << 3)); }
#pragma unroll
    for (int i = 0; i < NVC; ++i) { const int p = tid + 512 * i, d = p >> 3, cp = p & 7; vvo[i] = (unsigned)(d * u.vts + ((cp ^ ((d >> 1) & 7)) << 3)); }
#define AT_STAGE(t, bf) do { const bf16* kt_ = u.K + (size_t)(64 * (t)) * u.ks; const bf16* vt_ = u.VT + 64 * (t); \
        _Pragma("unroll") for (int i_ = 0; i_ < NKC; ++i_) __builtin_amdgcn_global_load_lds((const unsigned*)(kt_ + kvo[i_]), (LAS unsigned*)(lds + KOFF + (bf) * KBUF + (512 * i_ + wid * 64) * 16), 16, 0, 0); \
        _Pragma("unroll") for (int i_ = 0; i_ < NVC; ++i_) __builtin_amdgcn_global_load_lds((const unsigned*)(vt_ + vvo[i_]), (LAS unsigned*)(lds + VOFF + (bf) * VBUF + (512 * i_ + wid * 64) * 16), 16, 0, 0); } while (0)
#define AT_STAGE_K(t, bf) do { const bf16* kt_ = u.K + (size_t)(64 * (t)) * u.ks; \
        _Pragma("unroll") for (int i_ = 0; i_ < NKC; ++i_) __builtin_amdgcn_global_load_lds((const unsigned*)(kt_ + kvo[i_]), (LAS unsigned*)(lds + KOFF + (bf) * KBUF + (512 * i_ + wid * 64) * 16), 16, 0, 0); } while (0)
#define AT_STAGE_V(t, bf) do { const bf16* vt_ = u.VT + 64 * (t); \
        _Pragma("unroll") for (int i_ = 0; i_ < NVC; ++i_) __builtin_amdgcn_global_load_lds((const unsigned*)(vt_ + vvo[i_]), (LAS unsigned*)(lds + VOFF + (bf) * VBUF + (512 * i_ + wid * 64) * 16), 16, 0, 0); } while (0)
    float m_run = -1e30f, l_run = 0.f;
    f32x16 o[NDB];
#pragma unroll
    for (int i = 0; i < NDB; ++i)
#pragma unroll
        for (int r = 0; r < 16; ++r) o[i][r] = 0.f;
    const int qa = u.q0 + 32 * g;
    const int qpos = qa + r32;
    const int vswz = (r32 >> 1) & 7;
    int buf = 0;
    if constexpr (ALLSTAGE) {
#pragma unroll
        for (int i = 0; i < 4; ++i) if (u.t_lo + i < u.t_hi) AT_STAGE(u.t_lo + i, i);
        VM_WAIT(); __syncthreads();
    } else if constexpr (PIPE3) {
        AT_STAGE(u.t_lo, 0);
        if (ROT) { if (u.t_lo + 1 < u.t_hi) { AT_STAGE_K(u.t_lo + 1, 1); asm volatile("s_waitcnt vmcnt(%0)" :: "i"(NKC) : "memory"); } else VM_WAIT(); }
        else if (u.t_lo + 1 < u.t_hi) { AT_STAGE(u.t_lo + 1, 1); asm volatile("s_waitcnt vmcnt(%0)" :: "i"(NLD) : "memory"); } else VM_WAIT();
        asm volatile("s_waitcnt lgkmcnt(0)" ::: "memory"); __builtin_amdgcn_s_barrier(); asm volatile("" ::: "memory");
    } else { AT_STAGE(u.t_lo, 0); VM_WAIT(); __syncthreads(); }
    const bool rotw = ROT && kh == 1;
    bf16x8 pa0, pa1; bool pend = false; int pbuf = 0;
#define AT_PV(bi, khx, a0_, a1_) do { int vsw_ = vswz; asm volatile("" : "+v"(vsw_)); const LAS unsigned char* vb_ = lds + VOFF + (bi) * VBUF + r32 * VROW; \
        _Pragma("unroll") for (int ib = 0; ib < NDB; ib += 2) { bf16x8 vf_[2][2]; \
        _Pragma("unroll") for (int i = 0; i < 2; ++i) { vf_[i][0] = *(const LAS bf16x8*)(vb_ + (ib + i) * 32 * VROW + (((4 * (khx) + hi) ^ vsw_) << 4)); vf_[i][1] = *(const LAS bf16x8*)(vb_ + (ib + i) * 32 * VROW + (((4 * (khx) + 2 + hi) ^ vsw_) << 4)); } \
        SBAR(); \
        _Pragma("unroll") for (int i = 0; i < 2; ++i) { o[ib + i] = __builtin_amdgcn_mfma_f32_32x32x16_bf16(a0_, vf_[i][0], o[ib + i], 0, 0, 0); o[ib + i] = __builtin_amdgcn_mfma_f32_32x32x16_bf16(a1_, vf_[i][1], o[ib + i], 0, 0, 0); } \
        SBAR(); } } while (0)
    for (int t = u.t_lo; t < u.t_hi; ++t) {
        if constexpr (PIPE3 && ROT) { if (t + 1 < u.t_hi) AT_STAGE_V(t + 1, buf == 2 ? 0 : buf + 1); if (t + 2 < u.t_hi) AT_STAGE_K(t + 2, buf >= 1 ? buf - 1 : 2); if (rotw && pend) { SBAR(); AT_PV(pbuf, kh, pa0, pa1); SBAR(); } }
        else if constexpr (PIPE3) { if (t + 2 < u.t_hi) AT_STAGE(t + 2, buf >= 1 ? buf - 1 : 2); }
        else if constexpr (!ALLSTAGE) { if (t + 1 < u.t_hi) AT_STAGE(t + 1, buf ^ 1); }
        SBAR();
#pragma unroll
        for (int kk = 0; kk < (PAIR ? 2 : 1); ++kk) {
        const int khv = PAIR ? kk : kh;
        const int krow = 32 * khv + r32, kswz = AT_KSWZ(krow);
        const int kb0 = 64 * t + 32 * khv;
        bool act = true;
#ifndef MK_NOSKIP
        if constexpr (MODE == 1) act = kb0 <= qa + 31;
        if constexpr (MODE == 2) act = (qa + 31 - kb0 >= 0) && (qa - (kb0 + 31) <= 127);
#endif
        if (act) {
            f32x16 p;
#pragma unroll
            for (int r = 0; r < 16; ++r) p[r] = 0.f;
            int ksw = kswz, vsw = vswz; asm volatile("" : "+v"(ksw), "+v"(vsw));
            const LAS unsigned char* kb = lds + KOFF + buf * KBUF + krow * KROW;
            if constexpr (ROT) {
#pragma unroll
              for (int hb = 0; hb < ND0 / 4; ++hb) { bf16x8 kf[4];
#pragma unroll
                for (int d0 = 0; d0 < 4; ++d0) kf[d0] = *(const LAS bf16x8*)(kb + (((2 * (d0 + hb * 4) + hi) ^ ksw) << 4));
                SBAR();
#pragma unroll
                for (int d0 = 0; d0 < 4; ++d0) p = __builtin_amdgcn_mfma_f32_32x32x16_bf16(kf[d0], qr[d0 + hb * 4], p, 0, 0, 0);
                SBAR(); }
            } else
            { bf16x8 kf[ND0];
#pragma unroll
              for (int d0 = 0; d0 < ND0; ++d0) kf[d0] = *(const LAS bf16x8*)(kb + (((2 * d0 + hi) ^ ksw) << 4));
              SBAR();
#pragma unroll
              for (int d0 = 0; d0 < ND0; ++d0) p = __builtin_amdgcn_mfma_f32_32x32x16_bf16(kf[d0], qr[d0], p, 0, 0, 0); }
            const int dq = qpos - kb0 - 4 * hi;
            float pmax = -1e30f, esc = 1.f;
            if (MODE == 1 && kb0 + 31 <= qa) {
#pragma unroll
                for (int r = 0; r < 16; ++r) pmax = fmaxf(pmax, p[r]);
                pmax *= scl2; esc = scl2;
            } else {
#pragma unroll
            for (int r = 0; r < 16; ++r) { const int c = (r & 3) + 8 * (r >> 2); float s = p[r] * scl2;
                if constexpr (MODE == 1) { if (dq - c < 0) s = -__builtin_inff(); }
                if constexpr (MODE == 2) { const int dist = dq - c; const bool ok = (unsigned)dist < 128u; const float bv = bT[ok ? dist : 0]; s = ok ? s + bv : -__builtin_inff(); }
                p[r] = s; pmax = fmaxf(pmax, s); }
            }
#if MK_DEBUG
            if (u.dbg && t == u.t_lo) { for (int r = 0; r < 16; ++r) u.dbg[(wid * 64 + lane) * 16 + r] = p[r]; }
#endif
            const bool keep = __all(pmax - m_run <= 11.5f) != 0;
            float m_new = m_run, alpha = 1.f;
            if (!keep) { pmax = swap_max(pmax); m_new = fmaxf(m_run, pmax); alpha = ex2(m_run - m_new); }
            float ps = 0.f;
#pragma unroll
            for (int r = 0; r < 16; ++r) { p[r] = ex2(__builtin_fmaf(p[r], esc, -m_new)); ps += p[r]; }
            l_run = l_run * alpha + ps; m_run = m_new;
            if (!keep && __any(alpha < 1.f)) {
                if (hi == 0) Al[r32] = alpha;
                LDS_WAIT();
#pragma unroll
                for (int r = 0; r < 16; ++r) { const float a = Al[crow(r, hi)];
#pragma unroll
                    for (int i = 0; i < NDB; ++i) o[i][r] *= a; }
                LDS_WAIT();
            }
            PK4(p, 0, pa0); PK4(p, 8, pa1);
            SBAR();
            if (!rotw) {
            const LAS unsigned char* vb = lds + VOFF + buf * VBUF + r32 * VROW;
            { bf16x8 vf[NDB][2];
#pragma unroll
              for (int i = 0; i < NDB; ++i) { vf[i][0] = *(const LAS bf16x8*)(vb + i * 32 * VROW + (((4 * khv + hi) ^ vsw) << 4)); vf[i][1] = *(const LAS bf16x8*)(vb + i * 32 * VROW + (((4 * khv + 2 + hi) ^ vsw) << 4)); }
              SBAR();
#pragma unroll
              for (int i = 0; i < NDB; ++i) { o[i] = __builtin_amdgcn_mfma_f32_32x32x16_bf16(pa0, vf[i][0], o[i], 0, 0, 0); o[i] = __builtin_amdgcn_mfma_f32_32x32x16_bf16(pa1, vf[i][1], o[i], 0, 0, 0); } }
            }
        }
        if (rotw) { pend = act; pbuf = buf; }
        SBAR();
        }
        if constexpr (ALLSTAGE) { buf += 1; }
        else if constexpr (PIPE3) {
            if (ROT) { if (t + 2 < u.t_hi) asm volatile("s_waitcnt vmcnt(%0)" :: "i"(NKC) : "memory"); else VM_WAIT(); }
            else if (t + 2 < u.t_hi) asm volatile("s_waitcnt vmcnt(%0)" :: "i"(NLD) : "memory"); else VM_WAIT();
            asm volatile("s_waitcnt lgkmcnt(0)" ::: "memory"); __builtin_amdgcn_s_barrier(); asm volatile("" ::: "memory");
            buf = buf == 2 ? 0 : buf + 1; }
        else { VM_WAIT(); __syncthreads(); buf ^= 1; }
    }
    if constexpr (ROT) { if (rotw && pend) AT_PV(pbuf, kh, pa0, pa1); __syncthreads(); }
    if constexpr (ALLSTAGE && !PAIR) __syncthreads();
#undef AT_PV
#undef AT_STAGE_K
#undef AT_STAGE_V
#undef AT_STAGE
#undef AT_KSWZ
#if MK_DEBUG
    if (u.dbg) { u.dbg[8192 + (wid * 64 + lane) * 2] = m_run; u.dbg[8192 + (wid * 64 + lane) * 2 + 1] = l_run;
        for (int i = 0; i < NDB; ++i) for (int r = 0; r < 16; ++r) u.dbg[16384 + ((wid * 64 + lane) * 4 + i) * 16 + r] = o[i][r]; }
#endif
    l_run = swap_sum(l_run);
    if constexpr (PAIR) {
        if (hi == 0) { Ms[wid * 32 + r32] = m_run; Ls[wid * 32 + r32] = l_run; }
        LDS_WAIT();
        const float sk = kh ? u.sinkb : sink2;
#pragma unroll
        for (int r = 0; r < 16; ++r) { const int q = crow(r, hi);
            float L = Ls[wid * 32 + q]; if constexpr (MODE == 2) L += ex2(sk - Ms[wid * 32 + q]);
            const float inv = 1.f / L;
            bf16* orow = u.O + kh * u.oh + (size_t)(32 * g + q) * u.os;
#pragma unroll
            for (int i = 0; i < NDB; ++i) { const float v = o[i][r] * inv; const float vn = __shfl_xor(v, 1);
                if ((r32 & 1) == 0) *(unsigned*)(orow + 32 * i + r32) = pk2(v, vn); }
            SBAR(); }
        __syncthreads();
        return;
    }
    if (hi == 0) { Ms[wid * 32 + r32] = m_run; Ls[wid * 32 + r32] = l_run; }
    if (kh == 1) {
#pragma unroll
        for (int i = 0; i < NDB; ++i)
#pragma unroll
            for (int r = 0; r < 16; ++r) OM[(g * 32 + crow(r, hi)) * DV + 32 * i + r32] = o[i][r];
    }
    LDS_WAIT(); __syncthreads();
    if (kh == 0) {
#pragma unroll
        for (int r = 0; r < 16; ++r) { const int q = crow(r, hi);
            const float m0 = Ms[g * 32 + q], m1 = Ms[(4 + g) * 32 + q], l0 = Ls[g * 32 + q], l1 = Ls[(4 + g) * 32 + q];
            const float mm = fmaxf(m0, m1), a0 = ex2(m0 - mm), a1 = ex2(m1 - mm);
            float L = l0 * a0 + l1 * a1; if constexpr (MODE == 2) L += ex2(sink2 - mm);
            const float inv = 1.f / L;
            bf16* orow = u.O + (size_t)(32 * g + q) * u.os;
#pragma unroll
            for (int i = 0; i < NDB; ++i) { const float v = (o[i][r] * a0 + OM[(g * 32 + q) * DV + 32 * i + r32] * a1) * inv; const float vn = __shfl_xor(v, 1);
                if ((r32 & 1) == 0) *(unsigned*)(orow + 32 * i + r32) = pk2(v, vn); }
            SBAR(); }
    }
    __syncthreads();
}

template <int NC>
__device__ __forceinline__ void transpose_tile64(LAS unsigned char* lds, const bf16* src, int sstr, const float* rowscale, bf16* dst, size_t dstr, int tid) {
    constexpr int CPT = NC / 8;
    const int row = tid >> 3, c0 = (tid & 7) * CPT;
    const float sc = rowscale ? rowscale[row] : 1.f;
#pragma unroll
    for (int i = 0; i < CPT / 8; ++i) { const u32x4 w = *(const u32x4*)(src + (size_t)row * sstr + c0 + 8 * i); const unsigned ww[4] = {w.x, w.y, w.z, w.w};
#pragma unroll
        for (int j = 0; j < 4; ++j) { unsigned lo = ww[j] & 0xffffu, hi = ww[j] >> 16; if (rowscale) { lo = f2bf(bf2f(lo) * sc); hi = f2bf(bf2f(hi) * sc); }
            *(LAS unsigned short*)(lds + (c0 + 8 * i + 2 * j) * 144 + row * 2) = (unsigned short)lo; *(LAS unsigned short*)(lds + (c0 + 8 * i + 2 * j + 1) * 144 + row * 2) = (unsigned short)hi; } }
    LDS_WAIT(); __syncthreads();
    if constexpr (NC == 512) { const int col = tid;
#pragma unroll
        for (int i = 0; i < 8; ++i) *(u32x4*)(dst + (size_t)col * dstr + 8 * i) = *(const LAS u32x4*)(lds + col * 144 + 16 * i); }
    else { const int col = tid >> 2, ch = (tid & 3) * 2;
#pragma unroll
        for (int i = 0; i < 2; ++i) *(u32x4*)(dst + (size_t)col * dstr + 8 * (ch + i)) = *(const LAS u32x4*)(lds + col * 144 + 16 * (ch + i)); }
    __syncthreads();
}

__device__ __forceinline__ void transpose4_tile64x128(LAS unsigned char* lds, const bf16* src, size_t sgap, int sstr, const float* rowscale, bf16* dst, size_t dgap, size_t dstr, int tid) {
    const int row = tid >> 3, c0 = (tid & 7) * 16; const float sc = rowscale ? rowscale[row] : 1.f;
    u32x4 w[4][2];
#pragma unroll
    for (int hh = 0; hh < 4; ++hh)
#pragma unroll
        for (int i = 0; i < 2; ++i) w[hh][i] = *(const u32x4*)(src + hh * sgap + (size_t)row * sstr + c0 + 8 * i);
#pragma unroll
    for (int hh = 0; hh < 4; ++hh)
#pragma unroll
        for (int i = 0; i < 2; ++i) { const unsigned ww[4] = {w[hh][i].x, w[hh][i].y, w[hh][i].z, w[hh][i].w};
#pragma unroll
            for (int j = 0; j < 4; ++j) { unsigned lo = ww[j] & 0xffffu, hi = ww[j] >> 16; if (rowscale) { lo = f2bf(bf2f(lo) * sc); hi = f2bf(bf2f(hi) * sc); }
                *(LAS unsigned short*)(lds + hh * 18432 + (c0 + 8 * i + 2 * j) * 144 + row * 2) = (unsigned short)lo; *(LAS unsigned short*)(lds + hh * 18432 + (c0 + 8 * i + 2 * j + 1) * 144 + row * 2) = (unsigned short)hi; } }
    LDS_WAIT(); __syncthreads();
    const int col = tid >> 2, ch = (tid & 3) * 2;
#pragma unroll
    for (int hh = 0; hh < 4; ++hh)
#pragma unroll
        for (int i = 0; i < 2; ++i) *(u32x4*)(dst + hh * dgap + (size_t)col * dstr + 8 * (ch + i)) = *(const LAS u32x4*)(lds + hh * 18432 + col * 144 + 16 * (ch + i));
    __syncthreads();
}

__device__ __forceinline__ void p_prep(Frame& F, int l) {
    bf16* U = (bf16*)(F.ws + WS_OVL + OV_U); bf16* SVT = (bf16*)(F.ws + WS_OVL + OV_SVT);
    float* rcq = (float*)(F.ws + WS_SMALL + SM_RSTDCQ); float* rckv = (float*)(F.ws + WS_SMALL + SM_RSTDCKV);
    const float* gq = F.in[6] + l * 64; const float* gk = F.in[7] + l * 64;
    const int lane = F.lane;
    for (int tile = F.bid; tile < NTOK / 64; tile += F.G) {
        {
            const int rowb = tile * 64 + F.wave * 8; const int l16 = lane & 15;
            u32x4 wq[8], wk[8], wc[8]; u32x2 wv[8];
#pragma unroll
            for (int rr = 0; rr < 8; ++rr) { const bf16* up = U + (size_t)(rowb + rr) * UW;
                wq[rr] = *(const u32x4*)(up + C_SQ + 8 * lane); wk[rr] = *(const u32x4*)(up + C_SK + 8 * l16); wc[rr] = *(const u32x4*)(up + C_CQ + 8 * lane); wv[rr] = *(const u32x2*)(up + C_CKV + 4 * lane); }
#pragma unroll
            for (int rr = 0; rr < 8; ++rr) { const int row = rowb + rr; bf16* up = U + (size_t)row * UW;
                { const unsigned ww[4] = {wq[rr].x, wq[rr].y, wq[rr].z, wq[rr].w}; float v[8]; float ss = 0.f;
#pragma unroll
                  for (int j = 0; j < 4; ++j) { v[2 * j] = bflo(ww[j]); v[2 * j + 1] = bfhi(ww[j]); ss += v[2 * j] * v[2 * j] + v[2 * j + 1] * v[2 * j + 1]; }
                  ss += __shfl_xor(ss, 1); ss += __shfl_xor(ss, 2); ss += __shfl_xor(ss, 4);
                  const float rstd = __builtin_amdgcn_rsqf(ss * (1.f / 64) + EPS); const float* gp = gq + (lane & 7) * 8;
                  u32x4 o; o.x = pk2(v[0] * rstd * gp[0], v[1] * rstd * gp[1]); o.y = pk2(v[2] * rstd * gp[2], v[3] * rstd * gp[3]); o.z = pk2(v[4] * rstd * gp[4], v[5] * rstd * gp[5]); o.w = pk2(v[6] * rstd * gp[6], v[7] * rstd * gp[7]);
                  *(u32x4*)(up + C_SQ + 8 * lane) = o; }
                { const unsigned ww[4] = {wk[rr].x, wk[rr].y, wk[rr].z, wk[rr].w}; float v[8]; float ss = 0.f;
#pragma unroll
                  for (int j = 0; j < 4; ++j) { v[2 * j] = bflo(ww[j]); v[2 * j + 1] = bfhi(ww[j]); ss += v[2 * j] * v[2 * j] + v[2 * j + 1] * v[2 * j + 1]; }
                  ss += __shfl_xor(ss, 1); ss += __shfl_xor(ss, 2); ss += __shfl_xor(ss, 4);
                  const float rstd = __builtin_amdgcn_rsqf(ss * (1.f / 64) + EPS); const float* gp = gk + (lane & 7) * 8;
                  u32x4 o; o.x = pk2(v[0] * rstd * gp[0], v[1] * rstd * gp[1]); o.y = pk2(v[2] * rstd * gp[2], v[3] * rstd * gp[3]); o.z = pk2(v[4] * rstd * gp[4], v[5] * rstd * gp[5]); o.w = pk2(v[6] * rstd * gp[6], v[7] * rstd * gp[7]);
                  if (lane < 16) *(u32x4*)(up + C_SK + 8 * l16) = o; }
                { const unsigned ww[4] = {wc[rr].x, wc[rr].y, wc[rr].z, wc[rr].w}; float ss = 0.f;
#pragma unroll
                  for (int j = 0; j < 4; ++j) { const float a_ = bflo(ww[j]), b_ = bfhi(ww[j]); ss += a_ * a_ + b_ * b_; }
                  ss = wave_sum(ss); if (lane == 0) rcq[row] = __builtin_amdgcn_rsqf(ss * (1.f / 512) + EPS); }
                { const u32x2 w = wv[rr]; float ss = bflo(w.x) * bflo(w.x) + bfhi(w.x) * bfhi(w.x) + bflo(w.y) * bflo(w.y) + bfhi(w.y) * bfhi(w.y);
                  ss = wave_sum(ss); if (lane == 0) rckv[row] = __builtin_amdgcn_rsqf(ss * (1.f / 256) + EPS); }
            }
        }
        const int b = tile >> 6, s0 = (tile & 63) * 64;
        transpose_tile64<128>(F.lds, U + (size_t)tile * 64 * UW + C_SV, UW, nullptr, SVT + (size_t)b * 128 * SEQ + s0, SEQ, F.tid);
    }
}

__device__ __forceinline__ void p_mla_post(Frame& F, int l) {
    const bf16* U = (const bf16*)(F.ws + WS_OVL + OV_U); const bf16* QM = (const bf16*)(F.ws + WS_OVL + OV_QM); const bf16* KVM = (const bf16*)(F.ws + WS_OVL + OV_KVM);
    bf16* QF = (bf16*)(F.ws + WS_OVL + OV_QF); bf16* KF = (bf16*)(F.ws + WS_OVL + OV_KF); bf16* VT = (bf16*)(F.ws + WS_OVL + OV_VT);
    const float* rcq = (const float*)(F.ws + WS_SMALL + SM_RSTDCQ); const float* rckv = (const float*)(F.ws + WS_SMALL + SM_RSTDCKV);
    const float* rope = (const float*)(F.ws + WS_ROPE);
    const float* gq = F.in[14] + l * 192; const float* gk = F.in[15] + l * 192;
    const int lane = F.lane, h = lane >> 4, lh = lane & 15;
    for (int tile = F.bid; tile < NTOK / 64; tile += F.G) {
        for (int r4 = 0; r4 < 8; r4 += 4) {
            const int rowb = tile * 64 + F.wave * 8 + r4;
            f32x4 csv[4]; u32x4 wn[4][2]; unsigned ra[4][2], rb[4][2]; float scq[4], sck[4];
#pragma unroll
            for (int rr = 0; rr < 4; ++rr) { const int row = rowb + rr, s = row & 4095;
                csv[rr] = *(const f32x4*)(rope + ((size_t)s * 32 + 2 * lh) * 2);
                const bf16* qp = QM + (size_t)row * 768 + h * 192; const bf16* kp = KVM + (size_t)row * 1024 + h * 256; const bf16* kr = U + (size_t)row * UW + C_KR;
                wn[rr][0] = *(const u32x4*)(qp + 8 * lh); wn[rr][1] = *(const u32x4*)(kp + 8 * lh);
                ra[rr][0] = *(const unsigned*)(qp + 128 + 2 * lh); rb[rr][0] = *(const unsigned*)(qp + 160 + 2 * lh);
                ra[rr][1] = *(const unsigned*)(kr + 2 * lh); rb[rr][1] = *(const unsigned*)(kr + 32 + 2 * lh);
                scq[rr] = rcq[row]; sck[rr] = rckv[row]; }
#pragma unroll
            for (int rr = 0; rr < 4; ++rr) { const int row = rowb + rr, b = row >> 12, s = row & 4095; const f32x4 cs = csv[rr];
#pragma unroll
            for (int which = 0; which < 2; ++which) {
                const float sc = which == 0 ? scq[rr] : sck[rr], scr = which == 0 ? sc : 1.f;
                const float* gg = which == 0 ? gq : gk;
                const u32x4 w = wn[rr][which]; const unsigned ww[4] = {w.x, w.y, w.z, w.w};
                const unsigned r1 = ra[rr][which], r2 = rb[rr][which];
                float v[8]; float ss = 0.f;
#pragma unroll
                for (int j = 0; j < 4; ++j) { v[2 * j] = bflo(ww[j]) * sc; v[2 * j + 1] = bfhi(ww[j]) * sc; ss += v[2 * j] * v[2 * j] + v[2 * j + 1] * v[2 * j + 1]; }
                float x1a = bflo(r1) * scr, x1b = bfhi(r1) * scr, x2a = bflo(r2) * scr, x2b = bfhi(r2) * scr;
                ss += x1a * x1a + x1b * x1b + x2a * x2a + x2b * x2b;
                ss += __shfl_xor(ss, 1); ss += __shfl_xor(ss, 2); ss += __shfl_xor(ss, 4); ss += __shfl_xor(ss, 8);
                const float rstd = __builtin_amdgcn_rsqf(ss * (1.f / 192) + EPS);
                const float* g8 = gg + 8 * lh;
                u32x4 o; o.x = pk2(v[0] * rstd * g8[0], v[1] * rstd * g8[1]); o.y = pk2(v[2] * rstd * g8[2], v[3] * rstd * g8[3]); o.z = pk2(v[4] * rstd * g8[4], v[5] * rstd * g8[5]); o.w = pk2(v[6] * rstd * g8[6], v[7] * rstd * g8[7]);
                x1a *= rstd * gg[128 + 2 * lh]; x1b *= rstd * gg[128 + 2 * lh + 1]; x2a *= rstd * gg[160 + 2 * lh]; x2b *= rstd * gg[160 + 2 * lh + 1];
                const float o1a = x1a * cs[0] - x2a * cs[1], o2a = x1a * cs[1] + x2a * cs[0], o1b = x1b * cs[2] - x2b * cs[3], o2b = x1b * cs[3] + x2b * cs[2];
                bf16* op = (which == 0 ? QF : KF) + ((size_t)(b * 4 + h) * SEQ + s) * 192;
                *(u32x4*)(op + 8 * lh) = o; *(unsigned*)(op + 128 + 2 * lh) = pk2(o1a, o1b); *(unsigned*)(op + 160 + 2 * lh) = pk2(o2a, o2b);
            } } }
        const int b = tile >> 6, s0 = (tile & 63) * 64;
        transpose4_tile64x128(F.lds, KVM + (size_t)tile * 64 * 1024 + 128, 256, 1024, rckv + tile * 64, VT + ((size_t)(b * 4) * 128) * SEQ + s0, (size_t)128 * SEQ, SEQ, F.tid);
    }
}

__device__ __forceinline__ void p_mem_post(Frame& F) {
    const int lane = F.lane, h = lane >> 4, lh = lane & 15;
    for (int unit = F.bid; unit < 32; unit += F.G) { const int l = unit >> 4, tile = unit & 15;
        const bf16* MKV = (const bf16*)(F.ws + WS_MKV) + (size_t)l * 1024 * 1024; bf16* MK = (bf16*)(F.ws + WS_MK) + (size_t)l * 1024 * 512; bf16* MVT = (bf16*)(F.ws + WS_MVT) + (size_t)l * 1024 * 512;
        const float* gk = F.in[22] + l * 128;
        for (int rr = 0; rr < 8; ++rr) { const int row = tile * 64 + F.wave * 8 + rr, b = row >> 8, m = row & 255;
            const u32x4 w = *(const u32x4*)(MKV + (size_t)row * 1024 + h * 128 + 8 * lh); const unsigned ww[4] = {w.x, w.y, w.z, w.w}; float v[8]; float ss = 0.f;
#pragma unroll
            for (int j = 0; j < 4; ++j) { v[2 * j] = bflo(ww[j]); v[2 * j + 1] = bfhi(ww[j]); ss += v[2 * j] * v[2 * j] + v[2 * j + 1] * v[2 * j + 1]; }
            ss += __shfl_xor(ss, 1); ss += __shfl_xor(ss, 2); ss += __shfl_xor(ss, 4); ss += __shfl_xor(ss, 8);
            const float rstd = __builtin_amdgcn_rsqf(ss * (1.f / 128) + EPS); const float* g8 = gk + 8 * lh;
            u32x4 o; o.x = pk2(v[0] * rstd * g8[0], v[1] * rstd * g8[1]); o.y = pk2(v[2] * rstd * g8[2], v[3] * rstd * g8[3]); o.z = pk2(v[4] * rstd * g8[4], v[5] * rstd * g8[5]); o.w = pk2(v[6] * rstd * g8[6], v[7] * rstd * g8[7]);
            *(u32x4*)(MK + ((size_t)(b * 4 + h) * 256 + m) * 128 + 8 * lh) = o; }
        const int b = tile >> 2, m0 = (tile & 3) * 64;
        for (int hh = 0; hh < 4; ++hh)
            transpose_tile64<128>(F.lds, MKV + (size_t)tile * 64 * 1024 + 512 + hh * 128, 1024, nullptr, MVT + ((size_t)(b * 4 + hh) * 128) * 256 + m0, 256, F.tid);
    }
}

constexpr int HG_QH = 0, HG_KH = 64 * 272, HG_KT = 2 * 64 * 272, HG_VT = HG_KT + 128 * 144, HG_TOT = HG_VT + 128 * 144;
__device__ __forceinline__ void p_hgrn1(Frame& F, int l) {
    const bf16* U = (const bf16*)(F.ws + WS_OVL + OV_U); bf16* QT = (bf16*)(F.ws + WS_OVL + OV_QT); bf16* INTRA = (bf16*)(F.ws + WS_OVL + OV_INTRA); bf16* UT = (bf16*)(F.ws + WS_OVL + OV_UT);
    float* DEC = (float*)(F.ws + WS_OVL + OV_DEC); const float* lb = (const float*)(F.ws + WS_SMALL + SM_LB) + l * 1024;
    LAS unsigned char* lds = F.lds; LAS float* tot = (LAS float*)(lds + HG_TOT);
    const int tid = F.tid, lane = F.lane, wid = F.wave, r32 = lane & 31, hi = lane >> 5;
    const int cp = tid & 63, part = tid >> 6;
    unsigned fw[8], qw[8], vw[8];
#define H1_LOAD(un) do { const int b_ = (un) >> 9, h_ = ((un) >> 6) & 7, c_ = (un) & 63; const bf16* base = U + (size_t)(b_ * SEQ + 64 * c_ + 8 * part) * UW + h_ * 128 + 2 * cp; \
        _Pragma("unroll") for (int i = 0; i < 8; ++i) { fw[i] = *(const unsigned*)(base + (size_t)i * UW + C_HF); qw[i] = *(const unsigned*)(base + (size_t)i * UW + C_HQ); vw[i] = *(const unsigned*)(base + (size_t)i * UW + C_HI); } } while (0)
    if (F.bid < 2048) H1_LOAD(F.bid);
    for (int unit = F.bid; unit < 2048; unit += F.G) {
        const int b = unit >> 9, h = (unit >> 6) & 7, c = unit & 63, row0 = b * SEQ + 64 * c;
        const float lb0 = lb[h * 128 + 2 * cp], lb1 = lb[h * 128 + 2 * cp + 1];
        float cs0[8], cs1[8], kin0[8], kin1[8]; float run0 = 0.f, run1 = 0.f;
#pragma unroll
        for (int i = 0; i < 8; ++i) { const float f0 = bflo(fw[i]), f1 = bfhi(fw[i]);
            const float sg0 = __builtin_amdgcn_rcpf(1.f + fexp(-f0)), sg1 = __builtin_amdgcn_rcpf(1.f + fexp(-f1));
            run0 += flog(lb0 + (1.f - lb0) * sg0); run1 += flog(lb1 + (1.f - lb1) * sg1); cs0[i] = run0; cs1[i] = run1;
            kin0[i] = (1.f - lb0) * (1.f - sg0); kin1[i] = (1.f - lb1) * (1.f - sg1); }
        tot[part * 128 + 2 * cp] = run0; tot[part * 128 + 2 * cp + 1] = run1;
        BAR_LDS();
        float off0 = 0.f, off1 = 0.f, rr0 = 0.f, rr1 = 0.f, bt0 = 0.f, bt1 = 0.f;
#pragma unroll
        for (int p = 0; p < 8; ++p) { const float t0 = tot[p * 128 + 2 * cp], t1 = tot[p * 128 + 2 * cp + 1];
            if (p < part) { off0 += t0; off1 += t1; } if (p < 4) { rr0 += t0; rr1 += t1; } bt0 += t0; bt1 += t1; }
        const float er0 = fexp(rr0), er1 = fexp(rr1), eb0 = fexp(bt0 - rr0), eb1 = fexp(bt1 - rr1);
        unsigned ktw0[4], ktw1[4], vtw0[4], vtw1[4]; float kp0 = 0.f, kp1 = 0.f; unsigned vp0 = 0u, vp1 = 0u;
#pragma unroll
        for (int i = 0; i < 8; ++i) { const int s = 8 * part + i;
            const float E0 = fexp(off0 + cs0[i] - rr0), E1 = fexp(off1 + cs1[i] - rr1), I0 = __builtin_amdgcn_rcpf(E0), I1 = __builtin_amdgcn_rcpf(E1);
            const float qh0 = bflo(qw[i]) * E0, qh1 = bfhi(qw[i]) * E1, kh0 = kin0[i] * I0, kh1 = kin1[i] * I1;
            *(LAS unsigned*)(lds + HG_QH + s * 272 + cp * 4) = pk2(qh0, qh1);
            *(LAS unsigned*)(lds + HG_KH + s * 272 + cp * 4) = pk2(kh0, kh1);
            *(unsigned*)(QT + (size_t)(row0 + s) * 1024 + h * 128 + 2 * cp) = pk2(qh0 * er0, qh1 * er1);
            const float kt0 = kh0 * eb0, kt1 = kh1 * eb1; const unsigned v0 = vw[i] & 0xffffu, v1 = vw[i] >> 16;
            if (i & 1) { ktw0[i >> 1] = pk2(kp0, kt0); ktw1[i >> 1] = pk2(kp1, kt1); vtw0[i >> 1] = vp0 | (v0 << 16); vtw1[i >> 1] = vp1 | (v1 << 16); }
            else { kp0 = kt0; kp1 = kt1; vp0 = v0; vp1 = v1; } }
        SBAR();
        if (unit + F.G < 2048) H1_LOAD(unit + F.G);
        SBAR();
        *(LAS u32x4*)(lds + HG_KT + (2 * cp) * 144 + part * 16) = (u32x4){ktw0[0], ktw0[1], ktw0[2], ktw0[3]};
        *(LAS u32x4*)(lds + HG_KT + (2 * cp + 1) * 144 + part * 16) = (u32x4){ktw1[0], ktw1[1], ktw1[2], ktw1[3]};
        *(LAS u32x4*)(lds + HG_VT + (2 * cp) * 144 + part * 16) = (u32x4){vtw0[0], vtw0[1], vtw0[2], vtw0[3]};
        *(LAS u32x4*)(lds + HG_VT + (2 * cp + 1) * 144 + part * 16) = (u32x4){vtw1[0], vtw1[1], vtw1[2], vtw1[3]};
        if (part == 0) { DEC[unit * 128 + 2 * cp] = er0 * eb0; DEC[unit * 128 + 2 * cp + 1] = er1 * eb1; }
        BAR_LDS();
        const int tb = wid >> 2, vb = wid & 3;
        bf16x8 pa[2][2];
#pragma unroll
        for (int sb = 0; sb < 2; ++sb) {
            if (sb <= tb) {
                f32x16 p;
#pragma unroll
                for (int r = 0; r < 16; ++r) p[r] = 0.f;
#pragma unroll
                for (int d0 = 0; d0 < 8; ++d0) { const bf16x8 a = *(const LAS bf16x8*)(lds + HG_KH + (32 * sb + r32) * 272 + (16 * d0 + 8 * hi) * 2), bq = *(const LAS bf16x8*)(lds + HG_QH + (32 * tb + r32) * 272 + (16 * d0 + 8 * hi) * 2);
                    p = __builtin_amdgcn_mfma_f32_32x32x16_bf16(a, bq, p, 0, 0, 0); }
#pragma unroll
                for (int r = 0; r < 16; ++r) { const int s = 32 * sb + crow(r, hi), t = 32 * tb + r32; if (s > t) p[r] = 0.f; }
                PK4(p, 0, pa[sb][0]); PK4(p, 8, pa[sb][1]);
            }
        }
        { f32x16 o;
#pragma unroll
          for (int r = 0; r < 16; ++r) o[r] = 0.f;
#pragma unroll
          for (int sb = 0; sb < 2; ++sb) if (sb <= tb) {
#pragma unroll
              for (int ks = 0; ks < 2; ++ks) { const bf16x8 bv = *(const LAS bf16x8*)(lds + HG_VT + (32 * vb + r32) * 144 + (32 * sb + 16 * ks + 8 * hi) * 2);
                  o = __builtin_amdgcn_mfma_f32_32x32x16_bf16(pa[sb][ks], bv, o, 0, 0, 0); } }
#pragma unroll
          for (int r = 0; r < 16; ++r) { const int t = 32 * tb + crow(r, hi); const float v = o[r], vn = __shfl_xor(v, 1);
              if ((r32 & 1) == 0) *(unsigned*)(INTRA + (size_t)(row0 + t) * 1024 + h * 128 + 32 * vb + r32) = pk2(v, vn); } }
#pragma unroll
        for (int j = 0; j < 2; ++j) { const int kbk = 2 * tb + j; f32x16 a2;
#pragma unroll
            for (int r = 0; r < 16; ++r) a2[r] = 0.f;
#pragma unroll
            for (int ks = 0; ks < 4; ++ks) { const bf16x8 av = *(const LAS bf16x8*)(lds + HG_VT + (32 * vb + r32) * 144 + (16 * ks + 8 * hi) * 2), bk = *(const LAS bf16x8*)(lds + HG_KT + (32 * kbk + r32) * 144 + (16 * ks + 8 * hi) * 2);
                a2 = __builtin_amdgcn_mfma_f32_32x32x16_bf16(av, bk, a2, 0, 0, 0); }
#pragma unroll
            for (int r = 0; r < 16; ++r) { const int v = 32 * vb + crow(r, hi); const float x = a2[r], xn = __shfl_xor(x, 1);
                if ((r32 & 1) == 0) *(unsigned*)(UT + ((size_t)unit * 128 + v) * 128 + 32 * kbk + r32) = pk2(x, xn); } }
        BAR_LDS();
    }
}
__device__ __forceinline__ void p_hgrn2(Frame& F) {
    bf16* UT = (bf16*)(F.ws + WS_OVL + OV_UT); const float* DEC = (const float*)(F.ws + WS_OVL + OV_DEC);
    for (int id = F.bid * NTHR + F.tid; id < 32 * 4096; id += F.G * NTHR) {
        const int bh = id >> 12, rem = id & 4095, v = rem >> 5, k4 = rem & 31;
        float st[4] = {0.f, 0.f, 0.f, 0.f};
        for (int c0 = 0; c0 < 64; c0 += 8) {
            u32x2 uu[8]; f32x4 dd[8];
#pragma unroll
            for (int j = 0; j < 8; ++j) { const size_t un = (size_t)bh * 64 + c0 + j; uu[j] = *(const u32x2*)(UT + (un * 128 + v) * 128 + 4 * k4); dd[j] = *(const f32x4*)(DEC + un * 128 + 4 * k4); }
#pragma unroll
            for (int j = 0; j < 8; ++j) { const size_t un = (size_t)bh * 64 + c0 + j;
                u32x2 o; o.x = pk2(st[0], st[1]); o.y = pk2(st[2], st[3]); *(u32x2*)(UT + (un * 128 + v) * 128 + 4 * k4) = o;
                st[0] = st[0] * dd[j][0] + bflo(uu[j].x); st[1] = st[1] * dd[j][1] + bfhi(uu[j].x); st[2] = st[2] * dd[j][2] + bflo(uu[j].y); st[3] = st[3] * dd[j][3] + bfhi(uu[j].y); }
        }
    }
}
__device__ __forceinline__ void p_hgrn3(Frame& F, int l) {
    const bf16* U = (const bf16*)(F.ws + WS_OVL + OV_U); const bf16* QT = (const bf16*)(F.ws + WS_OVL + OV_QT); const bf16* INTRA = (const bf16*)(F.ws + WS_OVL + OV_INTRA); const bf16* UT = (const bf16*)(F.ws + WS_OVL + OV_UT);
    bf16* MIX = (bf16*)(F.ws + WS_OVL + OV_MIX); const float* gout = F.in[9] + l * 128;
    LAS float* OL = (LAS float*)F.lds;
    const int tid = F.tid, lane = F.lane, wid = F.wave, r32 = lane & 31, hi = lane >> 5, tb = wid >> 2, vb = wid & 3;
    bf16x8 fa[8], fb[8];
#define H3_FRAGS(unit_) do { const int b_ = (unit_) >> 9, h_ = ((unit_) >> 6) & 7, c_ = (unit_) & 63, row0_ = b_ * SEQ + 64 * c_; \
        const bf16* ap_ = QT + (size_t)(row0_ + 32 * tb + r32) * 1024 + h_ * 128 + 8 * hi; const bf16* bp_ = UT + ((size_t)(unit_) * 128 + 32 * vb + r32) * 128 + 8 * hi; \
        _Pragma("unroll") for (int ks = 0; ks < 8; ++ks) { fa[ks] = *(const bf16x8*)(ap_ + 16 * ks); fb[ks] = *(const bf16x8*)(bp_ + 16 * ks); } } while (0)
    if (F.bid < 2048) H3_FRAGS(F.bid);
    for (int unit = F.bid; unit < 2048; unit += F.G) {
        const int b = unit >> 9, h = (unit >> 6) & 7, c = unit & 63, row0 = b * SEQ + 64 * c;
        const int t = tid >> 3, j = tid & 7; const size_t row = (size_t)(row0 + t);
        const u32x4 i0 = *(const u32x4*)(INTRA + row * 1024 + h * 128 + 16 * j), i1 = *(const u32x4*)(INTRA + row * 1024 + h * 128 + 16 * j + 8);
        const u32x4 g0 = *(const u32x4*)(U + row * UW + C_HG + h * 128 + 16 * j), g1 = *(const u32x4*)(U + row * UW + C_HG + h * 128 + 16 * j + 8);
        f32x16 acc;
#pragma unroll
        for (int r = 0; r < 16; ++r) acc[r] = 0.f;
#pragma unroll
        for (int ks = 0; ks < 8; ++ks) acc = __builtin_amdgcn_mfma_f32_32x32x16_bf16(fa[ks], fb[ks], acc, 0, 0, 0);
#pragma unroll
        for (int r = 0; r < 16; ++r) OL[(32 * tb + crow(r, hi)) * 132 + 32 * vb + r32] = acc[r];
        SBAR();
        if (unit + F.G < 2048) H3_FRAGS(unit + F.G);
        SBAR();
        BAR_LDS();
        { const unsigned iw[8] = {i0.x, i0.y, i0.z, i0.w, i1.x, i1.y, i1.z, i1.w}, gw[8] = {g0.x, g0.y, g0.z, g0.w, g1.x, g1.y, g1.z, g1.w};
          float o[16]; float ss = 0.f;
#pragma unroll
          for (int i = 0; i < 4; ++i) { const f32x4 x = *(const LAS f32x4*)(OL + t * 132 + 16 * j + 4 * i);
              o[4 * i] = x[0] + bflo(iw[2 * i]); o[4 * i + 1] = x[1] + bfhi(iw[2 * i]); o[4 * i + 2] = x[2] + bflo(iw[2 * i + 1]); o[4 * i + 3] = x[3] + bfhi(iw[2 * i + 1]); }
#pragma unroll
          for (int i = 0; i < 16; ++i) ss += o[i] * o[i];
          ss += __shfl_xor(ss, 1); ss += __shfl_xor(ss, 2); ss += __shfl_xor(ss, 4);
          const float rstd = __builtin_amdgcn_rsqf(ss * (1.f / 128) + EPS);
          unsigned ow[8];
#pragma unroll
          for (int i = 0; i < 8; ++i) { const float ga = bflo(gw[i]), gb = bfhi(gw[i]);
              const float ya = o[2 * i] * rstd * gout[16 * j + 2 * i] * ga * __builtin_amdgcn_rcpf(1.f + fexp(-ga)), yb = o[2 * i + 1] * rstd * gout[16 * j + 2 * i + 1] * gb * __builtin_amdgcn_rcpf(1.f + fexp(-gb));
              ow[i] = pk2(ya, yb); }
          bf16* op = MIX + row * D + 512 + h * 128 + 16 * j;
          *(u32x4*)op = (u32x4){ow[0], ow[1], ow[2], ow[3]}; *(u32x4*)(op + 8) = (u32x4){ow[4], ow[5], ow[6], ow[7]}; }
        BAR_LDS();
    }
#undef H3_FRAGS
}

constexpr int RT_CK = 128, RT_ROWB = RT_CK * 2 + 16, RT_WBUF = 2 * 80 * RT_ROWB, RT_LG = 2 * RT_WBUF;
__device__ __forceinline__ void p_router(Frame& F, int l) {
    const bf16* x = (const bf16*)(F.ws + WS_HN); const float* bgr = F.in[26] + l * 8; const float* ber = F.in[28] + l * 64;
    const bf16* rw = (const bf16*)(F.ws + WS_SMALL + SM_RW) + (size_t)l * 2 * 80 * D;
    float* rstdo = (float*)(F.ws + WS_SMALL + SM_RSTDFFN); int* eidx = (int*)(F.ws + WS_SMALL + SM_EIDX); float* gate = (float*)(F.ws + WS_SMALL + SM_GATE); int* slot = (int*)(F.ws + WS_SMALL + SM_SLOT);
    unsigned* cnt = F.ctl + CW_CNT + l * 64 * 64; int* rt2 = (int*)(F.ws + WS_OVL + OV_XG); float* rs2 = (float*)(F.ws + WS_OVL + OV_XG + RS2_OFF);
    LAS unsigned char* WB = F.lds; LAS float* LG = (LAS float*)(F.lds + RT_LG + F.wave * (16 * 84 * 4));
    const int tid = F.tid, lane = F.lane, c = lane & 15, q = lane >> 4, wv = F.wave;
    const int srow = tid >> 4, sck = tid & 15;
    for (int tg = F.bid; tg < NTOK / 64; tg += F.G) {
        u32x4 wA[5], wB[5];
#define RT_WLOAD(w_, ch) do { _Pragma("unroll") for (int e = 0; e < 5; ++e) w_[e] = *(const u32x4*)(rw + (size_t)(srow + 32 * e) * D + RT_CK * (ch) + sck * 8); } while (0)
#define RT_WSTORE(w_, bf) do { _Pragma("unroll") for (int e = 0; e < 5; ++e) *(LAS u32x4*)(WB + (bf) * RT_WBUF + (srow + 32 * e) * RT_ROWB + sck * 16) = w_[e]; } while (0)
#define RT_XLOAD(x_, ch) do { if (wv < 4) { _Pragma("unroll") for (int i = 0; i < 4; ++i) x_[i] = *(const bf16x8*)(xp + RT_CK * (ch) + 32 * i); } } while (0)
        f32x4 acc[5];
#pragma unroll
        for (int i = 0; i < 5; ++i) acc[i] = (f32x4){0.f, 0.f, 0.f, 0.f};
        float ss = 0.f;
        const bf16* xp = x + (size_t)(tg * 64 + (wv & 3) * 16 + c) * D + 8 * q;
        bf16x8 xv[4], xA[4], xB[4];
        RT_WLOAD(wB, 0); RT_XLOAD(xv, 0);
        RT_WLOAD(wA, 1); RT_XLOAD(xA, 1);
        SBAR();
        RT_WSTORE(wB, 0); BAR_LDS();
#define RT_COMPUTE(bf) do { if (wv < 4) { const LAS unsigned char* wb = WB + (bf) * RT_WBUF + c * RT_ROWB + q * 16; \
            _Pragma("unroll") for (int i = 0; i < 4; ++i) { \
                _Pragma("unroll") for (int j = 0; j < 8; ++j) { const float xf = bf2f((unsigned short)xv[i][j]); ss += xf * xf; } \
                bf16x8 bh[5], bl[5]; \
                _Pragma("unroll") for (int ct = 0; ct < 5; ++ct) { bh[ct] = *(const LAS bf16x8*)(wb + (16 * ct) * RT_ROWB + i * 64); bl[ct] = *(const LAS bf16x8*)(wb + (80 + 16 * ct) * RT_ROWB + i * 64); } \
                SBAR(); \
                _Pragma("unroll") for (int ct = 0; ct < 5; ++ct) { acc[ct] = __builtin_amdgcn_mfma_f32_16x16x32_bf16(xv[i], bh[ct], acc[ct], 0, 0, 0); acc[ct] = __builtin_amdgcn_mfma_f32_16x16x32_bf16(xv[i], bl[ct], acc[ct], 0, 0, 0); } \
                SBAR(); } } } while (0)
#pragma nounroll
        for (int ch = 0; ch < D / RT_CK; ch += 2) {
            if (ch + 2 < D / RT_CK) { RT_WLOAD(wB, ch + 2); RT_XLOAD(xB, ch + 2); }
            SBAR();
            RT_COMPUTE(0);
            SBAR();
            RT_WSTORE(wA, 1);
            if (wv < 4) {
#pragma unroll
                for (int i = 0; i < 4; ++i) xv[i] = xA[i]; }
            BAR_LDS();
            if (ch + 3 < D / RT_CK) { RT_WLOAD(wA, ch + 3); RT_XLOAD(xA, ch + 3); }
            SBAR();
            RT_COMPUTE(1);
            SBAR();
            if (ch + 2 < D / RT_CK) { RT_WSTORE(wB, 0);
                if (wv < 4) {
#pragma unroll
                    for (int i = 0; i < 4; ++i) xv[i] = xB[i]; } }
            BAR_LDS();
        }
#undef RT_COMPUTE
#undef RT_XLOAD
#undef RT_WLOAD
#undef RT_WSTORE
        if (wv < 4) {
            ss += __shfl_xor(ss, 16); ss += __shfl_xor(ss, 32);
            const float rstd = __builtin_amdgcn_rsqf(ss * (1.f / D) + EPS);
#pragma unroll
            for (int ct = 0; ct < 5; ++ct)
#pragma unroll
                for (int r = 0; r < 4; ++r) LG[(4 * q + r) * 84 + 16 * ct + c] = acc[ct][r];
            LDS_WAIT();
            if (lane < 16) {
                const int tok = tg * 64 + wv * 16 + lane; const LAS float* lg = LG + lane * 84;
                float gl[8]; float gm = -3.4e38f; int grp = 0;
#pragma unroll
                for (int j = 0; j < 8; ++j) { gl[j] = lg[j] * rstd + bgr[j]; if (gl[j] > gm) { gm = gl[j]; grp = j; } }
                float gs = 0.f;
#pragma unroll
                for (int j = 0; j < 8; ++j) gs += expf(gl[j] - gm);
                const float pgrp = 1.f / gs;
                float el[8]; float e1 = -3.4e38f; int i1 = 0;
#pragma unroll
                for (int j = 0; j < 8; ++j) { el[j] = lg[16 + grp * 8 + j] * rstd + ber[grp * 8 + j]; if (el[j] > e1) { e1 = el[j]; i1 = j; } }
                float e2 = -3.4e38f; int i2 = 0;
#pragma unroll
                for (int j = 0; j < 8; ++j) if (j != i1 && el[j] > e2) { e2 = el[j]; i2 = j; }
                const float r21 = expf(e2 - e1), g1 = pgrp / (1.f + r21), g2 = pgrp * r21 / (1.f + r21);
                const int ex1 = grp * 8 + i1, ex2_ = grp * 8 + i2;
                const int s1 = (int)atomicAdd(cnt + ex1 * 64, 1u), s2 = (int)atomicAdd(cnt + ex2_ * 64, 1u);
                rt2[ex1 * RT_CAP + s1] = tok; rt2[ex2_ * RT_CAP + s2] = tok; rs2[ex1 * RT_CAP + s1] = rstd; rs2[ex2_ * RT_CAP + s2] = rstd;
                rstdo[tok] = rstd; eidx[2 * tok] = ex1; eidx[2 * tok + 1] = ex2_; gate[2 * tok] = g1; gate[2 * tok + 1] = g2; slot[2 * tok] = s1; slot[2 * tok + 1] = s2;
            }
            LDS_WAIT();
        }
        __syncthreads();
    }
}
__device__ __forceinline__ void p_gather(Frame& F, int l) {
    const int* eidx = (const int*)(F.ws + WS_SMALL + SM_EIDX); const int* slot = (const int*)(F.ws + WS_SMALL + SM_SLOT);
    int* arow = (int*)(F.ws + WS_SMALL + SM_AROW); int* rowtok = (int*)(F.ws + WS_SMALL + SM_ROWTOK);
    const unsigned* cnt = F.ctl + CW_CNT + l * 64 * 64;
    LAS int* OFF = (LAS int*)F.lds;
    LAS int* CN = OFF + 128;
    if (F.tid < 64) {
        const int cn = (int)__hip_atomic_load(cnt + F.tid * 64, __ATOMIC_RELAXED, __HIP_MEMORY_SCOPE_AGENT); const int pd = (cn + 255) & ~255;
        int inc = pd;
#pragma unroll
        for (int o = 1; o < 64; o <<= 1) { const int t = __shfl_up(inc, o); if (F.lane >= o) inc += t; }
        CN[F.tid] = cn; OFF[F.tid] = inc - pd; if (F.tid == 63) OFF[64] = inc;
        if (F.bid == 0) {
            const int e = F.tid, o0 = inc - pd; int n = o0 >> 8;
            for (int r = o0; r < inc; r += 256) { F.ctl[CW_MTE + l * 256 + n] = (unsigned)e; F.ctl[CW_MTR + l * 256 + n] = (unsigned)r | ((o0 + cn - r <= 128) ? 0x80000000u : 0u); ++n; }
            if (e == 63) F.ctl[CW_NMT + l] = (unsigned)(inc >> 8); }
    }
    LDS_WAIT(); __syncthreads();
    for (int tok = F.bid * NTHR + F.tid; tok < NTOK; tok += F.G * NTHR) {
        const int r0 = OFF[eidx[2 * tok]] + slot[2 * tok], r1 = OFF[eidx[2 * tok + 1]] + slot[2 * tok + 1];
        arow[2 * tok] = r0; arow[2 * tok + 1] = r1; rowtok[r0] = tok; rowtok[r1] = tok; }
    for (int e = F.bid; e < 64; e += F.G)
        for (int r = OFF[e] + CN[e] + F.tid; r < OFF[e + 1]; r += NTHR) rowtok[r] = 0;
    __syncthreads();
}

__device__ __forceinline__ int moe_tables(Frame& F, int l) {
    const unsigned* cnt = F.ctl + CW_CNT + l * 64 * 64;
    LAS int* tb = (LAS int*)(F.lds + MT_LDS);
    if (F.tid < 64) {
        const int cn = (int)cnt[F.tid * 64];   const int pd = (cn + 255) & ~255;
        int inc = pd;
#pragma unroll
        for (int o = 1; o < 64; o <<= 1) { const int t = __shfl_up(inc, o); if (F.lane >= o) inc += t; }
        const int e = F.tid, o0 = inc - pd; int n = o0 >> 8;
        tb[MT_CN + e] = cn; tb[MT_OFF + e] = o0; if (e == 63) tb[MT_OFF + 64] = inc;
        for (int r = o0; r < inc; r += 256) { tb[MT_E + n] = e; tb[MT_R + n] = (int)((unsigned)r | ((o0 + cn - r <= 128) ? 0x80000000u : 0u)); tb[MT_B + n] = e * RT_CAP - o0; tb[MT_N + n] = o0 + cn; ++n; }
    }
    LDS_WAIT(); __syncthreads();
    return __builtin_amdgcn_readfirstlane(tb[MT_OFF + 64]) >> 8;
}

constexpr int PH_PER_LAYER = 14, PH_BASE = 1, N_PHASES = PH_BASE + DEPTH * PH_PER_LAYER;
__global__ void __launch_bounds__(NTHR, 2) mk_fwd(Args args) {
    extern __shared__ __attribute__((aligned(16))) unsigned char lds_raw[];
    Frame F; F.lds = (LAS unsigned char*)lds_raw; F.tid = threadIdx.x; F.lane = F.tid & 63; F.wave = __builtin_amdgcn_readfirstlane(F.tid >> 6);
    F.G = gridDim.x; F.bid = blockIdx.x; F.ws = args.ws; F.ctl = (unsigned*)(args.ws + WS_CTL); F.in = args.in; F.out = args.out;
    volatile LAS unsigned* MISC = (volatile LAS unsigned*)(F.lds + MISC_OFF);
    if (F.tid < 64) MISC[F.tid] = 0u;
    __syncthreads();
    XcdBarrier bar = xcd_barrier_post(F.ctl + CW_BAR, MISC + 8);
    const int lo = args.ph_lo, hi = args.ph_hi;
#if MK_STAMP
    if (blockIdx.x == 0 && threadIdx.x == 0) ((unsigned long long*)(F.ctl + CW_STAMPS))[0] = wall_clock64();
#endif
#ifndef MK_PHMASK
#define MK_PHMASK 0xFFFFFFFFu
#endif
#ifndef MK_STOP
#define MK_STOP 1000
#endif
#define IN(k) (lo <= (k) && (k) < hi && ((k) < MK_STOP || (k) >= N_PHASES))
#define EN(j) (((MK_PHMASK) >> (j)) & 1u)
#if MK_STAMP
#define SEAM(k) do { if (IN((k) + 1)) xcd_barrier(bar, P.tid == 0); if (P.bid == 0 && P.tid == 0) ((unsigned long long*)(P.ctl + CW_STAMPS))[(k) + 1] = wall_clock64(); } while (0)
#else
#define SEAM(k) do { if (IN((k) + 1)) xcd_barrier(bar, P.tid == 0); } while (0)
#endif
#define LAUNDER(v) asm volatile("" : "+s"(v))
#define PHASE_FRAME() Frame P = F; int z_ = 0; LAUNDER(z_); asm volatile("v_mbcnt_lo_u32_b32 %0, -1, 0\n\tv_mbcnt_hi_u32_b32 %0, -1, %0" : "=v"(P.tid)); P.tid |= (F.wave << 6) + z_; P.lane = P.tid & 63; P.wave = __builtin_amdgcn_readfirstlane(P.tid >> 6); P.ws = F.ws + z_; P.ctl = F.ctl + z_; P.in = F.in + z_; P.out = F.out + z_; P.G = F.G + z_; P.bid = F.bid + z_; unsigned char* ws = P.ws; (void)ws
    if (EN(14) && IN(0)) {
        PHASE_FRAME();
        p_convert(P);
        const int gw = P.bid * NWAVES + P.wave, NGW = P.G * NWAVES;
        for (int r = gw; r < 2 * 1024; r += NGW) { const int l = r >> 10, row = r & 1023;
            norm_row(P.in[1] + (size_t)row * D, nullptr, (bf16*)(ws + WS_MEMN) + (size_t)r * D, P.in[18] + l * D, nullptr, nullptr, 0.f, 0.f, P.lane); }
        for (int r = gw; r < NTOK; r += 2 * NGW) { const int r2 = r + NGW, rb = r2 < NTOK ? r2 : r;
            float* const rsb = (float*)(ws + WS_SMALL + SM_RS);
            const void* const xi[2] = {P.in[0] + (size_t)r * D, P.in[0] + (size_t)rb * D}; bf16* const x16[2] = {(bf16*)(ws + WS_HN) + (size_t)r * D, (bf16*)(ws + WS_HN) + (size_t)rb * D};
            float* const xf[2] = {nullptr, nullptr}; float* const rs[2] = {rsb + r, rsb + rb}; const bf16* const ya[2] = {nullptr, nullptr}; const float gg[2] = {0.f, 0.f};
            stream_rows<2, false, false>(xi, x16, xf, rs, ya, ya, gg, gg, P.lane); }
        SEAM(0);
    }
    for (int l_ = 0; l_ < DEPTH; ++l_) {
        const int pb = PH_BASE + l_ * PH_PER_LAYER;
#define LAYER_FRAME() PHASE_FRAME(); int l = l_ + z_; const int vcu = (P.G % 8 == 0) ? (P.bid % 8) * (P.G / 8) + P.bid / 8 : P.bid; (void)vcu; unsigned char* wl = ws + WS_W + (size_t)l * WL_END; (void)wl; \
        bf16* U = (bf16*)(ws + WS_OVL + OV_U); bf16* MIX = (bf16*)(ws + WS_OVL + OV_MIX); bf16* HN = (bf16*)(ws + WS_HN); (void)U; (void)MIX; (void)HN
        if (EN(0) && IN(pb + 0)) {
            LAYER_FRAME();
            pg8::Gemm g{HN, (const bf16*)(wl + WL_WIN), D, D}; pg8::EpiBf16 E{U, UW, nullptr, (const float*)(ws + WS_SMALL + SM_RS)};
            pg8::WinPlusExtra S; S.base.init(NTOK, UW, D, D, P.G, P.bid); S.nx = l == 0 ? 32 : 0;
            S.xa = (long)((ws + WS_MEMN) - (ws + WS_HN)); S.xa_l = (long)1024 * D * 2; S.xb = (long)((ws + WS_W + WL_WMKV) - (wl + WL_WIN)); S.xb_l = (long)WL_END;
            S.xo = (bf16*)(ws + WS_MKV); S.xo_l = (size_t)1024 * 1024;
            pg8::gemm_phase(P.lds, P.tid, g, S, E);
            SEAM(pb + 0);
        }
        if (EN(1) && IN(pb + 1)) {
            LAYER_FRAME();
            { pg8::Gemm g{U + C_CQ, (const bf16*)(wl + WL_WUQ), UW, 512}; pg8::StaticOrder S; S.init(NTOK, 768, UW, 512, P.G, P.bid); pg8::EpiBf16 E{(bf16*)(ws + WS_OVL + OV_QM), 768, nullptr, nullptr};
              pg8::gemm_phase(P.lds, P.tid, g, S, E); }
            { pg8::Gemm g{U + C_CKV, (const bf16*)(wl + WL_WUKV), UW, 256}; pg8::StaticOrder S; S.init(NTOK, 1024, UW, 256, P.G, P.bid); pg8::EpiBf16 E{(bf16*)(ws + WS_OVL + OV_KVM), 1024, nullptr, nullptr};
              pg8::gemm_phase(P.lds, P.tid, g, S, E); }
            if (l == 0) p_mem_post(P);
            p_prep(P, l);
            p_hgrn1(P, l);
            SEAM(pb + 1);
        }
        if (EN(2) && IN(pb + 2)) {
            LAYER_FRAME();
            p_mla_post(P, l);
            p_hgrn2(P);
            { LAS float* bias = (LAS float*)(P.lds + AT_ML + 4096);
              for (int i = P.tid; i < 1024; i += NTHR) { const int h = i >> 7, d = i & 127; int bk = d;
                  if (d >= 16) { bk = 16 + (int)(logf((float)d / 16.f) / 2.0794415416798357f * 16.f); if (bk > 31) bk = 31; }
                  bias[i] = P.in[2][bk * 8 + h] * LOG2E; }
              LDS_WAIT(); __syncthreads();
              const bf16* SVT = (const bf16*)(ws + WS_OVL + OV_SVT);
              for (int un = vcu; un < 512; un += P.G) { const int b = un >> 7, h = 2 * ((un >> 5) & 3), qb = un & 31;
                  AttnU a; a.Q = U + (size_t)(b * SEQ + qb * 128) * UW + C_SQ + h * 64; a.qs = UW; a.K = U + (size_t)(b * SEQ) * UW + C_SK + (h >> 2) * 64; a.ks = UW;
                  a.VT = SVT + (size_t)((b * 2 + (h >> 2)) * 64) * SEQ; a.vts = SEQ; a.O = MIX + (size_t)(b * SEQ + qb * 128) * D + h * 64; a.os = D; a.q0 = qb * 128;
                  a.t_lo = qb > 0 ? 2 * qb - 2 : 0; a.t_hi = 2 * qb + 2; a.dbg = nullptr; a.qh = 64; a.oh = 64; a.sinkb = P.in[8][l * 8 + h + 1] * LOG2E;
                  attn_unit<64, 64, 2, false, true, false, true>(P.lds, P.tid, a, 0.125f * LOG2E, nullptr, P.in[8][l * 8 + h] * LOG2E, bias + h * 128); }
            }
            SEAM(pb + 2);
        }
        if (EN(3) && IN(pb + 3)) {
            LAYER_FRAME();
            { const bf16* QF = (const bf16*)(ws + WS_OVL + OV_QF); const bf16* KF = (const bf16*)(ws + WS_OVL + OV_KF); const bf16* VT = (const bf16*)(ws + WS_OVL + OV_VT);
              for (int it = vcu; it < 512; it += P.G) { const int pair = it & 255, bh = pair >> 4, j = pair & 15, qb = it < 256 ? 31 - j : j;
                  AttnU a; a.Q = QF + ((size_t)bh * SEQ + qb * 128) * 192; a.qs = 192; a.K = KF + (size_t)bh * SEQ * 192; a.ks = 192; a.VT = VT + (size_t)bh * 128 * SEQ; a.vts = SEQ;
                  a.O = MIX + ((size_t)(bh >> 2) * SEQ + qb * 128) * D + 1536 + (bh & 3) * 128; a.os = D; a.q0 = qb * 128; a.t_lo = 0; a.t_hi = 2 * qb + 2; a.dbg = nullptr;
                  attn_unit<192, 128, 1, false, false, true, false, true>(P.lds, P.tid, a, 0.07216878364870322f * LOG2E, nullptr, 0.f, nullptr); }
 }
#ifndef MK_NOH3
            p_hgrn3(P, l);
#endif
            SEAM(pb + 3);
        }
        if (EN(4) && IN(pb + 4)) {
            LAYER_FRAME();
            pg8::Gemm g{MIX, (const bf16*)(wl + WL_WOUT), D, D}; pg8::StaticOrder S; S.init(NTOK, D, D, D, P.G, P.bid); pg8::EpiResid16 E{HN, D, (float*)(ws + WS_SMALL + SM_ROWSS)};
            pg8::gemm_phase(P.lds, P.tid, g, S, E);
            SEAM(pb + 4);
        }
        if (EN(6) && IN(pb + 6)) {
            LAYER_FRAME();
            pg8::Gemm g{HN, (const bf16*)(wl + WL_WMQ), D, D}; pg8::HalfOrder S; S.base.init(NTOK, 512, D, D, P.G, P.bid); pg8::EpiBf16 E{(bf16*)(ws + WS_MQ), 512, (const float*)(ws + WS_SMALL + SM_ROWSS), nullptr};
            pg8::gemm_phase(P.lds, P.tid, g, S, E);
            SEAM(pb + 6);
        }
        if (EN(7) && IN(pb + 7)) {
            LAYER_FRAME();
            const bf16* MQ = (const bf16*)(ws + WS_MQ); bf16* MO = (bf16*)(ws + WS_MO);
            const bf16* MK = (const bf16*)(ws + WS_MK) + (size_t)l * 1024 * 512; const bf16* MVT = (const bf16*)(ws + WS_MVT) + (size_t)l * 1024 * 512;
            for (int un = vcu; un < 256; un += P.G) { const int b = un >> 6, h = (un >> 4) & 3, qb = 2 * (un & 15);
                AttnU a; a.Q = MQ + (size_t)(b * SEQ + qb * 128) * 512 + h * 128; a.qs = 512; a.K = MK + (size_t)((b * 4 + h) * 256) * 128; a.ks = 128; a.VT = MVT + (size_t)((b * 4 + h) * 128) * 256; a.vts = 256;
                a.O = MO + (size_t)(b * SEQ + qb * 128) * 512 + h * 128; a.os = 512; a.q0 = 0; a.t_lo = 0; a.t_hi = 4; a.dbg = nullptr; a.qh = 128 * 512; a.oh = 128 * 512; a.sinkb = 0.f;
                attn_unit<128, 128, 0, true, false, true, true>(P.lds, P.tid, a, 0.08838834764831845f * LOG2E, P.in[21] + l * 128, 0.f, nullptr); }
            SEAM(pb + 7);
        }
        if (EN(8) && IN(pb + 8)) {
            LAYER_FRAME();
            pg8::Gemm g{(const bf16*)(ws + WS_MO), (const bf16*)(wl + WL_WMO), 512, 512}; pg8::StaticOrder S; S.init(NTOK, D, 512, 512, P.G, P.bid); pg8::EpiResid16 E{HN, D, nullptr};
            pg8::gemm_phase(P.lds, P.tid, g, S, E);
            SEAM(pb + 8);
        }
        if (EN(9) && IN(pb + 9)) { LAYER_FRAME(); p_router(P, l); SEAM(pb + 9); }
        if (EN(11) && IN(pb + 11)) {
            LAYER_FRAME();
            const int nmt = moe_tables(P, l);
            pg8::Gemm g{HN, (const bf16*)(wl + WL_WGU), D, D, (const int*)(ws + WS_OVL + OV_XG)};
            pg8::GroupedOrder S{(const LAS int*)(P.lds + MT_LDS), nmt, 4, P.G, vcu, D, D, (size_t)1024 * D * 2};
            pg8::EpiGateUp E{(bf16*)(ws + WS_OVL + OV_HMID), 512, (const int*)(ws + WS_OVL + OV_XG), (const float*)(ws + WS_OVL + OV_XG + RS2_OFF)};
            pg8::gemm_phase<pg8::EpiGateUp, pg8::GroupedOrder, true>(P.lds, P.tid, g, S, E);
            SEAM(pb + 11);
        }
        if (EN(12) && IN(pb + 12)) {
            LAYER_FRAME();
            const int nmt = (lo == pb + 12) ? moe_tables(P, l) : (__builtin_amdgcn_readfirstlane(((const LAS int*)(P.lds + MT_LDS))[MT_OFF + 64]) >> 8);
            pg8::Gemm g{(const bf16*)(ws + WS_OVL + OV_HMID), (const bf16*)(wl + WL_WD), 512, 512};
            pg8::GroupedOrder S{(const LAS int*)(P.lds + MT_LDS), nmt, 8, P.G, vcu, 512, 512, (size_t)D * 512 * 2};
            pg8::EpiBf16 E{(bf16*)(ws + WS_OVL + OV_YB), D, nullptr, nullptr};
            pg8::gemm_phase(P.lds, P.tid, g, S, E);
            SEAM(pb + 12);
        }
        if (EN(13) && IN(pb + 13)) {
            LAYER_FRAME();
            const int gw = P.bid * NWAVES + P.wave, NGW = P.G * NWAVES;
            if (lo == pb + 13) (void)moe_tables(P, l); const LAS int* OFFT = (const LAS int*)(P.lds + MT_LDS) + MT_OFF;
            const int* eidx = (const int*)(ws + WS_SMALL + SM_EIDX); const int* slot = (const int*)(ws + WS_SMALL + SM_SLOT);
#define AROW(i) (OFFT[eidx[i]] + slot[i])
            const float* gate = (const float*)(ws + WS_SMALL + SM_GATE); const bf16* YB = (const bf16*)(ws + WS_OVL + OV_YB);
            float* const rsb = (float*)(ws + WS_SMALL + SM_RS); const bool lastl = l + 1 >= DEPTH;
            for (int r = gw; r < NTOK; r += 2 * NGW) { const int r2 = r + NGW;
                if (r2 < NTOK) {
                    const void* const xi[2] = {HN + (size_t)r * D, HN + (size_t)r2 * D}; bf16* const x16[2] = {lastl ? nullptr : HN + (size_t)r * D, lastl ? nullptr : HN + (size_t)r2 * D};
                    float* const xf[2] = {lastl ? P.out + (size_t)r * D : nullptr, lastl ? P.out + (size_t)r2 * D : nullptr}; float* const rs[2] = {lastl ? nullptr : rsb + r, lastl ? nullptr : rsb + r2};
                    const bf16* const ya[2] = {YB + (size_t)AROW(2 * r) * D, YB + (size_t)AROW(2 * r2) * D}; const bf16* const yb[2] = {YB + (size_t)AROW(2 * r + 1) * D, YB + (size_t)AROW(2 * r2 + 1) * D};
                    const float ga[2] = {gate[2 * r], gate[2 * r2]}, gb[2] = {gate[2 * r + 1], gate[2 * r2 + 1]};
                    stream_rows<2, true, true>(xi, x16, xf, rs, ya, yb, ga, gb, P.lane);
                } else {
                    const void* const xi[1] = {HN + (size_t)r * D}; bf16* const x16[1] = {lastl ? nullptr : HN + (size_t)r * D}; float* const xf[1] = {lastl ? P.out + (size_t)r * D : nullptr}; float* const rs[1] = {lastl ? nullptr : rsb + r};
                    const bf16* const ya[1] = {YB + (size_t)AROW(2 * r) * D}; const bf16* const yb[1] = {YB + (size_t)AROW(2 * r + 1) * D}; const float ga[1] = {gate[2 * r]}, gb[1] = {gate[2 * r + 1]};
                    stream_rows<1, true, true>(xi, x16, xf, rs, ya, yb, ga, gb, P.lane); } }
            SEAM(pb + 13);
        }
    }
#if MK_SANITIZE
    if (IN(N_PHASES)) { PHASE_FRAME(); for (size_t i = (size_t)P.bid * NTHR + P.tid; i < (size_t)NTOK * D; i += (size_t)P.G * NTHR) { float v = P.out[i]; if (!(fabsf(v) < 1e30f)) P.out[i] = 0.f; } }
#endif
#undef IN
#undef SEAM
}

#if MK_DEBUG
constexpr int CW_DBG = 12288;
__device__ __forceinline__ unsigned dh(unsigned x) { x ^= x >> 16; x *= 0x7feb352du; x ^= x >> 15; x *= 0x846ca68bu; x ^= x >> 16; return x; }
__device__ __forceinline__ void dbg_put(unsigned* ctl, int k, float got, float want, float scale) {
    float e = fabsf(got - want) / (fabsf(want) + scale); if (!(e == e) || !(fabsf(got) < 1e30f)) e = 1e9f;
    atomicMax(ctl + CW_DBG + k, __builtin_bit_cast(unsigned, e));
}
__device__ double dcos2pi(double fr, bool want_sin) {
    double th = (fr - 0.5) * 6.283185307179586;
    double t2 = th * th, c = 1.0, s = th, tc = 1.0, ts = th;
    for (int n = 1; n < 16; ++n) { tc *= -t2 / ((2.0 * n - 1.0) * (2.0 * n)); c += tc; ts *= -t2 / ((2.0 * n) * (2.0 * n + 1.0)); s += ts; }
    return want_sin ? -s : -c;
}
__global__ void __launch_bounds__(256) dbg_kernel(Args args, int stage, int l) {
    const float* const* in = args.in; unsigned char* ws = args.ws; unsigned* ctl = (unsigned*)(ws + WS_CTL);
    const int gid = blockIdx.x * 256 + threadIdx.x, NT = gridDim.x * 256;
    unsigned char* wl = ws + WS_W + (size_t)l * WL_END;
    const bf16* HN = (const bf16*)(ws + WS_HN); const bf16* U = (const bf16*)(ws + WS_OVL + OV_U); const bf16* MIX = (const bf16*)(ws + WS_OVL + OV_MIX);
    const bf16* WIN = (const bf16*)(wl + WL_WIN);
    if (stage == 1) {
        for (int s = gid; s < 8192; s += NT) { const unsigned h = dh(s * 2654435761u + 12345u);
            { const int n = h % INW, k = (h >> 13) % D; dbg_put(ctl, 1, bf2f(WIN[(size_t)n * D + k]), in[5][((size_t)l * D + k) * INW + n], 1e-3f); }
            { const int n = INW + h % (UW - INW), k = (h >> 13) % D; dbg_put(ctl, 1, bf2f(WIN[(size_t)n * D + k]), 0.f, 1e-3f); }
            { const int n = h % 768, k = (h >> 13) % 512; dbg_put(ctl, 1, bf2f(((const bf16*)(wl + WL_WUQ))[(size_t)n * 512 + k]), in[12][((size_t)l * 512 + k) * 768 + n] * in[10][l * 512 + k], 1e-3f); }
            { const int n = h % 1024, k = (h >> 13) % 256; dbg_put(ctl, 1, bf2f(((const bf16*)(wl + WL_WUKV))[(size_t)n * 256 + k]), in[13][((size_t)l * 256 + k) * 1024 + n] * in[11][l * 256 + k], 1e-3f); }
            { const int n = h % D, k = (h >> 13) % D; dbg_put(ctl, 1, bf2f(((const bf16*)(wl + WL_WOUT))[(size_t)n * D + k]), in[16][((size_t)l * D + k) * D + n], 1e-3f); }
            { const int n = h % 512, k = (h >> 13) % D; dbg_put(ctl, 1, bf2f(((const bf16*)(wl + WL_WMQ))[(size_t)n * D + k]), in[19][((size_t)l * D + k) * 512 + n], 1e-3f); }
            { const int n = h % 1024, k = (h >> 13) % D; dbg_put(ctl, 1, bf2f(((const bf16*)(wl + WL_WMKV))[(size_t)n * D + k]), in[20][((size_t)l * D + k) * 1024 + n], 1e-3f); }
            { const int n = h % D, k = (h >> 13) % 512; dbg_put(ctl, 1, bf2f(((const bf16*)(wl + WL_WMO))[(size_t)n * 512 + k]), in[23][((size_t)l * 512 + k) * D + n], 1e-3f); }
            { const int e = (h >> 3) % NEXP, n = h % DEXP, k = (h >> 13) % D; const bf16* gu = (const bf16*)(wl + WL_WGU) + (size_t)e * 1024 * D;
              dbg_put(ctl, 1, bf2f(gu[(size_t)((n >> 7) * 256 + (n & 127)) * D + k]), in[29][(((size_t)l * NEXP + e) * D + k) * DEXP + n], 1e-3f);
              dbg_put(ctl, 1, bf2f(gu[(size_t)((n >> 7) * 256 + 128 + (n & 127)) * D + k]), in[30][(((size_t)l * NEXP + e) * D + k) * DEXP + n], 1e-3f); }
            { const int e = (h >> 3) % NEXP, n = h % D, k = (h >> 13) % DEXP; dbg_put(ctl, 1, bf2f(((const bf16*)(wl + WL_WD))[((size_t)e * D + n) * DEXP + k]), in[31][(((size_t)l * NEXP + e) * DEXP + k) * D + n], 1e-3f); }
        }
    }
    if (stage == 2) {
        for (int s = gid; s < 512; s += NT) { const unsigned h = dh(s * 977u + 7u); const int r = (s < 4) ? (s & 1 ? NTOK - 1 : 0) : h % NTOK, c = (h >> 15) % D;
            const float* xr = in[0] + (size_t)r * D; float ss = 0.f; for (int k = 0; k < D; ++k) ss += xr[k] * xr[k];
            dbg_put(ctl, 2, bf2f(HN[(size_t)r * D + c]), xr[c] * rsqrtf(ss / D + EPS) * in[4][c], 1e-2f); dbg_put(ctl, 2, args.out[(size_t)r * D + c], xr[c], 1e-6f); }
    }
    if (stage == 3) {
        for (int s = gid; s < 4096; s += NT) { const unsigned h = dh(s * 31u + 99u); const int r = (s < 64) ? ((s & 1) ? NTOK - 1 - (s >> 1) : (s >> 1)) : h % NTOK; const int n = (s & 2) ? (UW - 1 - (h >> 14) % 512) : (h >> 14) % UW;
            float a = 0.f; for (int k = 0; k < D; ++k) a += bf2f(HN[(size_t)r * D + k]) * bf2f(WIN[(size_t)n * D + k]);
            dbg_put(ctl, 3, bf2f(U[(size_t)r * UW + n]), a, 0.05f); }
    }
    if (stage == 4) {
        const bf16* QM = (const bf16*)(ws + WS_OVL + OV_QM); const bf16* KVM = (const bf16*)(ws + WS_OVL + OV_KVM);
        for (int s = gid; s < 4096; s += NT) { const unsigned h = dh(s * 131u + 5u); const int r = h % NTOK;
            { const int n = (h >> 14) % 768; float a = 0.f; for (int k = 0; k < 512; ++k) a += bf2f(U[(size_t)r * UW + C_CQ + k]) * bf2f(((const bf16*)(wl + WL_WUQ))[(size_t)n * 512 + k]); dbg_put(ctl, 4, bf2f(QM[(size_t)r * 768 + n]), a, 0.05f); }
            { const int n = (h >> 14) % 1024; float a = 0.f; for (int k = 0; k < 256; ++k) a += bf2f(U[(size_t)r * UW + C_CKV + k]) * bf2f(((const bf16*)(wl + WL_WUKV))[(size_t)n * 256 + k]); dbg_put(ctl, 5, bf2f(KVM[(size_t)r * 1024 + n]), a, 0.05f); } }
    }
    if (stage == 6) {
        const float* rcq = (const float*)(ws + WS_SMALL + SM_RSTDCQ); const float* rckv = (const float*)(ws + WS_SMALL + SM_RSTDCKV); const bf16* SVT = (const bf16*)(ws + WS_OVL + OV_SVT);
        for (int s = gid; s < 256; s += NT) { const unsigned h = dh(s * 733u + 3u); const int r = h % NTOK, hd = (h >> 14) % 10, d = (h >> 20) % 64;
            const int c0 = hd < 8 ? C_SQ + hd * 64 : C_SK + (hd - 8) * 64; float ss = 0.f, mine = 0.f;
            for (int j = 0; j < 64; ++j) { float a = 0.f; for (int k = 0; k < D; ++k) a += bf2f(HN[(size_t)r * D + k]) * bf2f(WIN[(size_t)(c0 + j) * D + k]); a = bf2f(f2bf(a)); ss += a * a; if (j == d) mine = a; }
            dbg_put(ctl, 6, bf2f(U[(size_t)r * UW + c0 + d]), mine * rsqrtf(ss / 64 + EPS) * (hd < 8 ? in[6][l * 64 + d] : in[7][l * 64 + d]), 0.03f);
            float s1 = 0.f; for (int k = 0; k < 512; ++k) { const float a = bf2f(U[(size_t)r * UW + C_CQ + k]); s1 += a * a; } dbg_put(ctl, 6, rcq[r], rsqrtf(s1 / 512 + EPS), 1e-3f);
            float s2 = 0.f; for (int k = 0; k < 256; ++k) { const float a = bf2f(U[(size_t)r * UW + C_CKV + k]); s2 += a * a; } dbg_put(ctl, 6, rckv[r], rsqrtf(s2 / 256 + EPS), 1e-3f);
            const int b = r >> 12, sp = r & 4095, cc = (h >> 9) % 128; dbg_put(ctl, 7, bf2f(SVT[((size_t)b * 128 + cc) * SEQ + sp]), bf2f(U[(size_t)r * UW + C_SV + cc]), 1e-6f); }
    }
    if (stage == 8) {
        const bf16* QM = (const bf16*)(ws + WS_OVL + OV_QM); const bf16* KVM = (const bf16*)(ws + WS_OVL + OV_KVM); const bf16* QF = (const bf16*)(ws + WS_OVL + OV_QF); const bf16* KF = (const bf16*)(ws + WS_OVL + OV_KF); const bf16* VT = (const bf16*)(ws + WS_OVL + OV_VT);
        const float* rcq = (const float*)(ws + WS_SMALL + SM_RSTDCQ); const float* rckv = (const float*)(ws + WS_SMALL + SM_RSTDCKV);
        for (int s = gid; s < 2048; s += NT) { const unsigned h = dh(s * 3571u + 11u); const int r = h % NTOK, hh = (h >> 14) & 3, d = (h >> 16) % 192, b = r >> 12, sp = r & 4095;
            for (int which = 0; which < 2; ++which) {
                float ss = 0.f;
                for (int j = 0; j < 192; ++j) { float a; if (which == 0) a = bf2f(QM[(size_t)r * 768 + hh * 192 + j]) * rcq[r]; else a = j < 128 ? bf2f(KVM[(size_t)r * 1024 + hh * 256 + j]) * rckv[r] : bf2f(U[(size_t)r * UW + C_KR + j - 128]); ss += a * a; }
                const float rstd = rsqrtf(ss / 192 + EPS); const float* gg = which == 0 ? in[14] + l * 192 : in[15] + l * 192;
                auto el = [&](int j) { float a; if (which == 0) a = bf2f(QM[(size_t)r * 768 + hh * 192 + j]) * rcq[r]; else a = j < 128 ? bf2f(KVM[(size_t)r * 1024 + hh * 256 + j]) * rckv[r] : bf2f(U[(size_t)r * UW + C_KR + j - 128]); return a * rstd * gg[j]; };
                float want;
                if (d < 128) want = el(d);
                else { const int i = (d - 128) & 31; const float inv = powf(10000.f, -(float)i / 32.f); const float ang = (float)sp * inv; const double rev = (double)ang * 0.15915494309189535, fr = rev - floor(rev);
                    const float c = (float)dcos2pi(fr, false), sn = (float)dcos2pi(fr, true); const float x1 = el(128 + i), x2 = el(160 + i); want = d < 160 ? x1 * c - x2 * sn : x1 * sn + x2 * c; }
                dbg_put(ctl, 8 + which, bf2f((which == 0 ? QF : KF)[((size_t)(b * 4 + hh) * SEQ + sp) * 192 + d]), want, 0.03f);
            }
            const int dv = d & 127; dbg_put(ctl, 10, bf2f(VT[((size_t)(b * 4 + hh) * 128 + dv) * SEQ + sp]), bf2f(KVM[(size_t)r * 1024 + hh * 256 + 128 + dv]) * rckv[r], 0.01f); }
    }
    if (stage == 11) {
        for (int s = gid; s < 1024; s += NT) { const unsigned h = dh((s >> 4) * 7919u + 13u); const int cls = (s >> 4) % 3; const int r = cls == 0 ? (h % 4) * 4096 + (h >> 5) % 32 : cls == 1 ? (h % 4) * 4096 + 32 + (h >> 5) % 96 : h % NTOK, hq = (h >> 14) & 7, d = ((h >> 17) & 48) + (s & 15), b = r >> 12, t = r & 4095, hkv = hq >> 2;
            const float sink = in[8][l * 8 + hq]; float mx = sink;
            const int s_lo = t - 127 > 0 ? t - 127 : 0;
            for (int pass = 0; pass < 2; ++pass) { float den = 0.f, num = 0.f;
                for (int sk = s_lo; sk <= t; ++sk) { float sc = 0.f; for (int j = 0; j < 64; ++j) sc += bf2f(U[(size_t)r * UW + C_SQ + hq * 64 + j]) * bf2f(U[(size_t)(b * SEQ + sk) * UW + C_SK + hkv * 64 + j]);
                    const int dist = t - sk; int bk = dist; if (dist >= 16) { bk = 16 + (int)(logf((float)dist / 16.f) / 2.0794415416798357f * 16.f); if (bk > 31) bk = 31; }
                    sc = sc * 0.125f + in[2][bk * 8 + hq];
                    if (pass == 0) mx = fmaxf(mx, sc); else { const float p = expf(sc - mx); den += p; num += p * bf2f(U[(size_t)(b * SEQ + sk) * UW + C_SV + hkv * 64 + d]); } }
                if (pass == 1) { den += expf(sink - mx); dbg_put(ctl, 11, bf2f(MIX[(size_t)r * D + hq * 64 + d]), num / den, 0.2f); dbg_put(ctl, t < 32 ? 16 : t < 128 ? 17 : 18, bf2f(MIX[(size_t)r * D + hq * 64 + d]), num / den, 0.2f); } } }
    }
    if (stage == 12) {
        const bf16* QF = (const bf16*)(ws + WS_OVL + OV_QF); const bf16* KF = (const bf16*)(ws + WS_OVL + OV_KF); const bf16* VT = (const bf16*)(ws + WS_OVL + OV_VT);
        for (int s = gid; s < 512; s += NT) { const unsigned h = dh((s >> 3) * 104729u + 17u); const int cls = (s >> 3) % 4; const int r = cls == 0 ? (h % 4) * 4096 + (h >> 5) % 128 : cls == 1 ? (h % 4) * 4096 + 3968 + (h >> 5) % 128 : cls == 2 ? (h % 4) * 4096 + 128 + (h >> 5) % 128 : h % NTOK, hh = (h >> 14) & 3, d = ((h >> 16) & 120) + (s & 7), b = r >> 12, t = r & 4095;
            const bf16* q = QF + ((size_t)(b * 4 + hh) * SEQ + t) * 192; float mx = -1e30f;
            for (int pass = 0; pass < 2; ++pass) { float den = 0.f, num = 0.f;
                for (int sk = 0; sk <= t; ++sk) { const bf16* kk = KF + ((size_t)(b * 4 + hh) * SEQ + sk) * 192; float sc = 0.f; for (int j = 0; j < 192; ++j) sc += bf2f(q[j]) * bf2f(kk[j]); sc *= 0.07216878364870322f;
                    if (pass == 0) mx = fmaxf(mx, sc); else { const float p = expf(sc - mx); den += p; num += p * bf2f(VT[((size_t)(b * 4 + hh) * 128 + d) * SEQ + sk]); } }
                if (pass == 1) { dbg_put(ctl, 12, bf2f(MIX[(size_t)r * D + 1536 + hh * 128 + d]), num / den, 0.1f); dbg_put(ctl, t < 128 ? 19 : t >= 3968 ? 20 : t < 256 ? 21 : 22, bf2f(MIX[(size_t)r * D + 1536 + hh * 128 + d]), num / den, 0.1f); } } }
    }
    if (stage == 24) {
        const bf16* QF = (const bf16*)(ws + WS_OVL + OV_QF); const bf16* KF = (const bf16*)(ws + WS_OVL + OV_KF); const bf16* VT = (const bf16*)(ws + WS_OVL + OV_VT); const float* DB = (const float*)(ws + WS_MQ);
        const float sc2 = 0.07216878364870322f * LOG2E;
        for (int tl = gid; tl < 512; tl += NT) { const int wid = tl >> 6, lane = tl & 63, r32 = lane & 31, hi = lane >> 5, g = wid & 3, kh = wid >> 2, q = 32 * g + r32;
            float sv[32]; float mx = -1e30f;
            for (int kk = 0; kk < 32; ++kk) { const int key = 32 * kh + kk; float a = 0.f; for (int j = 0; j < 192; ++j) a += bf2f(QF[(size_t)q * 192 + j]) * bf2f(KF[(size_t)key * 192 + j]); a *= sc2; mx = fmaxf(mx, a);
                for (int r = 0; r < 16; ++r) if (crow(r, hi) == kk) dbg_put(ctl, 24, DB[(wid * 64 + lane) * 16 + r], a, 0.5f); }
            float l = 0.f; for (int kk = 0; kk < 32; ++kk) { const int key = 32 * kh + kk; float a = 0.f; for (int j = 0; j < 192; ++j) a += bf2f(QF[(size_t)q * 192 + j]) * bf2f(KF[(size_t)key * 192 + j]); a *= sc2; l += exp2f(a - mx); }
            dbg_put(ctl, 25, DB[8192 + (wid * 64 + lane) * 2], mx, 0.5f); dbg_put(ctl, 26, DB[8192 + (wid * 64 + lane) * 2 + 1], l, 0.5f);
            for (int i = 0; i < 4; ++i) for (int r = 0; r < 16; r += 5) { const int qq = 32 * g + crow(r, hi), d = 32 * i + r32; float m2 = -1e30f, acc = 0.f;
                for (int pass = 0; pass < 2; ++pass) for (int kk = 0; kk < 32; ++kk) { const int key = 32 * kh + kk; float a = 0.f; for (int j = 0; j < 192; ++j) a += bf2f(QF[(size_t)qq * 192 + j]) * bf2f(KF[(size_t)key * 192 + j]); a *= sc2;
                    if (pass == 0) m2 = fmaxf(m2, a); else acc += exp2f(a - m2) * bf2f(VT[(size_t)d * SEQ + key]); }
                dbg_put(ctl, 27, DB[16384 + ((wid * 64 + lane) * 4 + i) * 16 + r], acc, 0.3f); }
            (void)sv; }
    }
    if (stage == 13) {
        __shared__ float so[128]; const float* lb = (const float*)(ws + WS_SMALL + SM_LB) + l * 1024;
        for (int smp = blockIdx.x; smp < 64; smp += gridDim.x) { const unsigned h = dh(smp * 15485863u + 19u); const int r = smp < 4 ? ((smp & 1) ? 4096 + 63 + (smp >> 1) * 64 : (smp >> 1) * 70) : h % NTOK, hh = (h >> 14) & 7, b = r >> 12, t = r & 4095; const int v = threadIdx.x & 127;
            float o = 0.f;
            if (threadIdx.x < 128) {
                for (int k = 0; k < 128; ++k) { const float lbv = lb[hh * 128 + k]; const float q = bf2f(U[(size_t)r * UW + C_HQ + hh * 128 + k]); float dcy = 1.f, acc = 0.f;
                    for (int sk = t; sk >= 0 && dcy > 1e-12f; --sk) { const size_t rr = (size_t)(b * SEQ + sk) * UW; const float f = bf2f(U[rr + C_HF + hh * 128 + k]); const float sig = 1.f / (1.f + expf(-f)); const float fv = lbv + (1.f - lbv) * sig;
                        acc += dcy * (1.f - lbv) * (1.f - sig) * bf2f(U[rr + C_HI + hh * 128 + v]); dcy *= fv; }
                    o += q * acc; }
                so[v] = o; }
            __syncthreads();
            if (threadIdx.x < 128) { float ss = 0.f; for (int j = 0; j < 128; ++j) ss += so[j] * so[j]; const float gv = bf2f(U[(size_t)r * UW + C_HG + hh * 128 + v]);
                dbg_put(ctl, 13, bf2f(MIX[(size_t)r * D + 512 + hh * 128 + v]), o * rsqrtf(ss / 128 + EPS) * in[9][l * 128 + v] * gv / (1.f + expf(-gv)), 0.3f); }
            __syncthreads(); }
    }
    if (stage == 14) {
        for (int s = gid; s < 2048; s += NT) { const unsigned h = dh(s * 193u + 23u); const int r = h % NTOK, c = (h >> 14) % D; float a = in[0][(size_t)r * D + c];
            for (int k = 0; k < D; ++k) a += bf2f(MIX[(size_t)r * D + k]) * bf2f(((const bf16*)(wl + WL_WOUT))[(size_t)c * D + k]);
            dbg_put(ctl, 14, args.out[(size_t)r * D + c], a, 1.0f); }
    }
}
__global__ void dbg_final(Args args, float tol, int first, int count) {
    const unsigned* ctl = (const unsigned*)(args.ws + WS_CTL); float c = 1.f; int mask = 0;
    if (count > 0) { for (int k = 0; k < count; ++k) { const float e = __builtin_bit_cast(float, ctl[CW_DBG + first + k]); if (e > tol) mask |= 1 << k; } }
    else { for (int k = 0; k < -count; ++k) { const float e = __builtin_bit_cast(float, ctl[CW_DBG + first + k]);
        const int lv = e <= 0.05f ? 0 : e <= 0.2f ? 1 : e <= 1.f ? 2 : e <= 5.f ? 3 : e <= 100.f ? 4 : e <= 1e6f ? 5 : e < 1e9f ? 6 : 7; mask |= lv << (3 * k); } }
    if (mask) c = 2.f + 0.5f * mask;
    for (size_t i = (size_t)blockIdx.x * 256 + threadIdx.x; i < (size_t)NTOK * D; i += (size_t)gridDim.x * 256) args.out[i] = c * args.in[0][i];
}
#endif

#if MK_STAMP
__global__ void stamp_final(Args args, int pa, int pb) {
    const unsigned long long* st = (const unsigned long long*)((const unsigned*)(args.ws + WS_CTL) + CW_STAMPS);
    long long da = (long long)(st[pa + 1] - st[pa]) / 1000, db = (long long)(st[pb + 1] - st[pb]) / 1000;
    if (da < 0) da = 0; if (da > 99) da = 99; if (db < 0) db = 0; if (db > 99) db = 99;
    const float c = 2.f + 0.1f * (float)da, V = 100.f + 10.f * (float)db;
    for (size_t i = (size_t)blockIdx.x * 256 + threadIdx.x; i < (size_t)NTOK * D; i += (size_t)gridDim.x * 256) args.out[i] = i == 0 ? V : c * args.in[0][i];
}
#endif
extern "C" void kernel_launch(void* const* d_in, const int* in_sizes, int n_in, void* d_out, int out_size, void* d_ws, size_t ws_size, hipStream_t stream) {
    static int grid = 0;
    if (grid == 0) {
        if (n_in != 32 || out_size != NTOK * D || ws_size < WS_END) { fprintf(stderr, "kernel_launch: unexpected shapes (n_in %d out %d ws %zu need %zu)\n", n_in, out_size, ws_size, (size_t)WS_END); grid = -1; return; }
        int dev = 0, cus = 0, per_cu = 0;
        if (hipGetDevice(&dev) != hipSuccess || hipDeviceGetAttribute(&cus, hipDeviceAttributeMultiprocessorCount, dev) != hipSuccess) { grid = -1; return; }
        if (hipFuncSetAttribute((const void*)mk_fwd, hipFuncAttributeMaxDynamicSharedMemorySize, LDS_BYTES) != hipSuccess) { fprintf(stderr, "kernel_launch: hipFuncSetAttribute failed\n"); grid = -1; return; }
        if (hipOccupancyMaxActiveBlocksPerMultiprocessor(&per_cu, (const void*)mk_fwd, NTHR, LDS_BYTES) != hipSuccess || per_cu < 1) { fprintf(stderr, "kernel_launch: occupancy query says %d\n", per_cu); (void)hipGetLastError(); }
        grid = cus;
    }
    if (grid < 0) return;
    (void)hipMemsetAsync((char*)d_ws + WS_CTL, 0, CTL_BYTES, stream);
    Args a{};
    for (int i = 0; i < 32; ++i) a.in[i] = (const float*)d_in[i];
    a.out = (float*)d_out; a.ws = (unsigned char*)d_ws;
#if MK_ONE_LAUNCH
    a.ph_lo = 0; a.ph_hi = N_PHASES + MK_SANITIZE;
    hipLaunchKernelGGL(mk_fwd, dim3(grid), dim3(NTHR), LDS_BYTES, stream, a);
#if MK_STAMP
    hipLaunchKernelGGL(stamp_final, dim3(1024), dim3(256), 0, stream, a, MK_STAMP_A, MK_STAMP_B);
#endif
#else
    for (int p = 0; p < N_PHASES + MK_SANITIZE; ++p) { a.ph_lo = p; a.ph_hi = p + 1; hipLaunchKernelGGL(mk_fwd, dim3(grid), dim3(NTHR), LDS_BYTES, stream, a);
#if MK_DEBUG
        const int pb0 = PH_BASE;
        if (p == 0) { hipLaunchKernelGGL(dbg_kernel, dim3(64), dim3(256), 0, stream, a, 1, 0); hipLaunchKernelGGL(dbg_kernel, dim3(64), dim3(256), 0, stream, a, 2, 0); }
        if (p == pb0 + 0) hipLaunchKernelGGL(dbg_kernel, dim3(64), dim3(256), 0, stream, a, 3, 0);
        if (p == pb0 + 1) { hipLaunchKernelGGL(dbg_kernel, dim3(64), dim3(256), 0, stream, a, 4, 0); hipLaunchKernelGGL(dbg_kernel, dim3(64), dim3(256), 0, stream, a, 6, 0); }
        if (p == pb0 + 2) { hipLaunchKernelGGL(dbg_kernel, dim3(64), dim3(256), 0, stream, a, 8, 0); hipLaunchKernelGGL(dbg_kernel, dim3(64), dim3(256), 0, stream, a, 11, 0); }
        if (p == pb0 + 3) { hipLaunchKernelGGL(dbg_kernel, dim3(64), dim3(256), 0, stream, a, 12, 0); hipLaunchKernelGGL(dbg_kernel, dim3(64), dim3(256), 0, stream, a, 13, 0); }
        if (p == pb0 + 4) { hipLaunchKernelGGL(dbg_kernel, dim3(64), dim3(256), 0, stream, a, 14, 0); hipLaunchKernelGGL(dbg_final, dim3(1024), dim3(256), 0, stream, a, 0.05f, 11, 4); break; }
#endif
    }
#endif
}
```

```cpp
#include <hip/hip_runtime.h>
#include <cstdio>
#include <cstdint>

#ifndef MK_DEBUG
#define MK_DEBUG 0
#endif
#ifndef MK_STAMP
#define MK_STAMP 0
#endif
#ifndef MK_STAMP_A
#define MK_STAMP_A 0
#define MK_STAMP_B 1
#endif
#ifndef MK_DUP
#define MK_DUP 0
#endif
#define DUP(g) for (int dup_ = 0; dup_ < 1 + ((MK_DUP >> (g)) & 1); ++dup_)
#ifndef MK_SANITIZE
#define MK_SANITIZE 0
#endif
#ifndef MK_ONE_LAUNCH
#define MK_ONE_LAUNCH 1
#endif

#define GAS __attribute__((address_space(1)))
#define LAS __attribute__((address_space(3)))
typedef unsigned short bf16;
typedef short bf16x8 __attribute__((ext_vector_type(8)));
typedef float f32x4 __attribute__((ext_vector_type(4)));
typedef float f32x16 __attribute__((ext_vector_type(16)));
typedef unsigned u32x4 __attribute__((ext_vector_type(4)));
typedef unsigned u32x2 __attribute__((ext_vector_type(2)));

constexpr int D = 2048, NB = 4, SEQ = 4096, NTOK = NB * SEQ, DEPTH = 2;
constexpr int UW = 5888;
constexpr int C_SQ = 0, C_SK = 512, C_SV = 640, C_HQ = 768, C_HF = 1792, C_HI = 2816, C_HG = 3840, C_CQ = 4864, C_CKV = 5376, C_KR = 5632, INW = 5696;
constexpr int NEXP = 64, DEXP = 512, MAXROWS = 49152;
constexpr float EPS = 1e-6f;
constexpr float LOG2E = 1.4426950408889634f;

constexpr size_t MiB = 1u << 20;
constexpr size_t WS_CTL = 0, CTL_BYTES = 1 * MiB;
constexpr size_t SZ_WIN = (size_t)UW * D * 2, SZ_WUQ = 768 * 512 * 2, SZ_WUKV = 1024 * 256 * 2, SZ_WOUT = (size_t)D * D * 2, SZ_WMQ = 512 * (size_t)D * 2,
                 SZ_WMKV = 1024 * (size_t)D * 2, SZ_WMO = (size_t)D * 512 * 2, SZ_WGU = (size_t)NEXP * 1024 * D * 2, SZ_WD = (size_t)NEXP * D * 512 * 2;
constexpr size_t WL_WIN = 0, WL_WUQ = WL_WIN + SZ_WIN, WL_WUKV = WL_WUQ + SZ_WUQ, WL_WOUT = WL_WUKV + SZ_WUKV, WL_WMQ = WL_WOUT + SZ_WOUT, WL_WMKV = WL_WMQ + SZ_WMQ,
                 WL_WMO = WL_WMKV + SZ_WMKV, WL_WGU = WL_WMO + SZ_WMO, WL_WD = WL_WGU + SZ_WGU, WL_END = WL_WD + SZ_WD;
constexpr size_t WS_W = 1 * MiB;
constexpr size_t WS_PERS = WS_W + 2 * WL_END;
constexpr size_t WS_HN = WS_PERS;
constexpr size_t WS_MEMN = WS_HN + (size_t)NTOK * D * 2;
constexpr size_t WS_MKV = WS_MEMN + 2 * 1024 * (size_t)D * 2;
constexpr size_t WS_MK = WS_MKV + 2 * 1024 * 1024 * 2;
constexpr size_t WS_MVT = WS_MK + 2 * 1024 * 512 * 2;
constexpr size_t WS_ROPE = WS_MVT + 2 * 1024 * 512 * 2;
constexpr size_t WS_MQ = WS_ROPE + 4096 * 32 * 8;
constexpr size_t WS_MO = WS_MQ + (size_t)NTOK * 512 * 2;
constexpr size_t WS_SMALL = WS_MO + (size_t)NTOK * 512 * 2;
constexpr size_t SM_RSTDCQ = 0, SM_RSTDCKV = SM_RSTDCQ + NTOK * 4, SM_RSTDFFN = SM_RSTDCKV + NTOK * 4, SM_EIDX = SM_RSTDFFN + NTOK * 4, SM_GATE = SM_EIDX + NTOK * 8,
                 SM_SLOT = SM_GATE + NTOK * 8, SM_AROW = SM_SLOT + NTOK * 8, SM_LB = SM_AROW + NTOK * 8, SM_ROWTOK = SM_LB + 2 * 1024 * 4, SM_ROWSS = (SM_ROWTOK + (size_t)MAXROWS * 4 + 15) / 16 * 16, SM_RS = SM_ROWSS + (size_t)NTOK * 32 * 4, SM_RW = SM_RS + NTOK * 4, SM_END = SM_RW + (size_t)2 * 2 * 80 * D * 2;
constexpr size_t WS_OVL = (WS_SMALL + SM_END + 4095) / 4096 * 4096;
constexpr size_t OV_U = 0;
constexpr size_t OV_QM = OV_U + (size_t)NTOK * UW * 2;
constexpr size_t OV_KVM = OV_QM + (size_t)NTOK * 768 * 2;
constexpr size_t OV_QF = OV_KVM + (size_t)NTOK * 1024 * 2;
constexpr size_t OV_KF = OV_QF + (size_t)NTOK * 768 * 2;
constexpr size_t OV_VT = OV_KF + (size_t)NTOK * 768 * 2;
constexpr size_t OV_SVT = OV_VT + (size_t)NTOK * 512 * 2;
constexpr size_t OV_QT = OV_SVT + (size_t)NTOK * 128 * 2;
constexpr size_t OV_INTRA = OV_QT + (size_t)NTOK * 1024 * 2;
constexpr size_t OV_UT = OV_INTRA + (size_t)NTOK * 1024 * 2;
constexpr size_t OV_DEC = OV_UT + (size_t)2048 * 128 * 128 * 2;
constexpr size_t OV_MIX = OV_DEC + 2048 * 128 * 4;
constexpr size_t OV_MIXEND = OV_MIX + (size_t)NTOK * D * 2;
constexpr size_t OV_XG = 0;
constexpr size_t OV_HMID = OV_XG + (size_t)MAXROWS * D * 2;
constexpr size_t OV_YB = OV_HMID + (size_t)MAXROWS * 512 * 2;
constexpr size_t OV_MOEEND = OV_YB + (size_t)MAXROWS * D * 2;
constexpr size_t WS_END = WS_OVL + (OV_MIXEND > OV_MOEEND ? OV_MIXEND : OV_MOEEND);
static_assert(WS_END <= (size_t)2048 * MiB, "workspace map must fit 2 GiB");
constexpr int CW_BAR = 4096;
constexpr int CW_CNT = 32768;
constexpr int CW_NMT = 8192 + 128;
constexpr int CW_MTE = 8192 + 256;
constexpr int CW_MTR = 8192 + 768;
constexpr int CW_STAMPS = 14336;

constexpr int LDS_WORK = 131072;
constexpr int MISC_OFF = LDS_WORK;
constexpr int LDS_BYTES = 147456;
constexpr int NWAVES = 8, NTHR = 512;
constexpr int MT_OFF = 0, MT_CN = 80, MT_E = 160, MT_R = 416, MT_B = 672, MT_N = 928, MT_WORDS = 1184, MT_LDS = MISC_OFF + 2048;
constexpr size_t RS2_OFF = (size_t)8 << 20;
constexpr int RT_CAP = 16384;

#define LDS_WAIT() asm volatile("s_waitcnt lgkmcnt(0)" ::: "memory")
#define VM_WAIT() asm volatile("s_waitcnt vmcnt(0)" ::: "memory")
#define BAR_LDS() do { asm volatile("s_waitcnt lgkmcnt(0)" ::: "memory"); __builtin_amdgcn_s_barrier(); asm volatile("" ::: "memory"); } while (0)
#define SBAR() __builtin_amdgcn_sched_barrier(0)
__device__ __forceinline__ unsigned f2bf(float f) { unsigned u = __builtin_bit_cast(unsigned, f); return (u + 0x7fffu + ((u >> 16) & 1u)) >> 16; }
__device__ __forceinline__ unsigned pk2(float lo, float hi) { return f2bf(lo) | (f2bf(hi) << 16); }
__device__ __forceinline__ float bf2f(unsigned b) { return __builtin_bit_cast(float, b << 16); }
__device__ __forceinline__ float bflo(unsigned w) { return __builtin_bit_cast(float, w << 16); }
__device__ __forceinline__ float bfhi(unsigned w) { return __builtin_bit_cast(float, w & 0xffff0000u); }
__device__ __forceinline__ unsigned cvtpk(float lo, float hi) { unsigned r; asm volatile("v_cvt_pk_bf16_f32 %0, %1, %2" : "=v"(r) : "v"(lo), "v"(hi)); return r; }
__device__ __forceinline__ float ex2(float x) { return __builtin_amdgcn_exp2f(x); }
__device__ __forceinline__ float fexp(float x) { return __builtin_amdgcn_exp2f(x * LOG2E); }
__device__ __forceinline__ float flog(float x) { return __builtin_amdgcn_logf(x) * 0.6931471805599453f; }
__device__ __forceinline__ float wave_sum(float v) {
#pragma unroll
    for (int o = 1; o < 64; o <<= 1) v += __shfl_xor(v, o);
    return v;
}
__device__ __forceinline__ int crow(int r, int hi) { return (r & 3) + 8 * (r >> 2) + 4 * hi; }
#define PK4(P, B_, OUT) do { unsigned a0_ = cvtpk(P[B_ + 0], P[B_ + 1]), a1_ = cvtpk(P[B_ + 2], P[B_ + 3]), b0_ = cvtpk(P[B_ + 4], P[B_ + 5]), b1_ = cvtpk(P[B_ + 6], P[B_ + 7]); \
        auto r0_ = __builtin_amdgcn_permlane32_swap(a0_, b0_, false, false); auto r1_ = __builtin_amdgcn_permlane32_swap(a1_, b1_, false, false); \
        u32x4 w_ = {r0_[0], r1_[0], r0_[1], r1_[1]}; OUT = __builtin_bit_cast(bf16x8, w_); } while (0)
__device__ __forceinline__ float swap_max(float v) { return fmaxf(v, __shfl_xor(v, 32)); }
__device__ __forceinline__ float swap_sum(float v) { return v + __shfl_xor(v, 32); }

#define XB_TMO      128
#define XB_XCNT(j)  (256  + 64 * (j))
#define XB_XSUB(j)  (1280 + 64 * (j))
#define XB_XGEN(j)  (2304 + 64 * (j))
#define XB_TOP      3328
#define XB_TOPGEN   3392
#define XCD_BAR_WORDS 3456
#define XB_SPIN_CAP (1u << 22)
__device__ __forceinline__ unsigned xb_ld(unsigned* p)              { return __hip_atomic_load(p, __ATOMIC_RELAXED, __HIP_MEMORY_SCOPE_AGENT); }
__device__ __forceinline__ unsigned xb_add(unsigned* p, unsigned v) { return __hip_atomic_fetch_add(p, v, __ATOMIC_RELAXED, __HIP_MEMORY_SCOPE_AGENT); }
__device__ __forceinline__ unsigned xb_xcc_id() { return (unsigned)__builtin_amdgcn_s_getreg((3 << 11) | 20) & 0xFu; }
#define XB_SPIN(cond, bar) do { unsigned _sp = 0; while (cond) { __builtin_amdgcn_s_sleep(1); \
    if ((++_sp & 255u) == 0u) { if (xb_ld(&(bar)[XB_TMO])) break; if (_sp > XB_SPIN_CAP) { atomicAdd(&(bar)[XB_TMO], 1u); break; } } } } while (0)
struct XcdBarrier { unsigned* bar; unsigned x; volatile LAS unsigned* st; };
__device__ __forceinline__ XcdBarrier xcd_barrier_post(unsigned* bar, volatile LAS unsigned* st) {
    XcdBarrier b; b.bar = bar; b.x = xb_xcc_id(); b.st = st;
    if (threadIdx.x == 0) (void)xb_add(&bar[XB_XCNT(b.x)], 1u);
    return b;
}
__device__ __forceinline__ void xcd_barrier_complete(unsigned* bar, unsigned x, unsigned& nloc, unsigned& nx) {
    const unsigned G = gridDim.x * gridDim.y * gridDim.z;
    unsigned sum, cnt, mine, sp = 0u;
    for (;;) {
        sum = 0u; cnt = 0u; mine = 0u;
#pragma unroll
        for (unsigned j = 0; j < 16; ++j) { const unsigned c = xb_ld(&bar[XB_XCNT(j)]); sum += c; cnt += (c > 0u) ? 1u : 0u; mine = (j == x) ? c : mine; }
        if (sum == G) break;
        __builtin_amdgcn_s_sleep(1);
        if ((++sp & 255u) == 0u) { if (xb_ld(&bar[XB_TMO])) break; if (sp > XB_SPIN_CAP) { atomicAdd(&bar[XB_TMO], 1u); break; } }
    }
    nloc = mine > 0u ? mine : 1u; nx = cnt > 0u ? cnt : 1u;
}
__device__ __forceinline__ void xcd_barrier(const XcdBarrier& b, const bool leader) {
    asm volatile("s_waitcnt vmcnt(0)" ::: "memory");
    __syncthreads();
    if (leader) {
        unsigned* bar = b.bar;
        __builtin_amdgcn_s_waitcnt(0);
        unsigned nloc = b.st[0], nx = b.st[1];
        if (nloc == 0u) { xcd_barrier_complete(bar, b.x, nloc, nx); b.st[0] = nloc; b.st[1] = nx; }
        const unsigned old = xb_add(&bar[XB_XSUB(b.x)], 1u);
        const unsigned gen = old / nloc;
        if (old + 1u == (gen + 1u) * nloc) {
            __builtin_amdgcn_fence(__ATOMIC_RELEASE, "agent");
            asm volatile("s_waitcnt vmcnt(0)" ::: "memory");
            const unsigned og = xb_add(&bar[XB_TOP], 1u);
            const unsigned tg = og / nx;
            if (og + 1u == (tg + 1u) * nx) xb_add(&bar[XB_TOPGEN], 1u);
            else XB_SPIN(xb_ld(&bar[XB_TOPGEN]) == tg, bar);
            __builtin_amdgcn_fence(__ATOMIC_ACQUIRE, "agent");
            xb_add(&bar[XB_XGEN(b.x)], 1u);
            asm volatile("s_waitcnt vmcnt(0)" ::: "memory");
        } else {
            XB_SPIN(xb_ld(&bar[XB_XGEN(b.x)]) == gen, bar);
            __builtin_amdgcn_fence(__ATOMIC_ACQUIRE, "agent");
            asm volatile("s_waitcnt vmcnt(0)" ::: "memory");
        }
    }
    __syncthreads();
}

namespace pg8 {
constexpr int BM = 256, BK = 64, HALF = 128, HTB = HALF * BK * 2, STAGE_BYTES = 8 * HTB, NXCD = 8, WGM = 8;
__host__ __device__ __forceinline__ int lds_byte(int r, int c) { const int st = (r >> 4) * 2 + (c >> 5), rr = r & 15, cc = c & 31, ob = rr * 64 + cc * 2; return st * 1024 + (ob ^ (((ob >> 9) & 1) << 5)); }
__host__ __device__ __forceinline__ void stage_rc(int b, int& R, int& C) { const int st = b / 1024, sb = b % 1024, swz = sb ^ (((sb >> 9) & 1) << 5); R = (st >> 1) * 16 + swz / 64; C = (st & 1) * 32 + (swz % 64) / 2; }
__host__ __device__ __forceinline__ int perm32(int rho) { const int n = rho >> 4, i = rho & 15; return 8 * (i >> 2) + 4 * n + (i & 3); }

struct Unit { int pm, pn; size_t aoff, boff; bf16* obase; int oldc; int half; int roff; int rbase, rend; };
struct Gemm { const bf16* A; const bf16* Bt; int lda, K; const int* rowtok; };

struct StaticOrder {
    int nM, nN, nwg, G, c, lda, K;
    __device__ __forceinline__ void init(int M, int N, int lda_, int K_, int G_, int c_) { nM = M / BM; nN = N / BM; nwg = nM * nN; G = G_; c = c_; lda = lda_; K = K_; }
    __device__ __forceinline__ bool next(int i, Unit& u) const {
        const long L = (long)i * G + c; if (L >= nwg) return false;
        int wgid = (int)L; { const int q = nwg / NXCD, r = nwg % NXCD, xcd = wgid % NXCD, off = wgid / NXCD; wgid = (xcd < r ? xcd * (q + 1) : r * (q + 1) + (xcd - r) * q) + off; }
        const int nig = WGM * nN, gid = wgid / nig, fm = gid * WGM, gsz = (nM - fm) < WGM ? (nM - fm) : WGM;
        u.pm = fm + ((wgid % nig) % gsz); u.pn = (wgid % nig) / gsz;
        u.aoff = (size_t)u.pm * BM * lda * 2; u.boff = (size_t)u.pn * BM * K * 2; u.obase = nullptr; u.oldc = 0; u.half = 0; u.roff = -1; u.rbase = 0; u.rend = 0; return true;
    }
};
struct HalfOrder {
    StaticOrder base;
    __device__ __forceinline__ bool next(int i, Unit& u) const {
        const long L = (long)i * base.G + base.c; if (L >= 2L * base.nwg) return false;
        StaticOrder b2 = base; b2.c = (int)(L >> 1); b2.G = 0;
        if (!b2.next(0, u)) return false;
        const int mh = (int)(L & 1); u.aoff += (size_t)mh * HALF * base.lda * 2; u.half = 1; u.roff = mh * HALF; return true;
    }
};
struct WinPlusExtra {
    StaticOrder base; int nx; long xa, xb; long xa_l, xb_l; bf16* xo; size_t xo_l;
    __device__ __forceinline__ bool next(int i, Unit& u) const {
        const long L = (long)i * base.G + base.c;
        if (L < base.nwg) return base.next(i, u);
        const long m = L - base.nwg; if (m >= nx) return false;
        const int ll = (int)(m >> 4), t = (int)(m & 15); u.pm = t >> 2; u.pn = t & 3;
        u.aoff = (size_t)(xa + ll * xa_l + (long)u.pm * BM * base.lda * 2); u.boff = (size_t)(xb + ll * xb_l + (long)u.pn * BM * base.K * 2);
        u.obase = xo + (size_t)ll * xo_l; u.oldc = 1024; u.half = 0; u.roff = -1; u.rbase = 0; u.rend = 0; return true;
    }
};
struct GroupedOrder {
    const LAS int* tb; int nmt, nN, G, c, lda, K; size_t bstride;
    __device__ __forceinline__ bool next(int i, Unit& u) const {
        const int n = nmt * nN, nfull = n / G * G, rem = n - nfull;
        int L = i * G + c, mh = -1;
        if (2 * rem <= G && L >= nfull) { const int p = L - nfull; if (p >= 2 * rem) return false; L = nfull + (p >> 1); mh = p & 1; }
        else if (L >= n) return false;
        const int mt = L / nN; u.pn = L % nN;
        const unsigned e = (unsigned)__builtin_amdgcn_readfirstlane(tb[MT_E + mt]), rw_ = (unsigned)__builtin_amdgcn_readfirstlane(tb[MT_R + mt]), r0 = rw_ & 0x7fffffffu;
        u.rbase = __builtin_amdgcn_readfirstlane(tb[MT_B + mt]); u.rend = __builtin_amdgcn_readfirstlane(tb[MT_N + mt]);
        u.pm = (int)(r0 >> 8); u.aoff = (size_t)r0 * lda * 2; u.boff = (size_t)e * bstride + (size_t)u.pn * BM * K * 2; u.obase = nullptr; u.oldc = 0; u.half = (int)(rw_ >> 31); u.roff = -1;
        if (mh >= 0) { u.half = 1; u.roff = mh * HALF; u.aoff += (size_t)mh * HALF * lda * 2; }
        return true;
    }
};

struct EpiBf16 {
    static constexpr bool PERM = true;
    bf16* O; int ldc; const float* rowss; const float* rstd;
    __device__ __forceinline__ void operator()(const f32x4 (&acc)[2][2][4][2], const Unit& u, int wr, int wc, int fr, int fq) const {
        const int row0 = u.pm * BM + (u.roff > 0 ? u.roff : 0) + wr * 64 + fr, col0 = u.pn * BM + wc * 32 + 8 * fq;
        bf16* const Ob = u.obase ? u.obase : O; const int ld = u.obase ? u.oldc : ldc;
#pragma unroll
        for (int ai = 0; ai < 2; ++ai) { if (ai == 1 && u.roff >= 0) break;
#pragma unroll
            for (int m = 0; m < 4; ++m) { bf16* rowp = Ob + (size_t)(row0 + ai * HALF + m * 16) * ld + col0;
                float sr = 1.f;
                if (rowss) { const f32x4* sp = (const f32x4*)(rowss + (size_t)(row0 + ai * HALF + m * 16) * 32); f32x4 t = sp[0];
#pragma unroll
                    for (int k = 1; k < 8; ++k) t = t + sp[k];
                    sr = __builtin_amdgcn_rsqf(((t[0] + t[1]) + (t[2] + t[3])) * (1.f / 2048.f) + 1e-6f); }
                if (rstd && !u.obase) sr = rstd[row0 + ai * HALF + m * 16];
#pragma unroll
                for (int bj = 0; bj < 2; ++bj) { const f32x4 v0 = acc[ai][bj][m][0] * sr, v1 = acc[ai][bj][m][1] * sr;
                    u32x4 w; w.x = cvtpk(v0[0], v0[1]); w.y = cvtpk(v0[2], v0[3]); w.z = cvtpk(v1[0], v1[1]); w.w = cvtpk(v1[2], v1[3]);
                    *(u32x4*)(rowp + bj * HALF) = w; } } }
    }
};
struct EpiResid {
    static constexpr bool PERM = true;
    const float* B; float* X; int ldc; bf16* XB; float* rowss;
    __device__ __forceinline__ void operator()(const f32x4 (&acc)[2][2][4][2], const Unit& u, int wr, int wc, int fr, int fq) const {
        const int row0 = u.pm * BM + wr * 64 + fr, col0 = u.pn * BM + wc * 32 + 8 * fq;
#pragma unroll
        for (int ai = 0; ai < 2; ++ai)
#pragma unroll
            for (int m = 0; m < 4; ++m) { const size_t ro = (size_t)(row0 + ai * HALF + m * 16) * ldc + col0; float* rowp = X + ro; const float* bp = B + ro;
                f32x4 b[2][2];
#pragma unroll
                for (int bj = 0; bj < 2; ++bj)
#pragma unroll
                    for (int n = 0; n < 2; ++n) b[bj][n] = *(const f32x4*)(bp + bj * HALF + n * 4);
                float ssq = 0.f;
#pragma unroll
                for (int bj = 0; bj < 2; ++bj) {
#pragma unroll
                    for (int n = 0; n < 2; ++n) { b[bj][n] = b[bj][n] + acc[ai][bj][m][n]; *(f32x4*)(rowp + bj * HALF + n * 4) = b[bj][n]; }
                    if (XB) { const f32x4 v0 = b[bj][0], v1 = b[bj][1]; ssq += (v0[0] * v0[0] + v0[1] * v0[1]) + (v0[2] * v0[2] + v0[3] * v0[3]) + (v1[0] * v1[0] + v1[1] * v1[1]) + (v1[2] * v1[2] + v1[3] * v1[3]);
                        u32x4 w; w.x = cvtpk(v0[0], v0[1]); w.y = cvtpk(v0[2], v0[3]); w.z = cvtpk(v1[0], v1[1]); w.w = cvtpk(v1[2], v1[3]); *(u32x4*)(XB + ro + bj * HALF) = w; } }
                if (XB) { ssq += __shfl_xor(ssq, 16); ssq += __shfl_xor(ssq, 32); if (fq == 0) rowss[(size_t)(row0 + ai * HALF + m * 16) * 32 + u.pn * 4 + wc] = ssq; }
                asm volatile("" ::: "memory"); }
    }
};
struct EpiResid16 {
    static constexpr bool PERM = true;
    bf16* X; int ldc; float* rowss;
    __device__ __forceinline__ void operator()(const f32x4 (&acc)[2][2][4][2], const Unit& u, int wr, int wc, int fr, int fq) const {
        const int row0 = u.pm * BM + wr * 64 + fr, col0 = u.pn * BM + wc * 32 + 8 * fq;
#pragma unroll
        for (int ai = 0; ai < 2; ++ai)
#pragma unroll
            for (int m = 0; m < 4; ++m) { bf16* rowp = X + (size_t)(row0 + ai * HALF + m * 16) * ldc + col0;
                u32x4 b[2];
#pragma unroll
                for (int bj = 0; bj < 2; ++bj) b[bj] = *(const u32x4*)(rowp + bj * HALF);
                float ssq = 0.f;
#pragma unroll
                for (int bj = 0; bj < 2; ++bj) { const f32x4 a0 = acc[ai][bj][m][0], a1 = acc[ai][bj][m][1];
                    const float v0 = bflo(b[bj].x) + a0[0], v1 = bfhi(b[bj].x) + a0[1], v2 = bflo(b[bj].y) + a0[2], v3 = bfhi(b[bj].y) + a0[3];
                    const float v4 = bflo(b[bj].z) + a1[0], v5 = bfhi(b[bj].z) + a1[1], v6 = bflo(b[bj].w) + a1[2], v7 = bfhi(b[bj].w) + a1[3];
                    ssq += ((v0 * v0 + v1 * v1) + (v2 * v2 + v3 * v3)) + ((v4 * v4 + v5 * v5) + (v6 * v6 + v7 * v7));
                    u32x4 w; w.x = cvtpk(v0, v1); w.y = cvtpk(v2, v3); w.z = cvtpk(v4, v5); w.w = cvtpk(v6, v7); *(u32x4*)(rowp + bj * HALF) = w; }
                if (rowss) { ssq += __shfl_xor(ssq, 16); ssq += __shfl_xor(ssq, 32); if (fq == 0) rowss[(size_t)(row0 + ai * HALF + m * 16) * 32 + u.pn * 4 + wc] = ssq; }
                asm volatile("" ::: "memory"); }
    }
};
struct EpiGateUp {
    static constexpr bool PERM = true;
    bf16* H; int ldc; const int* rowtok; const float* rstd;
    __device__ __forceinline__ void operator()(const f32x4 (&acc)[2][2][4][2], const Unit& u, int wr, int wc, int fr, int fq) const {
        const int row0 = u.pm * BM + (u.roff > 0 ? u.roff : 0) + wr * 64 + fr, col0 = u.pn * HALF + wc * 32 + 8 * fq;
        float sc[2][4];
#pragma unroll
        for (int ai = 0; ai < 2; ++ai)
#pragma unroll
            for (int m = 0; m < 4; ++m) { const int r_ = row0 + ai * HALF + m * 16; sc[ai][m] = r_ < u.rend ? rstd[u.rbase + r_] : 0.f; }
#pragma unroll
        for (int ai = 0; ai < 2; ++ai) { if (ai == 1 && u.roff >= 0) break;
#pragma unroll
            for (int m = 0; m < 4; ++m) { bf16* rowp = H + (size_t)(row0 + ai * HALF + m * 16) * ldc + col0;
                float h[8];
#pragma unroll
                for (int n = 0; n < 2; ++n)
#pragma unroll
                    for (int j = 0; j < 4; ++j) { const float g = acc[ai][0][m][n][j] * sc[ai][m], up = acc[ai][1][m][n][j] * sc[ai][m]; h[n * 4 + j] = g * __builtin_amdgcn_rcpf(1.f + fexp(-g)) * up; }
                u32x4 w; w.x = cvtpk(h[0], h[1]); w.y = cvtpk(h[2], h[3]); w.z = cvtpk(h[4], h[5]); w.w = cvtpk(h[6], h[7]);
                *(u32x4*)rowp = w; } }
    }
};

template <class Epi, class Sched, bool GATHER = false>
__device__ __forceinline__ void gemm_phase(LAS unsigned char* lds, const int tid, const Gemm g, const Sched& S, const Epi& E) {
    const int wid = __builtin_amdgcn_readfirstlane(tid >> 6), lane = tid & 63, wr = wid >> 2, wc = wid & 3, fr = lane & 15, fq = lane >> 4;
    const int K = g.K, nt = K / BK, lda = g.lda;
    unsigned voffA[2], voffB[2]; int gR[2], gC[2];
#pragma unroll
    for (int i = 0; i < 2; ++i) { int R, C; stage_rc(tid * 16 + i * 8192, R, C); const int Rb = Epi::PERM ? ((R & ~31) + perm32(R & 31)) : R;
        voffA[i] = (unsigned)(R * lda + C) * 2u; voffB[i] = (unsigned)(Rb * K + C) * 2u; gR[i] = R; gC[i] = C; }
    unsigned vA0[2] = {0u, 0u}, vA1[2] = {0u, 0u}, nA0[2] = {0u, 0u}, nA1[2] = {0u, 0u};
#define PG8_GOFF(d0, d1, un) do { _Pragma("unroll") for (int _i = 0; _i < 2; ++_i) { const int r_ = (un).pm * BM + ((un).roff > 0 ? (un).roff : 0) + gR[_i]; \
        const int t0_ = r_ < (un).rend ? g.rowtok[(un).rbase + r_] : 0, t1_ = r_ + HALF < (un).rend ? g.rowtok[(un).rbase + r_ + HALF] : 0; \
        d0[_i] = (unsigned)(t0_ * lda + gC[_i]) * 2u; d1[_i] = (unsigned)(t1_ * lda + gC[_i]) * 2u; } } while (0)
    const size_t kstep = (size_t)(BK * 2);
    const size_t hstepA = (size_t)HALF * lda * 2, hstepB = (size_t)HALF * K * 2;
    const unsigned ldsw = (unsigned)wid * 1024u;
    const int aoff = lds_byte(wr * 64 + fr, fq * 8), boff = lds_byte(wc * 32 + fr, fq * 8);
#define PG8_SA(b, h) (((b) * 2 + (h)) * HTB)
#define PG8_SB(b, h) ((4 + (b) * 2 + (h)) * HTB)
#define PG8_STAGE(bufoff, gbase, voff) do { _Pragma("unroll") for (int _i = 0; _i < 2; ++_i) \
        __builtin_amdgcn_global_load_lds((const unsigned*)((const char*)(gbase) + (voff)[_i]), (LAS unsigned*)(lds + (bufoff) + ldsw + _i * 8192), 16, 0, 0); } while (0)
#define PG8_LDA(dst, b, h) do { _Pragma("unroll") for (int m = 0; m < 4; ++m) _Pragma("unroll") for (int k = 0; k < 2; ++k) dst[m][k] = *(const LAS bf16x8*)(lds + PG8_SA(b, h) + aoff + m * 2048 + k * 1024); } while (0)
#define PG8_LDB(dst, b, h) do { _Pragma("unroll") for (int n = 0; n < 2; ++n) _Pragma("unroll") for (int k = 0; k < 2; ++k) dst[n][k] = *(const LAS bf16x8*)(lds + PG8_SB(b, h) + boff + n * 2048 + k * 1024); } while (0)
#define PG8_MMA(ai, bj, At, Bt) do { __builtin_amdgcn_s_setprio(1); _Pragma("unroll") for (int m = 0; m < 4; ++m) _Pragma("unroll") for (int n = 0; n < 2; ++n) _Pragma("unroll") for (int k = 0; k < 2; ++k) \
        acc[ai][bj][m][n] = __builtin_amdgcn_mfma_f32_16x16x32_bf16(Bt[n][k], At[m][k], acc[ai][bj][m][n], 0, 0, 0); __builtin_amdgcn_s_setprio(0); } while (0)
#define PG8_WAIT_V(n) asm volatile("s_waitcnt vmcnt(" #n ")" ::: "memory")
#define PG8_WAIT_L(n) asm volatile("s_waitcnt lgkmcnt(" #n ")" ::: "memory")
#define PG8_BAR __builtin_amdgcn_s_barrier()
#define PG8_SCHED __builtin_amdgcn_sched_barrier(0)
    Unit cur, nxt; int ui = 0;
    if (!S.next(0, cur)) return;
    f32x4 acc[2][2][4][2];
#pragma unroll
    for (int a = 0; a < 2; ++a)
#pragma unroll
        for (int b = 0; b < 2; ++b)
#pragma unroll
            for (int m = 0; m < 4; ++m)
#pragma unroll
                for (int n = 0; n < 2; ++n) acc[a][b][m][n] = (f32x4){0.f, 0.f, 0.f, 0.f};
    bf16x8 At[4][2], B0[2][2], B1[2][2];
    const char* cA = GATHER ? (const char*)g.A : (const char*)g.A + cur.aoff; const char* cB = (const char*)g.Bt + cur.boff;
    if constexpr (GATHER) PG8_GOFF(vA0, vA1, cur);
    PG8_STAGE(PG8_SB(0, 0), cB, voffB); PG8_STAGE(PG8_SB(0, 1), cB + hstepB, voffB);
    if constexpr (GATHER) { PG8_STAGE(PG8_SA(0, 0), cA, vA0); PG8_STAGE(PG8_SA(0, 1), cA, vA1); } else { PG8_STAGE(PG8_SA(0, 0), cA, voffA); PG8_STAGE(PG8_SA(0, 1), cA + hstepA, voffA); }
    if (wr == 1) PG8_BAR;
    PG8_WAIT_V(2); PG8_BAR;
    PG8_STAGE(PG8_SB(1, 0), cB + kstep, voffB);
    if constexpr (GATHER) PG8_STAGE(PG8_SA(1, 0), cA + kstep, vA0); else PG8_STAGE(PG8_SA(1, 0), cA + kstep, voffA);
    PG8_STAGE(PG8_SB(1, 1), cB + hstepB + kstep, voffB);
    PG8_WAIT_V(6); PG8_BAR;
    for (;;) {
        const bool has_next = S.next(ui + 1, nxt);
        const char* nA = GATHER ? cA : (has_next ? (const char*)g.A + nxt.aoff : cA); const char* nB = has_next ? (const char*)g.Bt + nxt.boff : cB;
        if constexpr (GATHER) { if (has_next) PG8_GOFF(nA0, nA1, nxt); else { nA0[0] = vA0[0]; nA0[1] = vA0[1]; nA1[0] = vA1[0]; nA1[1] = vA1[1]; } }
#pragma nounroll
        for (int t = 0; t < nt; t += 2) {
            const bool last = (t == nt - 2);
            const char* a1 = cA + (size_t)(t + 1) * kstep;
            const char* a2 = last ? nA : cA + (size_t)(t + 2) * kstep; const char* b2 = last ? nB : cB + (size_t)(t + 2) * kstep;
            const char* a3 = a2 + kstep; const char* b3 = b2 + kstep;
            unsigned s0[2], s1[2];
            if constexpr (GATHER) { s0[0] = last ? nA0[0] : vA0[0]; s0[1] = last ? nA0[1] : vA0[1]; s1[0] = last ? nA1[0] : vA1[0]; s1[1] = last ? nA1[1] : vA1[1]; }
            PG8_LDB(B0, 0, 0); PG8_LDB(B1, 0, 1); PG8_SCHED; PG8_LDA(At, 0, 0);
            if constexpr (GATHER) PG8_STAGE(PG8_SA(1, 1), a1, vA1); else PG8_STAGE(PG8_SA(1, 1), a1 + hstepA, voffA);
            PG8_WAIT_V(8); PG8_WAIT_L(0); PG8_BAR; PG8_MMA(0, 0, At, B0); PG8_MMA(0, 1, At, B1); PG8_BAR; PG8_SCHED;
            PG8_LDA(At, 0, 1); PG8_STAGE(PG8_SB(0, 0), b2, voffB); PG8_STAGE(PG8_SB(0, 1), b2 + hstepB, voffB);
            if constexpr (GATHER) PG8_STAGE(PG8_SA(0, 0), a2, s0); else PG8_STAGE(PG8_SA(0, 0), a2, voffA);
            PG8_WAIT_V(8); PG8_WAIT_L(0); PG8_BAR; if (!cur.half) { PG8_MMA(1, 0, At, B0); PG8_MMA(1, 1, At, B1); } PG8_BAR; PG8_SCHED;
            PG8_LDB(B0, 1, 0); PG8_LDB(B1, 1, 1); PG8_SCHED; PG8_LDA(At, 1, 0);
            if constexpr (GATHER) PG8_STAGE(PG8_SA(0, 1), a2, s1); else PG8_STAGE(PG8_SA(0, 1), a2 + hstepA, voffA);
            PG8_WAIT_V(8); PG8_WAIT_L(0); PG8_BAR; PG8_MMA(0, 0, At, B0); PG8_MMA(0, 1, At, B1); PG8_BAR; PG8_SCHED;
            PG8_LDA(At, 1, 1); PG8_STAGE(PG8_SB(1, 0), b3, voffB); PG8_STAGE(PG8_SB(1, 1), b3 + hstepB, voffB);
            if constexpr (GATHER) PG8_STAGE(PG8_SA(1, 0), a3, s0); else PG8_STAGE(PG8_SA(1, 0), a3, voffA);
            PG8_WAIT_V(8); PG8_WAIT_L(0); PG8_BAR; if (!cur.half) { PG8_MMA(1, 0, At, B0); PG8_MMA(1, 1, At, B1); } PG8_BAR; PG8_SCHED;
        }
        if (wr == 0) PG8_BAR;
        E(acc, cur, wr, wc, fr, fq);
        if (!has_next) break;
#pragma unroll
        for (int a = 0; a < 2; ++a)
#pragma unroll
            for (int b = 0; b < 2; ++b)
#pragma unroll
                for (int m = 0; m < 4; ++m)
#pragma unroll
                    for (int n = 0; n < 2; ++n) acc[a][b][m][n] = (f32x4){0.f, 0.f, 0.f, 0.f};
        cur = nxt; cA = nA; cB = nB; ++ui;
        if constexpr (GATHER) { vA0[0] = nA0[0]; vA0[1] = nA0[1]; vA1[0] = nA1[0]; vA1[1] = nA1[1]; }
        if (wr == 1) PG8_BAR;
    }
    PG8_WAIT_V(0);
    PG8_BAR;
#undef PG8_GOFF
#undef PG8_SA
#undef PG8_SB
#undef PG8_STAGE
#undef PG8_LDA
#undef PG8_LDB
#undef PG8_MMA
#undef PG8_WAIT_V
#undef PG8_WAIT_L
#undef PG8_BAR
#undef PG8_SCHED
}
}

struct Args { const float* in[32]; float* out; unsigned char* ws; int ph_lo, ph_hi; };
struct Frame {
    LAS unsigned char* lds; int tid, lane, wave, G, bid;
    unsigned char* ws; unsigned* ctl; const float* const* in; float* out;
};

__device__ __forceinline__ void transpose_item(const float* W, int K, int N, bf16* WT, int dst_row0, const float* gain, LAS float* scr, int kb, int nb, int lane) {
    const int k0 = 64 * kb, n0 = 32 * nb, c4 = lane & 7, kr = lane >> 3;
    f32x4 v[8];
#pragma unroll
    for (int i = 0; i < 8; ++i) v[i] = *(const f32x4*)(W + (size_t)(k0 + 8 * i + kr) * N + n0 + 4 * c4);
#pragma unroll
    for (int i = 0; i < 8; ++i) { const int kk = 8 * i + kr; const float gk = gain ? gain[k0 + kk] : 1.f; LAS float* d = scr + kk * 33 + 4 * c4;
        d[0] = v[i][0] * gk; d[1] = v[i][1] * gk; d[2] = v[i][2] * gk; d[3] = v[i][3] * gk; }
    LDS_WAIT(); asm volatile("" ::: "memory");
    const int c = lane & 7;
#pragma unroll
    for (int j = 0; j < 4; ++j) { const int n = (lane >> 3) + 8 * j; const LAS float* s = scr + (8 * c) * 33 + n;
        u32x4 o; o.x = pk2(s[0 * 33], s[1 * 33]); o.y = pk2(s[2 * 33], s[3 * 33]); o.z = pk2(s[4 * 33], s[5 * 33]); o.w = pk2(s[6 * 33], s[7 * 33]);
        *(u32x4*)(WT + (size_t)(dst_row0 + n) * K + k0 + 8 * c) = o; }
    LDS_WAIT(); asm volatile("" ::: "memory");
}
struct ConvMat { const float* W; bf16* WT; const float* gain; int K, N, kind; };
__device__ __forceinline__ void convert_matrix(Frame& F, const ConvMat& m, int& base, int gw, int NGW, LAS float* scr) {
    const int nnb = m.N / 32, nkb = m.K / 64, items = nnb * nkb;
    int first = gw - base; if (first < 0) first += NGW;
    for (int it = first; it < items; it += NGW) {
        const int kb = it / nnb, nb = it % nnb, n0 = nb * 32;
        int r0 = n0; if (m.kind == 1) r0 = (n0 >> 7) * 256 + (n0 & 127); else if (m.kind == 2) r0 = (n0 >> 7) * 256 + 128 + (n0 & 127);
        transpose_item(m.W, m.K, m.N, m.WT, r0 - 0, m.gain, scr, kb, nb, F.lane);
        (void)n0;
    }
    base += items; while (base >= NGW) base -= NGW;
}
__device__ __forceinline__ void p_convert(Frame& F) {
    LAS float* scr = (LAS float*)(F.lds + F.wave * 16384);
    const int gw = F.bid * NWAVES + F.wave, NGW = F.G * NWAVES;
    int base = 0;
    for (int l = 0; l < DEPTH; ++l) {
        unsigned char* wl = F.ws + WS_W + (size_t)l * WL_END;
        { ConvMat m{F.in[5] + (size_t)l * D * INW, (bf16*)(wl + WL_WIN), F.in[4] + (size_t)l * D, D, INW, 0}; convert_matrix(F, m, base, gw, NGW, scr); }
        { ConvMat m{F.in[12] + (size_t)l * 512 * 768, (bf16*)(wl + WL_WUQ), F.in[10] + l * 512, 512, 768, 0}; convert_matrix(F, m, base, gw, NGW, scr); }
        { ConvMat m{F.in[13] + (size_t)l * 256 * 1024, (bf16*)(wl + WL_WUKV), F.in[11] + l * 256, 256, 1024, 0}; convert_matrix(F, m, base, gw, NGW, scr); }
        { ConvMat m{F.in[16] + (size_t)l * D * D, (bf16*)(wl + WL_WOUT), nullptr, D, D, 0}; convert_matrix(F, m, base, gw, NGW, scr); }
        { ConvMat m{F.in[19] + (size_t)l * D * 512, (bf16*)(wl + WL_WMQ), F.in[17] + (size_t)l * D, D, 512, 0}; convert_matrix(F, m, base, gw, NGW, scr); }
        { ConvMat m{F.in[20] + (size_t)l * D * 1024, (bf16*)(wl + WL_WMKV), nullptr, D, 1024, 0}; convert_matrix(F, m, base, gw, NGW, scr); }
        { ConvMat m{F.in[23] + (size_t)l * 512 * D, (bf16*)(wl + WL_WMO), nullptr, 512, D, 0}; convert_matrix(F, m, base, gw, NGW, scr); }
        for (int e = 0; e < NEXP; ++e) {
            bf16* gu = (bf16*)(wl + WL_WGU) + (size_t)e * 1024 * D;
            { ConvMat m{F.in[29] + ((size_t)l * NEXP + e) * D * DEXP, gu, F.in[24] + (size_t)l * D, D, DEXP, 1}; convert_matrix(F, m, base, gw, NGW, scr); }
            { ConvMat m{F.in[30] + ((size_t)l * NEXP + e) * D * DEXP, gu, F.in[24] + (size_t)l * D, D, DEXP, 2}; convert_matrix(F, m, base, gw, NGW, scr); }
            { ConvMat m{F.in[31] + ((size_t)l * NEXP + e) * DEXP * D, (bf16*)(wl + WL_WD) + (size_t)e * D * DEXP, nullptr, DEXP, D, 0}; convert_matrix(F, m, base, gw, NGW, scr); }
        }
        { u32x4* z = (u32x4*)((bf16*)(wl + WL_WIN) + (size_t)INW * D); const int n16 = (UW - INW) * D * 2 / 16;
          for (int i = F.bid * NTHR + F.tid; i < n16; i += F.G * NTHR) z[i] = (u32x4){0u, 0u, 0u, 0u}; }
    }
    for (int i = F.bid * NTHR + F.tid; i < 4096 * 32; i += F.G * NTHR) {
        const int pos = i >> 5, j = i & 31;
        const float inv = ex2(-(float)j * (13.287712379549449f / 32.0f));
        const float ang = (float)pos * inv;
        const double rev = (double)ang * 0.15915494309189535; const float fr = (float)(rev - floor(rev));
        float* rp = (float*)(F.ws + WS_ROPE) + 2 * i; rp[0] = __builtin_amdgcn_cosf(fr); rp[1] = __builtin_amdgcn_sinf(fr);
    }
    for (int i = F.bid * NTHR + F.tid; i < 2 * 80 * D; i += F.G * NTHR) { const int l = i / (80 * D), c = (i / D) % 80, k = i % D;
        float w = 0.f; if (c < 8) w = F.in[25][((size_t)l * D + k) * 8 + c]; else if (c >= 16) w = F.in[27][((size_t)l * D + k) * 64 + c - 16];
        w *= F.in[24][(size_t)l * D + k]; const unsigned hi = f2bf(w), lo = f2bf(w - bf2f(hi));
        bf16* rw = (bf16*)(F.ws + WS_SMALL + SM_RW) + (size_t)l * 2 * 80 * D; rw[(size_t)c * D + k] = (bf16)hi; rw[(size_t)(80 + c) * D + k] = (bf16)lo; }
    for (int i = F.bid * NTHR + F.tid; i < 1024; i += F.G * NTHR) {
        float* lb = (float*)(F.ws + WS_SMALL + SM_LB); const float a0 = F.in[3][i], a1 = F.in[3][1024 + i];
        const float mx = fmaxf(a0, a1), e0 = expf(a0 - mx), e1 = expf(a1 - mx), p0 = e0 / (e0 + e1), p1 = e1 / (e0 + e1);
        lb[i] = p0 - p0; lb[1024 + i] = (p0 + p1) - p0;
    }
}

template <int NR, bool MOE>
__device__ __forceinline__ void norm_rows(const float* const (&xin)[NR], float* const (&xout)[NR], bf16* const (&hn)[NR], const float* gain, const bf16* const (&y0)[NR], const bf16* const (&y1)[NR], const float (&g0)[NR], const float (&g1)[NR], int lane) {
    f32x4 v[NR][8]; u32x2 ya[NR][8], yb[NR][8];
#pragma unroll
    for (int n = 0; n < NR; ++n)
#pragma unroll
        for (int j = 0; j < 8; ++j) { v[n][j] = *((const f32x4*)xin[n] + lane + 64 * j); if constexpr (MOE) { ya[n][j] = *((const u32x2*)y0[n] + lane + 64 * j); yb[n][j] = *((const u32x2*)y1[n] + lane + 64 * j); } }
#pragma unroll
    for (int n = 0; n < NR; ++n) { float ss = 0.f;
#pragma unroll
        for (int j = 0; j < 8; ++j) {
            if constexpr (MOE) { const u32x2 a = ya[n][j], b = yb[n][j];
                v[n][j][0] += g0[n] * bflo(a.x) + g1[n] * bflo(b.x); v[n][j][1] += g0[n] * bfhi(a.x) + g1[n] * bfhi(b.x); v[n][j][2] += g0[n] * bflo(a.y) + g1[n] * bflo(b.y); v[n][j][3] += g0[n] * bfhi(a.y) + g1[n] * bfhi(b.y); }
            ss += (v[n][j][0] * v[n][j][0] + v[n][j][1] * v[n][j][1]) + (v[n][j][2] * v[n][j][2] + v[n][j][3] * v[n][j][3]); }
        if (xout[n]) {
#pragma unroll
            for (int j = 0; j < 8; ++j) *((f32x4*)xout[n] + lane + 64 * j) = v[n][j]; }
        if (hn[n]) {
            const float rstd = __builtin_amdgcn_rsqf(wave_sum(ss) * (1.f / D) + EPS);
#pragma unroll
            for (int j = 0; j < 8; ++j) { const f32x4 gv = *((const f32x4*)gain + lane + 64 * j);
                u32x2 o; o.x = pk2(v[n][j][0] * rstd * gv[0], v[n][j][1] * rstd * gv[1]); o.y = pk2(v[n][j][2] * rstd * gv[2], v[n][j][3] * rstd * gv[3]);
                *((u32x2*)hn[n] + lane + 64 * j) = o; }
        } }
}
__device__ __forceinline__ void norm_row(const float* xin, float* xout, bf16* hn, const float* gain, const bf16* y0, const bf16* y1, float g0, float g1, int lane) {
    const float* const xi[1] = {xin}; float* const xo[1] = {xout}; bf16* const h[1] = {hn}; const bf16* const a[1] = {y0}; const bf16* const b[1] = {y1}; const float ga[1] = {g0}, gb[1] = {g1};
    if (y0) norm_rows<1, true>(xi, xo, h, gain, a, b, ga, gb, lane); else norm_rows<1, false>(xi, xo, h, gain, a, b, ga, gb, lane);
}
template <int NR, bool MOE, bool IN16>
__device__ __forceinline__ void stream_rows(const void* const (&xin)[NR], bf16* const (&x16)[NR], float* const (&xf)[NR], float* const (&rs)[NR], const bf16* const (&y0)[NR], const bf16* const (&y1)[NR], const float (&g0)[NR], const float (&g1)[NR], int lane) {
    f32x4 v[NR][8]; u32x2 ya[NR][8], yb[NR][8];
#pragma unroll
    for (int n = 0; n < NR; ++n)
#pragma unroll
        for (int j = 0; j < 8; ++j) {
            if constexpr (IN16) { const u32x2 w = *((const u32x2*)xin[n] + lane + 64 * j); v[n][j] = (f32x4){bflo(w.x), bfhi(w.x), bflo(w.y), bfhi(w.y)}; }
            else v[n][j] = *((const f32x4*)xin[n] + lane + 64 * j);
            if constexpr (MOE) { ya[n][j] = *((const u32x2*)y0[n] + lane + 64 * j); yb[n][j] = *((const u32x2*)y1[n] + lane + 64 * j); } }
#pragma unroll
    for (int n = 0; n < NR; ++n) { float ss = 0.f;
#pragma unroll
        for (int j = 0; j < 8; ++j) {
            if constexpr (MOE) { const u32x2 a = ya[n][j], b = yb[n][j];
                v[n][j][0] += g0[n] * bflo(a.x) + g1[n] * bflo(b.x); v[n][j][1] += g0[n] * bfhi(a.x) + g1[n] * bfhi(b.x); v[n][j][2] += g0[n] * bflo(a.y) + g1[n] * bflo(b.y); v[n][j][3] += g0[n] * bfhi(a.y) + g1[n] * bfhi(b.y); }
            ss += (v[n][j][0] * v[n][j][0] + v[n][j][1] * v[n][j][1]) + (v[n][j][2] * v[n][j][2] + v[n][j][3] * v[n][j][3]); }
        if (xf[n]) {
#pragma unroll
            for (int j = 0; j < 8; ++j) *((f32x4*)xf[n] + lane + 64 * j) = v[n][j]; }
        if (x16[n]) {
#pragma unroll
            for (int j = 0; j < 8; ++j) { u32x2 o; o.x = pk2(v[n][j][0], v[n][j][1]); o.y = pk2(v[n][j][2], v[n][j][3]); *((u32x2*)x16[n] + lane + 64 * j) = o; } }
        if (rs[n]) { const float r = __builtin_amdgcn_rsqf(wave_sum(ss) * (1.f / D) + EPS); if (lane == 0) *rs[n] = r; } }
}
struct AttnU { const bf16* Q; const bf16* K; const bf16* VT; bf16* O; int qs, ks, vts, os, q0, t_lo, t_hi; float* dbg; int qh, oh; float sinkb; };
constexpr int AT_ML = 98304;
template <int DQK, int DV, int MODE, bool QNORM, bool ALLSTAGE = false, bool PIPE3 = false, bool PAIR = false, bool ROT = false>
__device__ __forceinline__ void attn_unit(LAS unsigned char* lds, const int tid, const AttnU u, const float scl2, const float* qgain, const float sink2, const LAS float* biasT) {
    constexpr int NBUF = ALLSTAGE ? 4 : (PIPE3 ? 3 : 2);
    constexpr int KROW = DQK * 2, VROW = 128, KBUF = 64 * KROW, VBUF = DV * VROW, KOFF = 0, VOFF = NBUF * KBUF;
    constexpr int KCH = DQK / 8, NKC = 64 * KCH / 512, NVC = DV * 8 / 512, ND0 = DQK / 16, NDB = DV / 32;
    constexpr int ML = (NBUF * KBUF + NBUF * VBUF <= AT_ML) ? AT_ML : LDS_WORK + 1024;
    static_assert(NBUF * KBUF + NBUF * VBUF <= ML && 4 * 32 * DV * 4 <= ML && ML + 3072 <= LDS_BYTES, "attention LDS map");
    constexpr int NLD = 64 * (DQK / 8) / 512 + DV * 8 / 512;
#define AT_KSWZ(row) (KCH == 16 ? ((row) & 15) : (((row) >> 1) & 7))
    const int wid = __builtin_amdgcn_readfirstlane(tid >> 6), lane = tid & 63, r32 = lane & 31, hi = lane >> 5, g = wid & 3, kh = wid >> 2;
    const LAS float* bT = PAIR ? biasT + kh * 128 : biasT; (void)bT;
    LAS float* Ms = (LAS float*)(lds + ML);
    LAS float* Ls = Ms + 256;
    LAS float* Al = Ls + 256 + wid * 32;
    LAS float* OM = (LAS float*)lds;
    bf16x8 qr[ND0];
    { const bf16* qp = u.Q + (PAIR ? kh * u.qh : 0) + (size_t)(32 * g + r32) * u.qs + 8 * hi;
#pragma unroll
      for (int d0 = 0; d0 < ND0; ++d0) qr[d0] = *(const bf16x8*)(qp + 16 * d0);
      if constexpr (QNORM) {
          float ss = 0.f;
#pragma unroll
          for (int d0 = 0; d0 < ND0; ++d0)
#pragma unroll
              for (int j = 0; j < 8; ++j) { const float v = bf2f((unsigned short)qr[d0][j]); ss += v * v; }
          ss = swap_sum(ss);
          const float rstd = __builtin_amdgcn_rsqf(ss * (1.f / DQK) + EPS);
#pragma unroll
          for (int d0 = 0; d0 < ND0; ++d0) { const f32x4 g0 = *(const f32x4*)(qgain + 16 * d0 + 8 * hi), g1 = *(const f32x4*)(qgain + 16 * d0 + 8 * hi + 4);
              u32x4 w; w.x = pk2(bf2f((unsigned short)qr[d0][0]) * rstd * g0[0], bf2f((unsigned short)qr[d0][1]) * rstd * g0[1]); w.y = pk2(bf2f((unsigned short)qr[d0][2]) * rstd * g0[2], bf2f((unsigned short)qr[d0][3]) * rstd * g0[3]);
              w.z = pk2(bf2f((unsigned short)qr[d0][4]) * rstd * g1[0], bf2f((unsigned short)qr[d0][5]) * rstd * g1[1]); w.w = pk2(bf2f((unsigned short)qr[d0][6]) * rstd * g1[2], bf2f((unsigned short)qr[d0][7]) * rstd * g1[3]);
              qr[d0] = __builtin_bit_cast(bf16x8, w); }
      } }
    unsigned kvo[NKC], vvo[NVC];
#pragma unroll
    for (int i = 0; i < NKC; ++i) { const int p = tid + 512 * i, row = p / KCH, cp = p % KCH; kvo[i] = (unsigned)(row * u.ks + ((cp ^ AT_KSWZ(row)) << 3)); }
#pragma unroll
    for (int i = 0; i < NVC; ++i) { const int p = tid + 512 * i, d = p >> 3, cp = p & 7; vvo[i] = (unsigned)(d * u.vts + ((cp ^ ((d >> 1) & 7)) << 3)); }
#define AT_STAGE(t, bf) do { const bf16* kt_ = u.K + (size_t)(64 * (t)) * u.ks; const bf16* vt_ = u.VT + 64 * (t); \
        _Pragma("unroll") for (int i_ = 0; i_ < NKC; ++i_) __builtin_amdgcn_global_load_lds((const unsigned*)(kt_ + kvo[i_]), (LAS unsigned*)(lds + KOFF + (bf) * KBUF + (512 * i_ + wid * 64) * 16), 16, 0, 0); \
        _Pragma("unroll") for (int i_ = 0; i_ < NVC; ++i_) __builtin_amdgcn_global_load_lds((const unsigned*)(vt_ + vvo[i_]), (LAS unsigned*)(lds + VOFF + (bf) * VBUF + (512 * i_ + wid * 64) * 16), 16, 0, 0); } while (0)
#define AT_STAGE_K(t, bf) do { const bf16* kt_ = u.K + (size_t)(64 * (t)) * u.ks; \
        _Pragma("unroll") for (int i_ = 0; i_ < NKC; ++i_) __builtin_amdgcn_global_load_lds((const unsigned*)(kt_ + kvo[i_]), (LAS unsigned*)(lds + KOFF + (bf) * KBUF + (512 * i_ + wid * 64) * 16), 16, 0, 0); } while (0)
#define AT_STAGE_V(t, bf) do { const bf16* vt_ = u.VT + 64 * (t); \
        _Pragma("unroll") for (int i_ = 0; i_ < NVC; ++i_) __builtin_amdgcn_global_load_lds((const unsigned*)(vt_ + vvo[i_]), (LAS unsigned*)(lds + VOFF + (bf) * VBUF + (512 * i_ + wid * 64) * 16), 16, 0, 0); } while (0)
    float m_run = -1e30f, l_run = 0.f;
    f32x16 o[NDB];
#pragma unroll
    for (int i = 0; i < NDB; ++i)
#pragma unroll
        for (int r = 0; r < 16; ++r) o[i][r] = 0.f;
    const int qa = u.q0 + 32 * g;
    const int qpos = qa + r32;
    const int vswz = (r32 >> 1) & 7;
    int buf = 0;
    if constexpr (ALLSTAGE) {
#pragma unroll
        for (int i = 0; i < 4; ++i) if (u.t_lo + i < u.t_hi) AT_STAGE(u.t_lo + i, i);
        VM_WAIT(); __syncthreads();
    } else if constexpr (PIPE3) {
        AT_STAGE(u.t_lo, 0);
        if (ROT) { if (u.t_lo + 1 < u.t_hi) { AT_STAGE_K(u.t_lo + 1, 1); asm volatile("s_waitcnt vmcnt(%0)" :: "i"(NKC) : "memory"); } else VM_WAIT(); }
        else if (u.t_lo + 1 < u.t_hi) { AT_STAGE(u.t_lo + 1, 1); asm volatile("s_waitcnt vmcnt(%0)" :: "i"(NLD) : "memory"); } else VM_WAIT();
        asm volatile("s_waitcnt lgkmcnt(0)" ::: "memory"); __builtin_amdgcn_s_barrier(); asm volatile("" ::: "memory");
    } else { AT_STAGE(u.t_lo, 0); VM_WAIT(); __syncthreads(); }
    const bool rotw = ROT && kh == 1;
    bf16x8 pa0, pa1; bool pend = false; int pbuf = 0;
#define AT_PV(bi, khx, a0_, a1_) do { int vsw_ = vswz; asm volatile("" : "+v"(vsw_)); const LAS unsigned char* vb_ = lds + VOFF + (bi) * VBUF + r32 * VROW; \
        _Pragma("unroll") for (int ib = 0; ib < NDB; ib += 2) { bf16x8 vf_[2][2]; \
        _Pragma("unroll") for (int i = 0; i < 2; ++i) { vf_[i][0] = *(const LAS bf16x8*)(vb_ + (ib + i) * 32 * VROW + (((4 * (khx) + hi) ^ vsw_) << 4)); vf_[i][1] = *(const LAS bf16x8*)(vb_ + (ib + i) * 32 * VROW + (((4 * (khx) + 2 + hi) ^ vsw_) << 4)); } \
        SBAR(); \
        _Pragma("unroll") for (int i = 0; i < 2; ++i) { o[ib + i] = __builtin_amdgcn_mfma_f32_32x32x16_bf16(a0_, vf_[i][0], o[ib + i], 0, 0, 0); o[ib + i] = __builtin_amdgcn_mfma_f32_32x32x16_bf16(a1_, vf_[i][1], o[ib + i], 0, 0, 0); } \
        SBAR(); } } while (0)
    for (int t = u.t_lo; t < u.t_hi; ++t) {
        if constexpr (PIPE3 && ROT) { if (t + 1 < u.t_hi) AT_STAGE_V(t + 1, buf == 2 ? 0 : buf + 1); if (t + 2 < u.t_hi) AT_STAGE_K(t + 2, buf >= 1 ? buf - 1 : 2); if (rotw && pend) { SBAR(); AT_PV(pbuf, kh, pa0, pa1); SBAR(); } }
        else if constexpr (PIPE3) { if (t + 2 < u.t_hi) AT_STAGE(t + 2, buf >= 1 ? buf - 1 : 2); }
        else if constexpr (!ALLSTAGE) { if (t + 1 < u.t_hi) AT_STAGE(t + 1, buf ^ 1); }
        SBAR();
#pragma unroll
        for (int kk = 0; kk < (PAIR ? 2 : 1); ++kk) {
        const int khv = PAIR ? kk : kh;
        const int krow = 32 * khv + r32, kswz = AT_KSWZ(krow);
        const int kb0 = 64 * t + 32 * khv;
        bool act = true;
#ifndef MK_NOSKIP
        if constexpr (MODE == 1) act = kb0 <= qa + 31;
        if constexpr (MODE == 2) act = (qa + 31 - kb0 >= 0) && (qa - (kb0 + 31) <= 127);
#endif
        if (act) {
            f32x16 p;
#pragma unroll
            for (int r = 0; r < 16; ++r) p[r] = 0.f;
            int ksw = kswz, vsw = vswz; asm volatile("" : "+v"(ksw), "+v"(vsw));
            const LAS unsigned char* kb = lds + KOFF + buf * KBUF + krow * KROW;
            if constexpr (ROT) {
#pragma unroll
              for (int hb = 0; hb < ND0 / 4; ++hb) { bf16x8 kf[4];
#pragma unroll
                for (int d0 = 0; d0 < 4; ++d0) kf[d0] = *(const LAS bf16x8*)(kb + (((2 * (d0 + hb * 4) + hi) ^ ksw) << 4));
                SBAR();
#pragma unroll
                for (int d0 = 0; d0 < 4; ++d0) p = __builtin_amdgcn_mfma_f32_32x32x16_bf16(kf[d0], qr[d0 + hb * 4], p, 0, 0, 0);
                SBAR(); }
            } else
            { bf16x8 kf[ND0];
#pragma unroll
              for (int d0 = 0; d0 < ND0; ++d0) kf[d0] = *(const LAS bf16x8*)(kb + (((2 * d0 + hi) ^ ksw) << 4));
              SBAR();
#pragma unroll
              for (int d0 = 0; d0 < ND0; ++d0) p = __builtin_amdgcn_mfma_f32_32x32x16_bf16(kf[d0], qr[d0], p, 0, 0, 0); }
            const int dq = qpos - kb0 - 4 * hi;
            float pmax = -1e30f, esc = 1.f;
            if (MODE == 1 && kb0 + 31 <= qa) {
#pragma unroll
                for (int r = 0; r < 16; ++r) pmax = fmaxf(pmax, p[r]);
                pmax *= scl2; esc = scl2;
            } else {
#pragma unroll
            for (int r = 0; r < 16; ++r) { const int c = (r & 3) + 8 * (r >> 2); float s = p[r] * scl2;
                if constexpr (MODE == 1) { if (dq - c < 0) s = -__builtin_inff(); }
                if constexpr (MODE == 2) { const int dist = dq - c; const bool ok = (unsigned)dist < 128u; const float bv = bT[ok ? dist : 0]; s = ok ? s + bv : -__builtin_inff(); }
                p[r] = s; pmax = fmaxf(pmax, s); }
            }
#if MK_DEBUG
            if (u.dbg && t == u.t_lo) { for (int r = 0; r < 16; ++r) u.dbg[(wid * 64 + lane) * 16 + r] = p[r]; }
#endif
            const bool keep = __all(pmax - m_run <= 11.5f) != 0;
            float m_new = m_run, alpha = 1.f;
            if (!keep) { pmax = swap_max(pmax); m_new = fmaxf(m_run, pmax); alpha = ex2(m_run - m_new); }
            float ps = 0.f;
#pragma unroll
            for (int r = 0; r < 16; ++r) { p[r] = ex2(__builtin_fmaf(p[r], esc, -m_new)); ps += p[r]; }
            l_run = l_run * alpha + ps; m_run = m_new;
            if (!keep && __any(alpha < 1.f)) {
                if (hi == 0) Al[r32] = alpha;
                LDS_WAIT();
#pragma unroll
                for (int r = 0; r < 16; ++r) { const float a = Al[crow(r, hi)];
#pragma unroll
                    for (int i = 0; i < NDB; ++i) o[i][r] *= a; }
                LDS_WAIT();
            }
            PK4(p, 0, pa0); PK4(p, 8, pa1);
            SBAR();
            if (!rotw) {
            const LAS unsigned char* vb = lds + VOFF + buf * VBUF + r32 * VROW;
            { bf16x8 vf[NDB][2];
#pragma unroll
              for (int i = 0; i < NDB; ++i) { vf[i][0] = *(const LAS bf16x8*)(vb + i * 32 * VROW + (((4 * khv + hi) ^ vsw) << 4)); vf[i][1] = *(const LAS bf16x8*)(vb + i * 32 * VROW + (((4 * khv + 2 + hi) ^ vsw) << 4)); }
              SBAR();
#pragma unroll
              for (int i = 0; i < NDB; ++i) { o[i] = __builtin_amdgcn_mfma_f32_32x32x16_bf16(pa0, vf[i][0], o[i], 0, 0, 0); o[i] = __builtin_amdgcn_mfma_f32_32x32x16_bf16(pa1, vf[i][1], o[i], 0, 0, 0); } }
            }
        }
        if (rotw) { pend = act; pbuf = buf; }
        SBAR();
        }
        if constexpr (ALLSTAGE) { buf += 1; }
        else if constexpr (PIPE3) {
            if (ROT) { if (t + 2 < u.t_hi) asm volatile("s_waitcnt vmcnt(%0)" :: "i"(NKC) : "memory"); else VM_WAIT(); }
            else if (t + 2 < u.t_hi) asm volatile("s_waitcnt vmcnt(%0)" :: "i"(NLD) : "memory"); else VM_WAIT();
            asm volatile("s_waitcnt lgkmcnt(0)" ::: "memory"); __builtin_amdgcn_s_barrier(); asm volatile("" ::: "memory");
            buf = buf == 2 ? 0 : buf + 1; }
        else { VM_WAIT(); __syncthreads(); buf ^= 1; }
    }
    if constexpr (ROT) { if (rotw && pend) AT_PV(pbuf, kh, pa0, pa1); __syncthreads(); }
    if constexpr (ALLSTAGE && !PAIR) __syncthreads();
#undef AT_PV
#undef AT_STAGE_K
#undef AT_STAGE_V
#undef AT_STAGE
#undef AT_KSWZ
#if MK_DEBUG
    if (u.dbg) { u.dbg[8192 + (wid * 64 + lane) * 2] = m_run; u.dbg[8192 + (wid * 64 + lane) * 2 + 1] = l_run;
        for (int i = 0; i < NDB; ++i) for (int r = 0; r < 16; ++r) u.dbg[16384 + ((wid * 64 + lane) * 4 + i) * 16 + r] = o[i][r]; }
#endif
    l_run = swap_sum(l_run);
    if constexpr (PAIR) {
        if (hi == 0) { Ms[wid * 32 + r32] = m_run; Ls[wid * 32 + r32] = l_run; }
        LDS_WAIT();
        const float sk = kh ? u.sinkb : sink2;
#pragma unroll
        for (int r = 0; r < 16; ++r) { const int q = crow(r, hi);
            float L = Ls[wid * 32 + q]; if constexpr (MODE == 2) L += ex2(sk - Ms[wid * 32 + q]);
            const float inv = 1.f / L;
            bf16* orow = u.O + kh * u.oh + (size_t)(32 * g + q) * u.os;
#pragma unroll
            for (int i = 0; i < NDB; ++i) { const float v = o[i][r] * inv; const float vn = __shfl_xor(v, 1);
                if ((r32 & 1) == 0) *(unsigned*)(orow + 32 * i + r32) = pk2(v, vn); }
            SBAR(); }
        __syncthreads();
        return;
    }
    if (hi == 0) { Ms[wid * 32 + r32] = m_run; Ls[wid * 32 + r32] = l_run; }
    if (kh == 1) {
#pragma unroll
        for (int i = 0; i < NDB; ++i)
#pragma unroll
            for (int r = 0; r < 16; ++r) OM[(g * 32 + crow(r, hi)) * DV + 32 * i + r32] = o[i][r];
    }
    LDS_WAIT(); __syncthreads();
    if (kh == 0) {
#pragma unroll
        for (int r = 0; r < 16; ++r) { const int q = crow(r, hi);
            const float m0 = Ms[g * 32 + q], m1 = Ms[(4 + g) * 32 + q], l0 = Ls[g * 32 + q], l1 = Ls[(4 + g) * 32 + q];
            const float mm = fmaxf(m0, m1), a0 = ex2(m0 - mm), a1 = ex2(m1 - mm);
            float L = l0 * a0 + l1 * a1; if constexpr (MODE == 2) L += ex2(sink2 - mm);
            const float inv = 1.f / L;
            bf16* orow = u.O + (size_t)(32 * g + q) * u.os;
#pragma unroll
            for (int i = 0; i < NDB; ++i) { const float v = (o[i][r] * a0 + OM[(g * 32 + q) * DV + 32 * i + r32] * a1) * inv; const float vn = __shfl_xor(v, 1);
                if ((r32 & 1) == 0) *(unsigned*)(orow + 32 * i + r32) = pk2(v, vn); }
            SBAR(); }
    }
    __syncthreads();
}

template <int NC>
__device__ __forceinline__ void transpose_tile64(LAS unsigned char* lds, const bf16* src, int sstr, const float* rowscale, bf16* dst, size_t dstr, int tid) {
    constexpr int CPT = NC / 8;
    const int row = tid >> 3, c0 = (tid & 7) * CPT;
    const float sc = rowscale ? rowscale[row] : 1.f;
#pragma unroll
    for (int i = 0; i < CPT / 8; ++i) { const u32x4 w = *(const u32x4*)(src + (size_t)row * sstr + c0 + 8 * i); const unsigned ww[4] = {w.x, w.y, w.z, w.w};
#pragma unroll
        for (int j = 0; j < 4; ++j) { unsigned lo = ww[j] & 0xffffu, hi = ww[j] >> 16; if (rowscale) { lo = f2bf(bf2f(lo) * sc); hi = f2bf(bf2f(hi) * sc); }
            *(LAS unsigned short*)(lds + (c0 + 8 * i + 2 * j) * 144 + row * 2) = (unsigned short)lo; *(LAS unsigned short*)(lds + (c0 + 8 * i + 2 * j + 1) * 144 + row * 2) = (unsigned short)hi; } }
    LDS_WAIT(); __syncthreads();
    if constexpr (NC == 512) { const int col = tid;
#pragma unroll
        for (int i = 0; i < 8; ++i) *(u32x4*)(dst + (size_t)col * dstr + 8 * i) = *(const LAS u32x4*)(lds + col * 144 + 16 * i); }
    else { const int col = tid >> 2, ch = (tid & 3) * 2;
#pragma unroll
        for (int i = 0; i < 2; ++i) *(u32x4*)(dst + (size_t)col * dstr + 8 * (ch + i)) = *(const LAS u32x4*)(lds + col * 144 + 16 * (ch + i)); }
    __syncthreads();
}

__device__ __forceinline__ void transpose4_tile64x128(LAS unsigned char* lds, const bf16* src, size_t sgap, int sstr, const float* rowscale, bf16* dst, size_t dgap, size_t dstr, int tid) {
    const int row = tid >> 3, c0 = (tid & 7) * 16; const float sc = rowscale ? rowscale[row] : 1.f;
    u32x4 w[4][2];
#pragma unroll
    for (int hh = 0; hh < 4; ++hh)
#pragma unroll
        for (int i = 0; i < 2; ++i) w[hh][i] = *(const u32x4*)(src + hh * sgap + (size_t)row * sstr + c0 + 8 * i);
#pragma unroll
    for (int hh = 0; hh < 4; ++hh)
#pragma unroll
        for (int i = 0; i < 2; ++i) { const unsigned ww[4] = {w[hh][i].x, w[hh][i].y, w[hh][i].z, w[hh][i].w};
#pragma unroll
            for (int j = 0; j < 4; ++j) { unsigned lo = ww[j] & 0xffffu, hi = ww[j] >> 16; if (rowscale) { lo = f2bf(bf2f(lo) * sc); hi = f2bf(bf2f(hi) * sc); }
                *(LAS unsigned short*)(lds + hh * 18432 + (c0 + 8 * i + 2 * j) * 144 + row * 2) = (unsigned short)lo; *(LAS unsigned short*)(lds + hh * 18432 + (c0 + 8 * i + 2 * j + 1) * 144 + row * 2) = (unsigned short)hi; } }
    LDS_WAIT(); __syncthreads();
    const int col = tid >> 2, ch = (tid & 3) * 2;
#pragma unroll
    for (int hh = 0; hh < 4; ++hh)
#pragma unroll
        for (int i = 0; i < 2; ++i) *(u32x4*)(dst + hh * dgap + (size_t)col * dstr + 8 * (ch + i)) = *(const LAS u32x4*)(lds + hh * 18432 + col * 144 + 16 * (ch + i));
    __syncthreads();
}

__device__ __forceinline__ void p_prep(Frame& F, int l) {
    bf16* U = (bf16*)(F.ws + WS_OVL + OV_U); bf16* SVT = (bf16*)(F.ws + WS_OVL + OV_SVT);
    float* rcq = (float*)(F.ws + WS_SMALL + SM_RSTDCQ); float* rckv = (float*)(F.ws + WS_SMALL + SM_RSTDCKV);
    const float* gq = F.in[6] + l * 64; const float* gk = F.in[7] + l * 64;
    const int lane = F.lane;
    for (int tile = F.bid; tile < NTOK / 64; tile += F.G) {
        {
            const int rowb = tile * 64 + F.wave * 8; const int l16 = lane & 15;
            u32x4 wq[8], wk[8], wc[8]; u32x2 wv[8];
#pragma unroll
            for (int rr = 0; rr < 8; ++rr) { const bf16* up = U + (size_t)(rowb + rr) * UW;
                wq[rr] = *(const u32x4*)(up + C_SQ + 8 * lane); wk[rr] = *(const u32x4*)(up + C_SK + 8 * l16); wc[rr] = *(const u32x4*)(up + C_CQ + 8 * lane); wv[rr] = *(const u32x2*)(up + C_CKV + 4 * lane); }
#pragma unroll
            for (int rr = 0; rr < 8; ++rr) { const int row = rowb + rr; bf16* up = U + (size_t)row * UW;
                { const unsigned ww[4] = {wq[rr].x, wq[rr].y, wq[rr].z, wq[rr].w}; float v[8]; float ss = 0.f;
#pragma unroll
                  for (int j = 0; j < 4; ++j) { v[2 * j] = bflo(ww[j]); v[2 * j + 1] = bfhi(ww[j]); ss += v[2 * j] * v[2 * j] + v[2 * j + 1] * v[2 * j + 1]; }
                  ss += __shfl_xor(ss, 1); ss += __shfl_xor(ss, 2); ss += __shfl_xor(ss, 4);
                  const float rstd = __builtin_amdgcn_rsqf(ss * (1.f / 64) + EPS); const float* gp = gq + (lane & 7) * 8;
                  u32x4 o; o.x = pk2(v[0] * rstd * gp[0], v[1] * rstd * gp[1]); o.y = pk2(v[2] * rstd * gp[2], v[3] * rstd * gp[3]); o.z = pk2(v[4] * rstd * gp[4], v[5] * rstd * gp[5]); o.w = pk2(v[6] * rstd * gp[6], v[7] * rstd * gp[7]);
                  *(u32x4*)(up + C_SQ + 8 * lane) = o; }
                { const unsigned ww[4] = {wk[rr].x, wk[rr].y, wk[rr].z, wk[rr].w}; float v[8]; float ss = 0.f;
#pragma unroll
                  for (int j = 0; j < 4; ++j) { v[2 * j] = bflo(ww[j]); v[2 * j + 1] = bfhi(ww[j]); ss += v[2 * j] * v[2 * j] + v[2 * j + 1] * v[2 * j + 1]; }
                  ss += __shfl_xor(ss, 1); ss += __shfl_xor(ss, 2); ss += __shfl_xor(ss, 4);
                  const float rstd = __builtin_amdgcn_rsqf(ss * (1.f / 64) + EPS); const float* gp = gk + (lane & 7) * 8;
                  u32x4 o; o.x = pk2(v[0] * rstd * gp[0], v[1] * rstd * gp[1]); o.y = pk2(v[2] * rstd * gp[2], v[3] * rstd * gp[3]); o.z = pk2(v[4] * rstd * gp[4], v[5] * rstd * gp[5]); o.w = pk2(v[6] * rstd * gp[6], v[7] * rstd * gp[7]);
                  if (lane < 16) *(u32x4*)(up + C_SK + 8 * l16) = o; }
                { const unsigned ww[4] = {wc[rr].x, wc[rr].y, wc[rr].z, wc[rr].w}; float ss = 0.f;
#pragma unroll
                  for (int j = 0; j < 4; ++j) { const float a_ = bflo(ww[j]), b_ = bfhi(ww[j]); ss += a_ * a_ + b_ * b_; }
                  ss = wave_sum(ss); if (lane == 0) rcq[row] = __builtin_amdgcn_rsqf(ss * (1.f / 512) + EPS); }
                { const u32x2 w = wv[rr]; float ss = bflo(w.x) * bflo(w.x) + bfhi(w.x) * bfhi(w.x) + bflo(w.y) * bflo(w.y) + bfhi(w.y) * bfhi(w.y);
                  ss = wave_sum(ss); if (lane == 0) rckv[row] = __builtin_amdgcn_rsqf(ss * (1.f / 256) + EPS); }
            }
        }
        const int b = tile >> 6, s0 = (tile & 63) * 64;
        transpose_tile64<128>(F.lds, U + (size_t)tile * 64 * UW + C_SV, UW, nullptr, SVT + (size_t)b * 128 * SEQ + s0, SEQ, F.tid);
    }
}

__device__ __forceinline__ void p_mla_post(Frame& F, int l) {
    const bf16* U = (const bf16*)(F.ws + WS_OVL + OV_U); const bf16* QM = (const bf16*)(F.ws + WS_OVL + OV_QM); const bf16* KVM = (const bf16*)(F.ws + WS_OVL + OV_KVM);
    bf16* QF = (bf16*)(F.ws + WS_OVL + OV_QF); bf16* KF = (bf16*)(F.ws + WS_OVL + OV_KF); bf16* VT = (bf16*)(F.ws + WS_OVL + OV_VT);
    const float* rcq = (const float*)(F.ws + WS_SMALL + SM_RSTDCQ); const float* rckv = (const float*)(F.ws + WS_SMALL + SM_RSTDCKV);
    const float* rope = (const float*)(F.ws + WS_ROPE);
    const float* gq = F.in[14] + l * 192; const float* gk = F.in[15] + l * 192;
    const int lane = F.lane, h = lane >> 4, lh = lane & 15;
    for (int tile = F.bid; tile < NTOK / 64; tile += F.G) {
        for (int r4 = 0; r4 < 8; r4 += 4) {
            const int rowb = tile * 64 + F.wave * 8 + r4;
            f32x4 csv[4]; u32x4 wn[4][2]; unsigned ra[4][2], rb[4][2]; float scq[4], sck[4];
#pragma unroll
            for (int rr = 0; rr < 4; ++rr) { const int row = rowb + rr, s = row & 4095;
                csv[rr] = *(const f32x4*)(rope + ((size_t)s * 32 + 2 * lh) * 2);
                const bf16* qp = QM + (size_t)row * 768 + h * 192; const bf16* kp = KVM + (size_t)row * 1024 + h * 256; const bf16* kr = U + (size_t)row * UW + C_KR;
                wn[rr][0] = *(const u32x4*)(qp + 8 * lh); wn[rr][1] = *(const u32x4*)(kp + 8 * lh);
                ra[rr][0] = *(const unsigned*)(qp + 128 + 2 * lh); rb[rr][0] = *(const unsigned*)(qp + 160 + 2 * lh);
                ra[rr][1] = *(const unsigned*)(kr + 2 * lh); rb[rr][1] = *(const unsigned*)(kr + 32 + 2 * lh);
                scq[rr] = rcq[row]; sck[rr] = rckv[row]; }
#pragma unroll
            for (int rr = 0; rr < 4; ++rr) { const int row = rowb + rr, b = row >> 12, s = row & 4095; const f32x4 cs = csv[rr];
#pragma unroll
            for (int which = 0; which < 2; ++which) {
                const float sc = which == 0 ? scq[rr] : sck[rr], scr = which == 0 ? sc : 1.f;
                const float* gg = which == 0 ? gq : gk;
                const u32x4 w = wn[rr][which]; const unsigned ww[4] = {w.x, w.y, w.z, w.w};
                const unsigned r1 = ra[rr][which], r2 = rb[rr][which];
                float v[8]; float ss = 0.f;
#pragma unroll
                for (int j = 0; j < 4; ++j) { v[2 * j] = bflo(ww[j]) * sc; v[2 * j + 1] = bfhi(ww[j]) * sc; ss += v[2 * j] * v[2 * j] + v[2 * j + 1] * v[2 * j + 1]; }
                float x1a = bflo(r1) * scr, x1b = bfhi(r1) * scr, x2a = bflo(r2) * scr, x2b = bfhi(r2) * scr;
                ss += x1a * x1a + x1b * x1b + x2a * x2a + x2b * x2b;
                ss += __shfl_xor(ss, 1); ss += __shfl_xor(ss, 2); ss += __shfl_xor(ss, 4); ss += __shfl_xor(ss, 8);
                const float rstd = __builtin_amdgcn_rsqf(ss * (1.f / 192) + EPS);
                const float* g8 = gg + 8 * lh;
                u32x4 o; o.x = pk2(v[0] * rstd * g8[0], v[1] * rstd * g8[1]); o.y = pk2(v[2] * rstd * g8[2], v[3] * rstd * g8[3]); o.z = pk2(v[4] * rstd * g8[4], v[5] * rstd * g8[5]); o.w = pk2(v[6] * rstd * g8[6], v[7] * rstd * g8[7]);
                x1a *= rstd * gg[128 + 2 * lh]; x1b *= rstd * gg[128 + 2 * lh + 1]; x2a *= rstd * gg[160 + 2 * lh]; x2b *= rstd * gg[160 + 2 * lh + 1];
                const float o1a = x1a * cs[0] - x2a * cs[1], o2a = x1a * cs[1] + x2a * cs[0], o1b = x1b * cs[2] - x2b * cs[3], o2b = x1b * cs[3] + x2b * cs[2];
                bf16* op = (which == 0 ? QF : KF) + ((size_t)(b * 4 + h) * SEQ + s) * 192;
                *(u32x4*)(op + 8 * lh) = o; *(unsigned*)(op + 128 + 2 * lh) = pk2(o1a, o1b); *(unsigned*)(op + 160 + 2 * lh) = pk2(o2a, o2b);
            } } }
        const int b = tile >> 6, s0 = (tile & 63) * 64;
        transpose4_tile64x128(F.lds, KVM + (size_t)tile * 64 * 1024 + 128, 256, 1024, rckv + tile * 64, VT + ((size_t)(b * 4) * 128) * SEQ + s0, (size_t)128 * SEQ, SEQ, F.tid);
    }
}

__device__ __forceinline__ void p_mem_post(Frame& F) {
    const int lane = F.lane, h = lane >> 4, lh = lane & 15;
    for (int unit = F.bid; unit < 32; unit += F.G) { const int l = unit >> 4, tile = unit & 15;
        const bf16* MKV = (const bf16*)(F.ws + WS_MKV) + (size_t)l * 1024 * 1024; bf16* MK = (bf16*)(F.ws + WS_MK) + (size_t)l * 1024 * 512; bf16* MVT = (bf16*)(F.ws + WS_MVT) + (size_t)l * 1024 * 512;
        const float* gk = F.in[22] + l * 128;
        for (int rr = 0; rr < 8; ++rr) { const int row = tile * 64 + F.wave * 8 + rr, b = row >> 8, m = row & 255;
            const u32x4 w = *(const u32x4*)(MKV + (size_t)row * 1024 + h * 128 + 8 * lh); const unsigned ww[4] = {w.x, w.y, w.z, w.w}; float v[8]; float ss = 0.f;
#pragma unroll
            for (int j = 0; j < 4; ++j) { v[2 * j] = bflo(ww[j]); v[2 * j + 1] = bfhi(ww[j]); ss += v[2 * j] * v[2 * j] + v[2 * j + 1] * v[2 * j + 1]; }
            ss += __shfl_xor(ss, 1); ss += __shfl_xor(ss, 2); ss += __shfl_xor(ss, 4); ss += __shfl_xor(ss, 8);
            const float rstd = __builtin_amdgcn_rsqf(ss * (1.f / 128) + EPS); const float* g8 = gk + 8 * lh;
            u32x4 o; o.x = pk2(v[0] * rstd * g8[0], v[1] * rstd * g8[1]); o.y = pk2(v[2] * rstd * g8[2], v[3] * rstd * g8[3]); o.z = pk2(v[4] * rstd * g8[4], v[5] * rstd * g8[5]); o.w = pk2(v[6] * rstd * g8[6], v[7] * rstd * g8[7]);
            *(u32x4*)(MK + ((size_t)(b * 4 + h) * 256 + m) * 128 + 8 * lh) = o; }
        const int b = tile >> 2, m0 = (tile & 3) * 64;
        for (int hh = 0; hh < 4; ++hh)
            transpose_tile64<128>(F.lds, MKV + (size_t)tile * 64 * 1024 + 512 + hh * 128, 1024, nullptr, MVT + ((size_t)(b * 4 + hh) * 128) * 256 + m0, 256, F.tid);
    }
}

constexpr int HG_QH = 0, HG_KH = 64 * 272, HG_KT = 2 * 64 * 272, HG_VT = HG_KT + 128 * 144, HG_TOT = HG_VT + 128 * 144;
__device__ __forceinline__ void p_hgrn1(Frame& F, int l) {
    const bf16* U = (const bf16*)(F.ws + WS_OVL + OV_U); bf16* QT = (bf16*)(F.ws + WS_OVL + OV_QT); bf16* INTRA = (bf16*)(F.ws + WS_OVL + OV_INTRA); bf16* UT = (bf16*)(F.ws + WS_OVL + OV_UT);
    float* DEC = (float*)(F.ws + WS_OVL + OV_DEC); const float* lb = (const float*)(F.ws + WS_SMALL + SM_LB) + l * 1024;
    LAS unsigned char* lds = F.lds; LAS float* tot = (LAS float*)(lds + HG_TOT);
    const int tid = F.tid, lane = F.lane, wid = F.wave, r32 = lane & 31, hi = lane >> 5;
    const int cp = tid & 63, part = tid >> 6;
    unsigned fw[8], qw[8], vw[8];
#define H1_LOAD(un) do { const int b_ = (un) >> 9, h_ = ((un) >> 6) & 7, c_ = (un) & 63; const bf16* base = U + (size_t)(b_ * SEQ + 64 * c_ + 8 * part) * UW + h_ * 128 + 2 * cp; \
        _Pragma("unroll") for (int i = 0; i < 8; ++i) { fw[i] = *(const unsigned*)(base + (size_t)i * UW + C_HF); qw[i] = *(const unsigned*)(base + (size_t)i * UW + C_HQ); vw[i] = *(const unsigned*)(base + (size_t)i * UW + C_HI); } } while (0)
    if (F.bid < 2048) H1_LOAD(F.bid);
    for (int unit = F.bid; unit < 2048; unit += F.G) {
        const int b = unit >> 9, h = (unit >> 6) & 7, c = unit & 63, row0 = b * SEQ + 64 * c;
        const float lb0 = lb[h * 128 + 2 * cp], lb1 = lb[h * 128 + 2 * cp + 1];
        float cs0[8], cs1[8], kin0[8], kin1[8]; float run0 = 0.f, run1 = 0.f;
#pragma unroll
        for (int i = 0; i < 8; ++i) { const float f0 = bflo(fw[i]), f1 = bfhi(fw[i]);
            const float sg0 = __builtin_amdgcn_rcpf(1.f + fexp(-f0)), sg1 = __builtin_amdgcn_rcpf(1.f + fexp(-f1));
            run0 += flog(lb0 + (1.f - lb0) * sg0); run1 += flog(lb1 + (1.f - lb1) * sg1); cs0[i] = run0; cs1[i] = run1;
            kin0[i] = (1.f - lb0) * (1.f - sg0); kin1[i] = (1.f - lb1) * (1.f - sg1); }
        tot[part * 128 + 2 * cp] = run0; tot[part * 128 + 2 * cp + 1] = run1;
        BAR_LDS();
        float off0 = 0.f, off1 = 0.f, rr0 = 0.f, rr1 = 0.f, bt0 = 0.f, bt1 = 0.f;
#pragma unroll
        for (int p = 0; p < 8; ++p) { const float t0 = tot[p * 128 + 2 * cp], t1 = tot[p * 128 + 2 * cp + 1];
            if (p < part) { off0 += t0; off1 += t1; } if (p < 4) { rr0 += t0; rr1 += t1; } bt0 += t0; bt1 += t1; }
        const float er0 = fexp(rr0), er1 = fexp(rr1), eb0 = fexp(bt0 - rr0), eb1 = fexp(bt1 - rr1);
        unsigned ktw0[4], ktw1[4], vtw0[4], vtw1[4]; float kp0 = 0.f, kp1 = 0.f; unsigned vp0 = 0u, vp1 = 0u;
#pragma unroll
        for (int i = 0; i < 8; ++i) { const int s = 8 * part + i;
            const float E0 = fexp(off0 + cs0[i] - rr0), E1 = fexp(off1 + cs1[i] - rr1), I0 = __builtin_amdgcn_rcpf(E0), I1 = __builtin_amdgcn_rcpf(E1);
            const float qh0 = bflo(qw[i]) * E0, qh1 = bfhi(qw[i]) * E1, kh0 = kin0[i] * I0, kh1 = kin1[i] * I1;
            *(LAS unsigned*)(lds + HG_QH + s * 272 + cp * 4) = pk2(qh0, qh1);
            *(LAS unsigned*)(lds + HG_KH + s * 272 + cp * 4) = pk2(kh0, kh1);
            *(unsigned*)(QT + (size_t)(row0 + s) * 1024 + h * 128 + 2 * cp) = pk2(qh0 * er0, qh1 * er1);
            const float kt0 = kh0 * eb0, kt1 = kh1 * eb1; const unsigned v0 = vw[i] & 0xffffu, v1 = vw[i] >> 16;
            if (i & 1) { ktw0[i >> 1] = pk2(kp0, kt0); ktw1[i >> 1] = pk2(kp1, kt1); vtw0[i >> 1] = vp0 | (v0 << 16); vtw1[i >> 1] = vp1 | (v1 << 16); }
            else { kp0 = kt0; kp1 = kt1; vp0 = v0; vp1 = v1; } }
        SBAR();
        if (unit + F.G < 2048) H1_LOAD(unit + F.G);
        SBAR();
        *(LAS u32x4*)(lds + HG_KT + (2 * cp) * 144 + part * 16) = (u32x4){ktw0[0], ktw0[1], ktw0[2], ktw0[3]};
        *(LAS u32x4*)(lds + HG_KT + (2 * cp + 1) * 144 + part * 16) = (u32x4){ktw1[0], ktw1[1], ktw1[2], ktw1[3]};
        *(LAS u32x4*)(lds + HG_VT + (2 * cp) * 144 + part * 16) = (u32x4){vtw0[0], vtw0[1], vtw0[2], vtw0[3]};
        *(LAS u32x4*)(lds + HG_VT + (2 * cp + 1) * 144 + part * 16) = (u32x4){vtw1[0], vtw1[1], vtw1[2], vtw1[3]};
        if (part == 0) { DEC[unit * 128 + 2 * cp] = er0 * eb0; DEC[unit * 128 + 2 * cp + 1] = er1 * eb1; }
        BAR_LDS();
        const int tb = wid >> 2, vb = wid & 3;
        bf16x8 pa[2][2];
#pragma unroll
        for (int sb = 0; sb < 2; ++sb) {
            if (sb <= tb) {
                f32x16 p;
#pragma unroll
                for (int r = 0; r < 16; ++r) p[r] = 0.f;
#pragma unroll
                for (int d0 = 0; d0 < 8; ++d0) { const bf16x8 a = *(const LAS bf16x8*)(lds + HG_KH + (32 * sb + r32) * 272 + (16 * d0 + 8 * hi) * 2), bq = *(const LAS bf16x8*)(lds + HG_QH + (32 * tb + r32) * 272 + (16 * d0 + 8 * hi) * 2);
                    p = __builtin_amdgcn_mfma_f32_32x32x16_bf16(a, bq, p, 0, 0, 0); }
#pragma unroll
                for (int r = 0; r < 16; ++r) { const int s = 32 * sb + crow(r, hi), t = 32 * tb + r32; if (s > t) p[r] = 0.f; }
                PK4(p, 0, pa[sb][0]); PK4(p, 8, pa[sb][1]);
            }
        }
        { f32x16 o;
#pragma unroll
          for (int r = 0; r < 16; ++r) o[r] = 0.f;
#pragma unroll
          for (int sb = 0; sb < 2; ++sb) if (sb <= tb) {
#pragma unroll
              for (int ks = 0; ks < 2; ++ks) { const bf16x8 bv = *(const LAS bf16x8*)(lds + HG_VT + (32 * vb + r32) * 144 + (32 * sb + 16 * ks + 8 * hi) * 2);
                  o = __builtin_amdgcn_mfma_f32_32x32x16_bf16(pa[sb][ks], bv, o, 0, 0, 0); } }
#pragma unroll
          for (int r = 0; r < 16; ++r) { const int t = 32 * tb + crow(r, hi); const float v = o[r], vn = __shfl_xor(v, 1);
              if ((r32 & 1) == 0) *(unsigned*)(INTRA + (size_t)(row0 + t) * 1024 + h * 128 + 32 * vb + r32) = pk2(v, vn); } }
#pragma unroll
        for (int j = 0; j < 2; ++j) { const int kbk = 2 * tb + j; f32x16 a2;
#pragma unroll
            for (int r = 0; r < 16; ++r) a2[r] = 0.f;
#pragma unroll
            for (int ks = 0; ks < 4; ++ks) { const bf16x8 av = *(const LAS bf16x8*)(lds + HG_VT + (32 * vb + r32) * 144 + (16 * ks + 8 * hi) * 2), bk = *(const LAS bf16x8*)(lds + HG_KT + (32 * kbk + r32) * 144 + (16 * ks + 8 * hi) * 2);
                a2 = __builtin_amdgcn_mfma_f32_32x32x16_bf16(av, bk, a2, 0, 0, 0); }
#pragma unroll
            for (int r = 0; r < 16; ++r) { const int v = 32 * vb + crow(r, hi); const float x = a2[r], xn = __shfl_xor(x, 1);
                if ((r32 & 1) == 0) *(unsigned*)(UT + ((size_t)unit * 128 + v) * 128 + 32 * kbk + r32) = pk2(x, xn); } }
        BAR_LDS();
    }
}
__device__ __forceinline__ void p_hgrn2(Frame& F) {
    bf16* UT = (bf16*)(F.ws + WS_OVL + OV_UT); const float* DEC = (const float*)(F.ws + WS_OVL + OV_DEC);
    for (int id = F.bid * NTHR + F.tid; id < 32 * 4096; id += F.G * NTHR) {
        const int bh = id >> 12, rem = id & 4095, v = rem >> 5, k4 = rem & 31;
        float st[4] = {0.f, 0.f, 0.f, 0.f};
        for (int c0 = 0; c0 < 64; c0 += 8) {
            u32x2 uu[8]; f32x4 dd[8];
#pragma unroll
            for (int j = 0; j < 8; ++j) { const size_t un = (size_t)bh * 64 + c0 + j; uu[j] = *(const u32x2*)(UT + (un * 128 + v) * 128 + 4 * k4); dd[j] = *(const f32x4*)(DEC + un * 128 + 4 * k4); }
#pragma unroll
            for (int j = 0; j < 8; ++j) { const size_t un = (size_t)bh * 64 + c0 + j;
                u32x2 o; o.x = pk2(st[0], st[1]); o.y = pk2(st[2], st[3]); *(u32x2*)(UT + (un * 128 + v) * 128 + 4 * k4) = o;
                st[0] = st[0] * dd[j][0] + bflo(uu[j].x); st[1] = st[1] * dd[j][1] + bfhi(uu[j].x); st[2] = st[2] * dd[j][2] + bflo(uu[j].y); st[3] = st[3] * dd[j][3] + bfhi(uu[j].y); }
        }
    }
}
__device__ __forceinline__ void p_hgrn3(Frame& F, int l) {
    const bf16* U = (const bf16*)(F.ws + WS_OVL + OV_U); const bf16* QT = (const bf16*)(F.ws + WS_OVL + OV_QT); const bf16* INTRA = (const bf16*)(F.ws + WS_OVL + OV_INTRA); const bf16* UT = (const bf16*)(F.ws + WS_OVL + OV_UT);
    bf16* MIX = (bf16*)(F.ws + WS_OVL + OV_MIX); const float* gout = F.in[9] + l * 128;
    LAS float* OL = (LAS float*)F.lds;
    const int tid = F.tid, lane = F.lane, wid = F.wave, r32 = lane & 31, hi = lane >> 5, tb = wid >> 2, vb = wid & 3;
    bf16x8 fa[8], fb[8];
#define H3_FRAGS(unit_) do { const int b_ = (unit_) >> 9, h_ = ((unit_) >> 6) & 7, c_ = (unit_) & 63, row0_ = b_ * SEQ + 64 * c_; \
        const bf16* ap_ = QT + (size_t)(row0_ + 32 * tb + r32) * 1024 + h_ * 128 + 8 * hi; const bf16* bp_ = UT + ((size_t)(unit_) * 128 + 32 * vb + r32) * 128 + 8 * hi; \
        _Pragma("unroll") for (int ks = 0; ks < 8; ++ks) { fa[ks] = *(const bf16x8*)(ap_ + 16 * ks); fb[ks] = *(const bf16x8*)(bp_ + 16 * ks); } } while (0)
    if (F.bid < 2048) H3_FRAGS(F.bid);
    for (int unit = F.bid; unit < 2048; unit += F.G) {
        const int b = unit >> 9, h = (unit >> 6) & 7, c = unit & 63, row0 = b * SEQ + 64 * c;
        const int t = tid >> 3, j = tid & 7; const size_t row = (size_t)(row0 + t);
        const u32x4 i0 = *(const u32x4*)(INTRA + row * 1024 + h * 128 + 16 * j), i1 = *(const u32x4*)(INTRA + row * 1024 + h * 128 + 16 * j + 8);
        const u32x4 g0 = *(const u32x4*)(U + row * UW + C_HG + h * 128 + 16 * j), g1 = *(const u32x4*)(U + row * UW + C_HG + h * 128 + 16 * j + 8);
        f32x16 acc;
#pragma unroll
        for (int r = 0; r < 16; ++r) acc[r] = 0.f;
#pragma unroll
        for (int ks = 0; ks < 8; ++ks) acc = __builtin_amdgcn_mfma_f32_32x32x16_bf16(fa[ks], fb[ks], acc, 0, 0, 0);
#pragma unroll
        for (int r = 0; r < 16; ++r) OL[(32 * tb + crow(r, hi)) * 132 + 32 * vb + r32] = acc[r];
        SBAR();
        if (unit + F.G < 2048) H3_FRAGS(unit + F.G);
        SBAR();
        BAR_LDS();
        { const unsigned iw[8] = {i0.x, i0.y, i0.z, i0.w, i1.x, i1.y, i1.z, i1.w}, gw[8] = {g0.x, g0.y, g0.z, g0.w, g1.x, g1.y, g1.z, g1.w};
          float o[16]; float ss = 0.f;
#pragma unroll
          for (int i = 0; i < 4; ++i) { const f32x4 x = *(const LAS f32x4*)(OL + t * 132 + 16 * j + 4 * i);
              o[4 * i] = x[0] + bflo(iw[2 * i]); o[4 * i + 1] = x[1] + bfhi(iw[2 * i]); o[4 * i + 2] = x[2] + bflo(iw[2 * i + 1]); o[4 * i + 3] = x[3] + bfhi(iw[2 * i + 1]); }
#pragma unroll
          for (int i = 0; i < 16; ++i) ss += o[i] * o[i];
          ss += __shfl_xor(ss, 1); ss += __shfl_xor(ss, 2); ss += __shfl_xor(ss, 4);
          const float rstd = __builtin_amdgcn_rsqf(ss * (1.f / 128) + EPS);
          unsigned ow[8];
#pragma unroll
          for (int i = 0; i < 8; ++i) { const float ga = bflo(gw[i]), gb = bfhi(gw[i]);
              const float ya = o[2 * i] * rstd * gout[16 * j + 2 * i] * ga * __builtin_amdgcn_rcpf(1.f + fexp(-ga)), yb = o[2 * i + 1] * rstd * gout[16 * j + 2 * i + 1] * gb * __builtin_amdgcn_rcpf(1.f + fexp(-gb));
              ow[i] = pk2(ya, yb); }
          bf16* op = MIX + row * D + 512 + h * 128 + 16 * j;
          *(u32x4*)op = (u32x4){ow[0], ow[1], ow[2], ow[3]}; *(u32x4*)(op + 8) = (u32x4){ow[4], ow[5], ow[6], ow[7]}; }
        BAR_LDS();
    }
#undef H3_FRAGS
}

constexpr int RT_CK = 128, RT_ROWB = RT_CK * 2 + 16, RT_WBUF = 2 * 80 * RT_ROWB, RT_LG = 2 * RT_WBUF;
__device__ __forceinline__ void p_router(Frame& F, int l) {
    const bf16* x = (const bf16*)(F.ws + WS_HN); const float* bgr = F.in[26] + l * 8; const float* ber = F.in[28] + l * 64;
    const bf16* rw = (const bf16*)(F.ws + WS_SMALL + SM_RW) + (size_t)l * 2 * 80 * D;
    float* rstdo = (float*)(F.ws + WS_SMALL + SM_RSTDFFN); int* eidx = (int*)(F.ws + WS_SMALL + SM_EIDX); float* gate = (float*)(F.ws + WS_SMALL + SM_GATE); int* slot = (int*)(F.ws + WS_SMALL + SM_SLOT);
    unsigned* cnt = F.ctl + CW_CNT + l * 64 * 64; int* rt2 = (int*)(F.ws + WS_OVL + OV_XG); float* rs2 = (float*)(F.ws + WS_OVL + OV_XG + RS2_OFF);
    LAS unsigned char* WB = F.lds; LAS float* LG = (LAS float*)(F.lds + RT_LG + F.wave * (16 * 84 * 4));
    const int tid = F.tid, lane = F.lane, c = lane & 15, q = lane >> 4, wv = F.wave;
    const int srow = tid >> 4, sck = tid & 15;
    for (int tg = F.bid; tg < NTOK / 64; tg += F.G) {
        u32x4 wA[5], wB[5];
#define RT_WLOAD(w_, ch) do { _Pragma("unroll") for (int e = 0; e < 5; ++e) w_[e] = *(const u32x4*)(rw + (size_t)(srow + 32 * e) * D + RT_CK * (ch) + sck * 8); } while (0)
#define RT_WSTORE(w_, bf) do { _Pragma("unroll") for (int e = 0; e < 5; ++e) *(LAS u32x4*)(WB + (bf) * RT_WBUF + (srow + 32 * e) * RT_ROWB + sck * 16) = w_[e]; } while (0)
#define RT_XLOAD(x_, ch) do { if (wv < 4) { _Pragma("unroll") for (int i = 0; i < 4; ++i) x_[i] = *(const bf16x8*)(xp + RT_CK * (ch) + 32 * i); } } while (0)
        f32x4 acc[5];
#pragma unroll
        for (int i = 0; i < 5; ++i) acc[i] = (f32x4){0.f, 0.f, 0.f, 0.f};
        float ss = 0.f;
        const bf16* xp = x + (size_t)(tg * 64 + (wv & 3) * 16 + c) * D + 8 * q;
        bf16x8 xv[4], xA[4], xB[4];
        RT_WLOAD(wB, 0); RT_XLOAD(xv, 0);
        RT_WLOAD(wA, 1); RT_XLOAD(xA, 1);
        SBAR();
        RT_WSTORE(wB, 0); BAR_LDS();
#define RT_COMPUTE(bf) do { if (wv < 4) { const LAS unsigned char* wb = WB + (bf) * RT_WBUF + c * RT_ROWB + q * 16; \
            _Pragma("unroll") for (int i = 0; i < 4; ++i) { \
                _Pragma("unroll") for (int j = 0; j < 8; ++j) { const float xf = bf2f((unsigned short)xv[i][j]); ss += xf * xf; } \
                bf16x8 bh[5], bl[5]; \
                _Pragma("unroll") for (int ct = 0; ct < 5; ++ct) { bh[ct] = *(const LAS bf16x8*)(wb + (16 * ct) * RT_ROWB + i * 64); bl[ct] = *(const LAS bf16x8*)(wb + (80 + 16 * ct) * RT_ROWB + i * 64); } \
                SBAR(); \
                _Pragma("unroll") for (int ct = 0; ct < 5; ++ct) { acc[ct] = __builtin_amdgcn_mfma_f32_16x16x32_bf16(xv[i], bh[ct], acc[ct], 0, 0, 0); acc[ct] = __builtin_amdgcn_mfma_f32_16x16x32_bf16(xv[i], bl[ct], acc[ct], 0, 0, 0); } \
                SBAR(); } } } while (0)
#pragma nounroll
        for (int ch = 0; ch < D / RT_CK; ch += 2) {
            if (ch + 2 < D / RT_CK) { RT_WLOAD(wB, ch + 2); RT_XLOAD(xB, ch + 2); }
            SBAR();
            RT_COMPUTE(0);
            SBAR();
            RT_WSTORE(wA, 1);
            if (wv < 4) {
#pragma unroll
                for (int i = 0; i < 4; ++i) xv[i] = xA[i]; }
            BAR_LDS();
            if (ch + 3 < D / RT_CK) { RT_WLOAD(wA, ch + 3); RT_XLOAD(xA, ch + 3); }
            SBAR();
            RT_COMPUTE(1);
            SBAR();
            if (ch + 2 < D / RT_CK) { RT_WSTORE(wB, 0);
                if (wv < 4) {
#pragma unroll
                    for (int i = 0; i < 4; ++i) xv[i] = xB[i]; } }
            BAR_LDS();
        }
#undef RT_COMPUTE
#undef RT_XLOAD
#undef RT_WLOAD
#undef RT_WSTORE
        if (wv < 4) {
            ss += __shfl_xor(ss, 16); ss += __shfl_xor(ss, 32);
            const float rstd = __builtin_amdgcn_rsqf(ss * (1.f / D) + EPS);
#pragma unroll
            for (int ct = 0; ct < 5; ++ct)
#pragma unroll
                for (int r = 0; r < 4; ++r) LG[(4 * q + r) * 84 + 16 * ct + c] = acc[ct][r];
            LDS_WAIT();
            if (lane < 16) {
                const int tok = tg * 64 + wv * 16 + lane; const LAS float* lg = LG + lane * 84;
                float gl[8]; float gm = -3.4e38f; int grp = 0;
#pragma unroll
                for (int j = 0; j < 8; ++j) { gl[j] = lg[j] * rstd + bgr[j]; if (gl[j] > gm) { gm = gl[j]; grp = j; } }
                float gs = 0.f;
#pragma unroll
                for (int j = 0; j < 8; ++j) gs += expf(gl[j] - gm);
                const float pgrp = 1.f / gs;
                float el[8]; float e1 = -3.4e38f; int i1 = 0;
#pragma unroll
                for (int j = 0; j < 8; ++j) { el[j] = lg[16 + grp * 8 + j] * rstd + ber[grp * 8 + j]; if (el[j] > e1) { e1 = el[j]; i1 = j; } }
                float e2 = -3.4e38f; int i2 = 0;
#pragma unroll
                for (int j = 0; j < 8; ++j) if (j != i1 && el[j] > e2) { e2 = el[j]; i2 = j; }
                const float r21 = expf(e2 - e1), g1 = pgrp / (1.f + r21), g2 = pgrp * r21 / (1.f + r21);
                const int ex1 = grp * 8 + i1, ex2_ = grp * 8 + i2;
                const int s1 = (int)atomicAdd(cnt + ex1 * 64, 1u), s2 = (int)atomicAdd(cnt + ex2_ * 64, 1u);
                rt2[ex1 * RT_CAP + s1] = tok; rt2[ex2_ * RT_CAP + s2] = tok; rs2[ex1 * RT_CAP + s1] = rstd; rs2[ex2_ * RT_CAP + s2] = rstd;
                (void)rstdo; eidx[2 * tok] = ex1; eidx[2 * tok + 1] = ex2_; gate[2 * tok] = g1; gate[2 * tok + 1] = g2; slot[2 * tok] = s1; slot[2 * tok + 1] = s2;
            }
            LDS_WAIT();
        }
        __syncthreads();
    }
}
__device__ __forceinline__ void p_gather(Frame& F, int l) {
    const int* eidx = (const int*)(F.ws + WS_SMALL + SM_EIDX); const int* slot = (const int*)(F.ws + WS_SMALL + SM_SLOT);
    int* arow = (int*)(F.ws + WS_SMALL + SM_AROW); int* rowtok = (int*)(F.ws + WS_SMALL + SM_ROWTOK);
    const unsigned* cnt = F.ctl + CW_CNT + l * 64 * 64;
    LAS int* OFF = (LAS int*)F.lds;
    LAS int* CN = OFF + 128;
    if (F.tid < 64) {
        const int cn = (int)__hip_atomic_load(cnt + F.tid * 64, __ATOMIC_RELAXED, __HIP_MEMORY_SCOPE_AGENT); const int pd = (cn + 255) & ~255;
        int inc = pd;
#pragma unroll
        for (int o = 1; o < 64; o <<= 1) { const int t = __shfl_up(inc, o); if (F.lane >= o) inc += t; }
        CN[F.tid] = cn; OFF[F.tid] = inc - pd; if (F.tid == 63) OFF[64] = inc;
        if (F.bid == 0) {
            const int e = F.tid, o0 = inc - pd; int n = o0 >> 8;
            for (int r = o0; r < inc; r += 256) { F.ctl[CW_MTE + l * 256 + n] = (unsigned)e; F.ctl[CW_MTR + l * 256 + n] = (unsigned)r | ((o0 + cn - r <= 128) ? 0x80000000u : 0u); ++n; }
            if (e == 63) F.ctl[CW_NMT + l] = (unsigned)(inc >> 8); }
    }
    LDS_WAIT(); __syncthreads();
    for (int tok = F.bid * NTHR + F.tid; tok < NTOK; tok += F.G * NTHR) {
        const int r0 = OFF[eidx[2 * tok]] + slot[2 * tok], r1 = OFF[eidx[2 * tok + 1]] + slot[2 * tok + 1];
        arow[2 * tok] = r0; arow[2 * tok + 1] = r1; rowtok[r0] = tok; rowtok[r1] = tok; }
    for (int e = F.bid; e < 64; e += F.G)
        for (int r = OFF[e] + CN[e] + F.tid; r < OFF[e + 1]; r += NTHR) rowtok[r] = 0;
    __syncthreads();
}

__device__ __forceinline__ int moe_tables(Frame& F, int l) {
    const unsigned* cnt = F.ctl + CW_CNT + l * 64 * 64;
    LAS int* tb = (LAS int*)(F.lds + MT_LDS);
    if (F.tid < 64) {
        const int cn = (int)cnt[F.tid * 64];   const int pd = (cn + 255) & ~255;
        int inc = pd;
#pragma unroll
        for (int o = 1; o < 64; o <<= 1) { const int t = __shfl_up(inc, o); if (F.lane >= o) inc += t; }
        const int e = F.tid, o0 = inc - pd; int n = o0 >> 8;
        tb[MT_CN + e] = cn; tb[MT_OFF + e] = o0; if (e == 63) tb[MT_OFF + 64] = inc;
        for (int r = o0; r < inc; r += 256) { tb[MT_E + n] = e; tb[MT_R + n] = (int)((unsigned)r | ((o0 + cn - r <= 128) ? 0x80000000u : 0u)); tb[MT_B + n] = e * RT_CAP - o0; tb[MT_N + n] = o0 + cn; ++n; }
    }
    LDS_WAIT(); __syncthreads();
    return __builtin_amdgcn_readfirstlane(tb[MT_OFF + 64]) >> 8;
}

constexpr int PH_PER_LAYER = 14, PH_BASE = 1, N_PHASES = PH_BASE + DEPTH * PH_PER_LAYER;
__global__ void __launch_bounds__(NTHR, 2) mk_fwd(Args args) {
    extern __shared__ __attribute__((aligned(16))) unsigned char lds_raw[];
    Frame F; F.lds = (LAS unsigned char*)lds_raw; F.tid = threadIdx.x; F.lane = F.tid & 63; F.wave = __builtin_amdgcn_readfirstlane(F.tid >> 6);
    F.G = gridDim.x; F.bid = blockIdx.x; F.ws = args.ws; F.ctl = (unsigned*)(args.ws + WS_CTL); F.in = args.in; F.out = args.out;
    volatile LAS unsigned* MISC = (volatile LAS unsigned*)(F.lds + MISC_OFF);
    if (F.tid < 64) MISC[F.tid] = 0u;
    __syncthreads();
    XcdBarrier bar = xcd_barrier_post(F.ctl + CW_BAR, MISC + 8);
    const int lo = args.ph_lo, hi = args.ph_hi;
#if MK_STAMP
    if (blockIdx.x == 0 && threadIdx.x == 0) ((unsigned long long*)(F.ctl + CW_STAMPS))[0] = wall_clock64();
#endif
#ifndef MK_PHMASK
#define MK_PHMASK 0xFFFFFFFFu
#endif
#ifndef MK_STOP
#define MK_STOP 1000
#endif
#define IN(k) (lo <= (k) && (k) < hi && ((k) < MK_STOP || (k) >= N_PHASES))
#define EN(j) (((MK_PHMASK) >> (j)) & 1u)
#if MK_STAMP
#define SEAM(k) do { if (IN((k) + 1)) xcd_barrier(bar, P.tid == 0); if (P.bid == 0 && P.tid == 0) ((unsigned long long*)(P.ctl + CW_STAMPS))[(k) + 1] = wall_clock64(); } while (0)
#else
#define SEAM(k) do { if (IN((k) + 1)) xcd_barrier(bar, P.tid == 0); } while (0)
#endif
#define LAUNDER(v) asm volatile("" : "+s"(v))
#define PHASE_FRAME() Frame P = F; int z_ = 0; LAUNDER(z_); asm volatile("v_mbcnt_lo_u32_b32 %0, -1, 0\n\tv_mbcnt_hi_u32_b32 %0, -1, %0" : "=v"(P.tid)); P.tid |= (F.wave << 6) + z_; P.lane = P.tid & 63; P.wave = __builtin_amdgcn_readfirstlane(P.tid >> 6); P.ws = F.ws + z_; P.ctl = F.ctl + z_; P.in = F.in + z_; P.out = F.out + z_; P.G = F.G + z_; P.bid = F.bid + z_; unsigned char* ws = P.ws; (void)ws
    if (EN(14) && IN(0)) {
        PHASE_FRAME();
        p_convert(P);
        const int gw = P.bid * NWAVES + P.wave, NGW = P.G * NWAVES;
        for (int r = gw; r < 2 * 1024; r += NGW) { const int l = r >> 10, row = r & 1023;
            norm_row(P.in[1] + (size_t)row * D, nullptr, (bf16*)(ws + WS_MEMN) + (size_t)r * D, P.in[18] + l * D, nullptr, nullptr, 0.f, 0.f, P.lane); }
        for (int r = gw; r < NTOK; r += 2 * NGW) { const int r2 = r + NGW, rb = r2 < NTOK ? r2 : r;
            float* const rsb = (float*)(ws + WS_SMALL + SM_RS);
            const void* const xi[2] = {P.in[0] + (size_t)r * D, P.in[0] + (size_t)rb * D}; bf16* const x16[2] = {(bf16*)(ws + WS_HN) + (size_t)r * D, (bf16*)(ws + WS_HN) + (size_t)rb * D};
            float* const xf[2] = {nullptr, nullptr}; float* const rs[2] = {rsb + r, rsb + rb}; const bf16* const ya[2] = {nullptr, nullptr}; const float gg[2] = {0.f, 0.f};
            stream_rows<2, false, false>(xi, x16, xf, rs, ya, ya, gg, gg, P.lane); }
        SEAM(0);
    }
    for (int l_ = 0; l_ < DEPTH; ++l_) {
        const int pb = PH_BASE + l_ * PH_PER_LAYER;
#define LAYER_FRAME() PHASE_FRAME(); int l = l_ + z_; const int vcu = (P.G % 8 == 0) ? (P.bid % 8) * (P.G / 8) + P.bid / 8 : P.bid; (void)vcu; unsigned char* wl = ws + WS_W + (size_t)l * WL_END; (void)wl; \
        bf16* U = (bf16*)(ws + WS_OVL + OV_U); bf16* MIX = (bf16*)(ws + WS_OVL + OV_MIX); bf16* HN = (bf16*)(ws + WS_HN); (void)U; (void)MIX; (void)HN
        if (EN(0) && IN(pb + 0)) {
            LAYER_FRAME();
            pg8::Gemm g{HN, (const bf16*)(wl + WL_WIN), D, D}; pg8::EpiBf16 E{U, UW, nullptr, (const float*)(ws + WS_SMALL + SM_RS)};
            pg8::WinPlusExtra S; S.base.init(NTOK, UW, D, D, P.G, P.bid); S.nx = l == 0 ? 32 : 0;
            S.xa = (long)((ws + WS_MEMN) - (ws + WS_HN)); S.xa_l = (long)1024 * D * 2; S.xb = (long)((ws + WS_W + WL_WMKV) - (wl + WL_WIN)); S.xb_l = (long)WL_END;
            S.xo = (bf16*)(ws + WS_MKV); S.xo_l = (size_t)1024 * 1024;
            pg8::gemm_phase(P.lds, P.tid, g, S, E);
            SEAM(pb + 0);
        }
        if (EN(1) && IN(pb + 1)) {
            LAYER_FRAME();
            { pg8::Gemm g{U + C_CQ, (const bf16*)(wl + WL_WUQ), UW, 512}; pg8::StaticOrder S; S.init(NTOK, 768, UW, 512, P.G, P.bid); pg8::EpiBf16 E{(bf16*)(ws + WS_OVL + OV_QM), 768, nullptr, nullptr};
              pg8::gemm_phase(P.lds, P.tid, g, S, E); }
            { pg8::Gemm g{U + C_CKV, (const bf16*)(wl + WL_WUKV), UW, 256}; pg8::StaticOrder S; S.init(NTOK, 1024, UW, 256, P.G, P.bid); pg8::EpiBf16 E{(bf16*)(ws + WS_OVL + OV_KVM), 1024, nullptr, nullptr};
              pg8::gemm_phase(P.lds, P.tid, g, S, E); }
            if (l == 0) p_mem_post(P);
            p_prep(P, l);
            p_hgrn1(P, l);
            SEAM(pb + 1);
        }
        if (EN(2) && IN(pb + 2)) {
            LAYER_FRAME();
            p_mla_post(P, l);
            p_hgrn2(P);
            { LAS float* bias = (LAS float*)(P.lds + AT_ML + 4096);
              for (int i = P.tid; i < 1024; i += NTHR) { const int h = i >> 7, d = i & 127; int bk = d;
                  if (d >= 16) { bk = 16 + (int)(logf((float)d / 16.f) / 2.0794415416798357f * 16.f); if (bk > 31) bk = 31; }
                  bias[i] = P.in[2][bk * 8 + h] * LOG2E; }
              LDS_WAIT(); __syncthreads();
              const bf16* SVT = (const bf16*)(ws + WS_OVL + OV_SVT);
              for (int un = vcu; un < 512; un += P.G) { const int b = un >> 7, h = 2 * ((un >> 5) & 3), qb = un & 31;
                  AttnU a; a.Q = U + (size_t)(b * SEQ + qb * 128) * UW + C_SQ + h * 64; a.qs = UW; a.K = U + (size_t)(b * SEQ) * UW + C_SK + (h >> 2) * 64; a.ks = UW;
                  a.VT = SVT + (size_t)((b * 2 + (h >> 2)) * 64) * SEQ; a.vts = SEQ; a.O = MIX + (size_t)(b * SEQ + qb * 128) * D + h * 64; a.os = D; a.q0 = qb * 128;
                  a.t_lo = qb > 0 ? 2 * qb - 2 : 0; a.t_hi = 2 * qb + 2; a.dbg = nullptr; a.qh = 64; a.oh = 64; a.sinkb = P.in[8][l * 8 + h + 1] * LOG2E;
                  attn_unit<64, 64, 2, false, true, false, true>(P.lds, P.tid, a, 0.125f * LOG2E, nullptr, P.in[8][l * 8 + h] * LOG2E, bias + h * 128); }
            }
            SEAM(pb + 2);
        }
        if (EN(3) && IN(pb + 3)) {
            LAYER_FRAME();
            { const bf16* QF = (const bf16*)(ws + WS_OVL + OV_QF); const bf16* KF = (const bf16*)(ws + WS_OVL + OV_KF); const bf16* VT = (const bf16*)(ws + WS_OVL + OV_VT);
              for (int it = vcu; it < 512; it += P.G) { const int pair = it & 255, bh = pair >> 4, j = pair & 15, qb = it < 256 ? 31 - j : j;
                  AttnU a; a.Q = QF + ((size_t)bh * SEQ + qb * 128) * 192; a.qs = 192; a.K = KF + (size_t)bh * SEQ * 192; a.ks = 192; a.VT = VT + (size_t)bh * 128 * SEQ; a.vts = SEQ;
                  a.O = MIX + ((size_t)(bh >> 2) * SEQ + qb * 128) * D + 1536 + (bh & 3) * 128; a.os = D; a.q0 = qb * 128; a.t_lo = 0; a.t_hi = 2 * qb + 2; a.dbg = nullptr;
                  attn_unit<192, 128, 1, false, false, true, false, true>(P.lds, P.tid, a, 0.07216878364870322f * LOG2E, nullptr, 0.f, nullptr); }
 }
#ifndef MK_NOH3
            p_hgrn3(P, l);
#endif
            SEAM(pb + 3);
        }
        if (EN(4) && IN(pb + 4)) {
            LAYER_FRAME();
            pg8::Gemm g{MIX, (const bf16*)(wl + WL_WOUT), D, D}; pg8::StaticOrder S; S.init(NTOK, D, D, D, P.G, P.bid); pg8::EpiResid16 E{HN, D, (float*)(ws + WS_SMALL + SM_ROWSS)};
            pg8::gemm_phase(P.lds, P.tid, g, S, E);
            SEAM(pb + 4);
        }
        if (EN(6) && IN(pb + 6)) {
            LAYER_FRAME();
            pg8::Gemm g{HN, (const bf16*)(wl + WL_WMQ), D, D}; pg8::HalfOrder S; S.base.init(NTOK, 512, D, D, P.G, P.bid); pg8::EpiBf16 E{(bf16*)(ws + WS_MQ), 512, (const float*)(ws + WS_SMALL + SM_ROWSS), nullptr};
            pg8::gemm_phase(P.lds, P.tid, g, S, E);
            SEAM(pb + 6);
        }
        if (EN(7) && IN(pb + 7)) {
            LAYER_FRAME();
            const bf16* MQ = (const bf16*)(ws + WS_MQ); bf16* MO = (bf16*)(ws + WS_MO);
            const bf16* MK = (const bf16*)(ws + WS_MK) + (size_t)l * 1024 * 512; const bf16* MVT = (const bf16*)(ws + WS_MVT) + (size_t)l * 1024 * 512;
            for (int un = vcu; un < 256; un += P.G) { const int b = un >> 6, h = (un >> 4) & 3, qb = 2 * (un & 15);
                AttnU a; a.Q = MQ + (size_t)(b * SEQ + qb * 128) * 512 + h * 128; a.qs = 512; a.K = MK + (size_t)((b * 4 + h) * 256) * 128; a.ks = 128; a.VT = MVT + (size_t)((b * 4 + h) * 128) * 256; a.vts = 256;
                a.O = MO + (size_t)(b * SEQ + qb * 128) * 512 + h * 128; a.os = 512; a.q0 = 0; a.t_lo = 0; a.t_hi = 4; a.dbg = nullptr; a.qh = 128 * 512; a.oh = 128 * 512; a.sinkb = 0.f;
                attn_unit<128, 128, 0, true, false, true, true>(P.lds, P.tid, a, 0.08838834764831845f * LOG2E, P.in[21] + l * 128, 0.f, nullptr); }
            SEAM(pb + 7);
        }
        if (EN(8) && IN(pb + 8)) {
            LAYER_FRAME();
            pg8::Gemm g{(const bf16*)(ws + WS_MO), (const bf16*)(wl + WL_WMO), 512, 512}; pg8::StaticOrder S; S.init(NTOK, D, 512, 512, P.G, P.bid); pg8::EpiResid16 E{HN, D, nullptr};
            pg8::gemm_phase(P.lds, P.tid, g, S, E);
            SEAM(pb + 8);
        }
        if (EN(9) && IN(pb + 9)) { LAYER_FRAME(); p_router(P, l); SEAM(pb + 9); }
        if (EN(11) && IN(pb + 11)) {
            LAYER_FRAME();
            const int nmt = moe_tables(P, l);
            pg8::Gemm g{HN, (const bf16*)(wl + WL_WGU), D, D, (const int*)(ws + WS_OVL + OV_XG)};
            pg8::GroupedOrder S{(const LAS int*)(P.lds + MT_LDS), nmt, 4, P.G, vcu, D, D, (size_t)1024 * D * 2};
            pg8::EpiGateUp E{(bf16*)(ws + WS_OVL + OV_HMID), 512, (const int*)(ws + WS_OVL + OV_XG), (const float*)(ws + WS_OVL + OV_XG + RS2_OFF)};
            pg8::gemm_phase<pg8::EpiGateUp, pg8::GroupedOrder, true>(P.lds, P.tid, g, S, E);
            SEAM(pb + 11);
        }
        if (EN(12) && IN(pb + 12)) {
            LAYER_FRAME();
            const int nmt = (lo == pb + 12) ? moe_tables(P, l) : (__builtin_amdgcn_readfirstlane(((const LAS int*)(P.lds + MT_LDS))[MT_OFF + 64]) >> 8);
            pg8::Gemm g{(const bf16*)(ws + WS_OVL + OV_HMID), (const bf16*)(wl + WL_WD), 512, 512};
            pg8::GroupedOrder S{(const LAS int*)(P.lds + MT_LDS), nmt, 8, P.G, vcu, 512, 512, (size_t)D * 512 * 2};
            pg8::EpiBf16 E{(bf16*)(ws + WS_OVL + OV_YB), D, nullptr, nullptr};
            pg8::gemm_phase(P.lds, P.tid, g, S, E);
            SEAM(pb + 12);
        }
        if (EN(13) && IN(pb + 13)) {
            LAYER_FRAME();
            const int gw = P.bid * NWAVES + P.wave, NGW = P.G * NWAVES;
            if (lo == pb + 13) (void)moe_tables(P, l); const LAS int* OFFT = (const LAS int*)(P.lds + MT_LDS) + MT_OFF;
            const int* eidx = (const int*)(ws + WS_SMALL + SM_EIDX); const int* slot = (const int*)(ws + WS_SMALL + SM_SLOT);
#define AROW(i) (OFFT[eidx[i]] + slot[i])
            const float* gate = (const float*)(ws + WS_SMALL + SM_GATE); const bf16* YB = (const bf16*)(ws + WS_OVL + OV_YB);
            float* const rsb = (float*)(ws + WS_SMALL + SM_RS); const bool lastl = l + 1 >= DEPTH;
            for (int r = gw; r < NTOK; r += 2 * NGW) { const int r2 = r + NGW;
                if (r2 < NTOK) {
                    const void* const xi[2] = {HN + (size_t)r * D, HN + (size_t)r2 * D}; bf16* const x16[2] = {lastl ? nullptr : HN + (size_t)r * D, lastl ? nullptr : HN + (size_t)r2 * D};
                    float* const xf[2] = {lastl ? P.out + (size_t)r * D : nullptr, lastl ? P.out + (size_t)r2 * D : nullptr}; float* const rs[2] = {lastl ? nullptr : rsb + r, lastl ? nullptr : rsb + r2};
                    const bf16* const ya[2] = {YB + (size_t)AROW(2 * r) * D, YB + (size_t)AROW(2 * r2) * D}; const bf16* const yb[2] = {YB + (size_t)AROW(2 * r + 1) * D, YB + (size_t)AROW(2 * r2 + 1) * D};
                    const float ga[2] = {gate[2 * r], gate[2 * r2]}, gb[2] = {gate[2 * r + 1], gate[2 * r2 + 1]};
                    stream_rows<2, true, true>(xi, x16, xf, rs, ya, yb, ga, gb, P.lane);
                } else {
                    const void* const xi[1] = {HN + (size_t)r * D}; bf16* const x16[1] = {lastl ? nullptr : HN + (size_t)r * D}; float* const xf[1] = {lastl ? P.out + (size_t)r * D : nullptr}; float* const rs[1] = {lastl ? nullptr : rsb + r};
                    const bf16* const ya[1] = {YB + (size_t)AROW(2 * r) * D}; const bf16* const yb[1] = {YB + (size_t)AROW(2 * r + 1) * D}; const float ga[1] = {gate[2 * r]}, gb[1] = {gate[2 * r + 1]};
                    stream_rows<1, true, true>(xi, x16, xf, rs, ya, yb, ga, gb, P.lane); } }
            SEAM(pb + 13);
        }
    }
#if MK_SANITIZE
    if (IN(N_PHASES)) { PHASE_FRAME(); for (size_t i = (size_t)P.bid * NTHR + P.tid; i < (size_t)NTOK * D; i += (size_t)P.G * NTHR) { float v = P.out[i]; if (!(fabsf(v) < 1e30f)) P.out[i] = 0.f; } }
#endif
#undef IN
#undef SEAM
}

#if MK_DEBUG
constexpr int CW_DBG = 12288;
__device__ __forceinline__ unsigned dh(unsigned x) { x ^= x >> 16; x *= 0x7feb352du; x ^= x >> 15; x *= 0x846ca68bu; x ^= x >> 16; return x; }
__device__ __forceinline__ void dbg_put(unsigned* ctl, int k, float got, float want, float scale) {
    float e = fabsf(got - want) / (fabsf(want) + scale); if (!(e == e) || !(fabsf(got) < 1e30f)) e = 1e9f;
    atomicMax(ctl + CW_DBG + k, __builtin_bit_cast(unsigned, e));
}
__device__ double dcos2pi(double fr, bool want_sin) {
    double th = (fr - 0.5) * 6.283185307179586;
    double t2 = th * th, c = 1.0, s = th, tc = 1.0, ts = th;
    for (int n = 1; n < 16; ++n) { tc *= -t2 / ((2.0 * n - 1.0) * (2.0 * n)); c += tc; ts *= -t2 / ((2.0 * n) * (2.0 * n + 1.0)); s += ts; }
    return want_sin ? -s : -c;
}
__global__ void __launch_bounds__(256) dbg_kernel(Args args, int stage, int l) {
    const float* const* in = args.in; unsigned char* ws = args.ws; unsigned* ctl = (unsigned*)(ws + WS_CTL);
    const int gid = blockIdx.x * 256 + threadIdx.x, NT = gridDim.x * 256;
    unsigned char* wl = ws + WS_W + (size_t)l * WL_END;
    const bf16* HN = (const bf16*)(ws + WS_HN); const bf16* U = (const bf16*)(ws + WS_OVL + OV_U); const bf16* MIX = (const bf16*)(ws + WS_OVL + OV_MIX);
    const bf16* WIN = (const bf16*)(wl + WL_WIN);
    if (stage == 1) {
        for (int s = gid; s < 8192; s += NT) { const unsigned h = dh(s * 2654435761u + 12345u);
            { const int n = h % INW, k = (h >> 13) % D; dbg_put(ctl, 1, bf2f(WIN[(size_t)n * D + k]), in[5][((size_t)l * D + k) * INW + n], 1e-3f); }
            { const int n = INW + h % (UW - INW), k = (h >> 13) % D; dbg_put(ctl, 1, bf2f(WIN[(size_t)n * D + k]), 0.f, 1e-3f); }
            { const int n = h % 768, k = (h >> 13) % 512; dbg_put(ctl, 1, bf2f(((const bf16*)(wl + WL_WUQ))[(size_t)n * 512 + k]), in[12][((size_t)l * 512 + k) * 768 + n] * in[10][l * 512 + k], 1e-3f); }
            { const int n = h % 1024, k = (h >> 13) % 256; dbg_put(ctl, 1, bf2f(((const bf16*)(wl + WL_WUKV))[(size_t)n * 256 + k]), in[13][((size_t)l * 256 + k) * 1024 + n] * in[11][l * 256 + k], 1e-3f); }
            { const int n = h % D, k = (h >> 13) % D; dbg_put(ctl, 1, bf2f(((const bf16*)(wl + WL_WOUT))[(size_t)n * D + k]), in[16][((size_t)l * D + k) * D + n], 1e-3f); }
            { const int n = h % 512, k = (h >> 13) % D; dbg_put(ctl, 1, bf2f(((const bf16*)(wl + WL_WMQ))[(size_t)n * D + k]), in[19][((size_t)l * D + k) * 512 + n], 1e-3f); }
            { const int n = h % 1024, k = (h >> 13) % D; dbg_put(ctl, 1, bf2f(((const bf16*)(wl + WL_WMKV))[(size_t)n * D + k]), in[20][((size_t)l * D + k) * 1024 + n], 1e-3f); }
            { const int n = h % D, k = (h >> 13) % 512; dbg_put(ctl, 1, bf2f(((const bf16*)(wl + WL_WMO))[(size_t)n * 512 + k]), in[23][((size_t)l * 512 + k) * D + n], 1e-3f); }
            { const int e = (h >> 3) % NEXP, n = h % DEXP, k = (h >> 13) % D; const bf16* gu = (const bf16*)(wl + WL_WGU) + (size_t)e * 1024 * D;
              dbg_put(ctl, 1, bf2f(gu[(size_t)((n >> 7) * 256 + (n & 127)) * D + k]), in[29][(((size_t)l * NEXP + e) * D + k) * DEXP + n], 1e-3f);
              dbg_put(ctl, 1, bf2f(gu[(size_t)((n >> 7) * 256 + 128 + (n & 127)) * D + k]), in[30][(((size_t)l * NEXP + e) * D + k) * DEXP + n], 1e-3f); }
            { const int e = (h >> 3) % NEXP, n = h % D, k = (h >> 13) % DEXP; dbg_put(ctl, 1, bf2f(((const bf16*)(wl + WL_WD))[((size_t)e * D + n) * DEXP + k]), in[31][(((size_t)l * NEXP + e) * DEXP + k) * D + n], 1e-3f); }
        }
    }
    if (stage == 2) {
        for (int s = gid; s < 512; s += NT) { const unsigned h = dh(s * 977u + 7u); const int r = (s < 4) ? (s & 1 ? NTOK - 1 : 0) : h % NTOK, c = (h >> 15) % D;
            const float* xr = in[0] + (size_t)r * D; float ss = 0.f; for (int k = 0; k < D; ++k) ss += xr[k] * xr[k];
            dbg_put(ctl, 2, bf2f(HN[(size_t)r * D + c]), xr[c] * rsqrtf(ss / D + EPS) * in[4][c], 1e-2f); dbg_put(ctl, 2, args.out[(size_t)r * D + c], xr[c], 1e-6f); }
    }
    if (stage == 3) {
        for (int s = gid; s < 4096; s += NT) { const unsigned h = dh(s * 31u + 99u); const int r = (s < 64) ? ((s & 1) ? NTOK - 1 - (s >> 1) : (s >> 1)) : h % NTOK; const int n = (s & 2) ? (UW - 1 - (h >> 14) % 512) : (h >> 14) % UW;
            float a = 0.f; for (int k = 0; k < D; ++k) a += bf2f(HN[(size_t)r * D + k]) * bf2f(WIN[(size_t)n * D + k]);
            dbg_put(ctl, 3, bf2f(U[(size_t)r * UW + n]), a, 0.05f); }
    }
    if (stage == 4) {
        const bf16* QM = (const bf16*)(ws + WS_OVL + OV_QM); const bf16* KVM = (const bf16*)(ws + WS_OVL + OV_KVM);
        for (int s = gid; s < 4096; s += NT) { const unsigned h = dh(s * 131u + 5u); const int r = h % NTOK;
            { const int n = (h >> 14) % 768; float a = 0.f; for (int k = 0; k < 512; ++k) a += bf2f(U[(size_t)r * UW + C_CQ + k]) * bf2f(((const bf16*)(wl + WL_WUQ))[(size_t)n * 512 + k]); dbg_put(ctl, 4, bf2f(QM[(size_t)r * 768 + n]), a, 0.05f); }
            { const int n = (h >> 14) % 1024; float a = 0.f; for (int k = 0; k < 256; ++k) a += bf2f(U[(size_t)r * UW + C_CKV + k]) * bf2f(((const bf16*)(wl + WL_WUKV))[(size_t)n * 256 + k]); dbg_put(ctl, 5, bf2f(KVM[(size_t)r * 1024 + n]), a, 0.05f); } }
    }
    if (stage == 6) {
        const float* rcq = (const float*)(ws + WS_SMALL + SM_RSTDCQ); const float* rckv = (const float*)(ws + WS_SMALL + SM_RSTDCKV); const bf16* SVT = (const bf16*)(ws + WS_OVL + OV_SVT);
        for (int s = gid; s < 256; s += NT) { const unsigned h = dh(s * 733u + 3u); const int r = h % NTOK, hd = (h >> 14) % 10, d = (h >> 20) % 64;
            const int c0 = hd < 8 ? C_SQ + hd * 64 : C_SK + (hd - 8) * 64; float ss = 0.f, mine = 0.f;
            for (int j = 0; j < 64; ++j) { float a = 0.f; for (int k = 0; k < D; ++k) a += bf2f(HN[(size_t)r * D + k]) * bf2f(WIN[(size_t)(c0 + j) * D + k]); a = bf2f(f2bf(a)); ss += a * a; if (j == d) mine = a; }
            dbg_put(ctl, 6, bf2f(U[(size_t)r * UW + c0 + d]), mine * rsqrtf(ss / 64 + EPS) * (hd < 8 ? in[6][l * 64 + d] : in[7][l * 64 + d]), 0.03f);
            float s1 = 0.f; for (int k = 0; k < 512; ++k) { const float a = bf2f(U[(size_t)r * UW + C_CQ + k]); s1 += a * a; } dbg_put(ctl, 6, rcq[r], rsqrtf(s1 / 512 + EPS), 1e-3f);
            float s2 = 0.f; for (int k = 0; k < 256; ++k) { const float a = bf2f(U[(size_t)r * UW + C_CKV + k]); s2 += a * a; } dbg_put(ctl, 6, rckv[r], rsqrtf(s2 / 256 + EPS), 1e-3f);
            const int b = r >> 12, sp = r & 4095, cc = (h >> 9) % 128; dbg_put(ctl, 7, bf2f(SVT[((size_t)b * 128 + cc) * SEQ + sp]), bf2f(U[(size_t)r * UW + C_SV + cc]), 1e-6f); }
    }
    if (stage == 8) {
        const bf16* QM = (const bf16*)(ws + WS_OVL + OV_QM); const bf16* KVM = (const bf16*)(ws + WS_OVL + OV_KVM); const bf16* QF = (const bf16*)(ws + WS_OVL + OV_QF); const bf16* KF = (const bf16*)(ws + WS_OVL + OV_KF); const bf16* VT = (const bf16*)(ws + WS_OVL + OV_VT);
        const float* rcq = (const float*)(ws + WS_SMALL + SM_RSTDCQ); const float* rckv = (const float*)(ws + WS_SMALL + SM_RSTDCKV);
        for (int s = gid; s < 2048; s += NT) { const unsigned h = dh(s * 3571u + 11u); const int r = h % NTOK, hh = (h >> 14) & 3, d = (h >> 16) % 192, b = r >> 12, sp = r & 4095;
            for (int which = 0; which < 2; ++which) {
                float ss = 0.f;
                for (int j = 0; j < 192; ++j) { float a; if (which == 0) a = bf2f(QM[(size_t)r * 768 + hh * 192 + j]) * rcq[r]; else a = j < 128 ? bf2f(KVM[(size_t)r * 1024 + hh * 256 + j]) * rckv[r] : bf2f(U[(size_t)r * UW + C_KR + j - 128]); ss += a * a; }
                const float rstd = rsqrtf(ss / 192 + EPS); const float* gg = which == 0 ? in[14] + l * 192 : in[15] + l * 192;
                auto el = [&](int j) { float a; if (which == 0) a = bf2f(QM[(size_t)r * 768 + hh * 192 + j]) * rcq[r]; else a = j < 128 ? bf2f(KVM[(size_t)r * 1024 + hh * 256 + j]) * rckv[r] : bf2f(U[(size_t)r * UW + C_KR + j - 128]); return a * rstd * gg[j]; };
                float want;
                if (d < 128) want = el(d);
                else { const int i = (d - 128) & 31; const float inv = powf(10000.f, -(float)i / 32.f); const float ang = (float)sp * inv; const double rev = (double)ang * 0.15915494309189535, fr = rev - floor(rev);
                    const float c = (float)dcos2pi(fr, false), sn = (float)dcos2pi(fr, true); const float x1 = el(128 + i), x2 = el(160 + i); want = d < 160 ? x1 * c - x2 * sn : x1 * sn + x2 * c; }
                dbg_put(ctl, 8 + which, bf2f((which == 0 ? QF : KF)[((size_t)(b * 4 + hh) * SEQ + sp) * 192 + d]), want, 0.03f);
            }
            const int dv = d & 127; dbg_put(ctl, 10, bf2f(VT[((size_t)(b * 4 + hh) * 128 + dv) * SEQ + sp]), bf2f(KVM[(size_t)r * 1024 + hh * 256 + 128 + dv]) * rckv[r], 0.01f); }
    }
    if (stage == 11) {
        for (int s = gid; s < 1024; s += NT) { const unsigned h = dh((s >> 4) * 7919u + 13u); const int cls = (s >> 4) % 3; const int r = cls == 0 ? (h % 4) * 4096 + (h >> 5) % 32 : cls == 1 ? (h % 4) * 4096 + 32 + (h >> 5) % 96 : h % NTOK, hq = (h >> 14) & 7, d = ((h >> 17) & 48) + (s & 15), b = r >> 12, t = r & 4095, hkv = hq >> 2;
            const float sink = in[8][l * 8 + hq]; float mx = sink;
            const int s_lo = t - 127 > 0 ? t - 127 : 0;
            for (int pass = 0; pass < 2; ++pass) { float den = 0.f, num = 0.f;
                for (int sk = s_lo; sk <= t; ++sk) { float sc = 0.f; for (int j = 0; j < 64; ++j) sc += bf2f(U[(size_t)r * UW + C_SQ + hq * 64 + j]) * bf2f(U[(size_t)(b * SEQ + sk) * UW + C_SK + hkv * 64 + j]);
                    const int dist = t - sk; int bk = dist; if (dist >= 16) { bk = 16 + (int)(logf((float)dist / 16.f) / 2.0794415416798357f * 16.f); if (bk > 31) bk = 31; }
                    sc = sc * 0.125f + in[2][bk * 8 + hq];
                    if (pass == 0) mx = fmaxf(mx, sc); else { const float p = expf(sc - mx); den += p; num += p * bf2f(U[(size_t)(b * SEQ + sk) * UW + C_SV + hkv * 64 + d]); } }
                if (pass == 1) { den += expf(sink - mx); dbg_put(ctl, 11, bf2f(MIX[(size_t)r * D + hq * 64 + d]), num / den, 0.2f); dbg_put(ctl, t < 32 ? 16 : t < 128 ? 17 : 18, bf2f(MIX[(size_t)r * D + hq * 64 + d]), num / den, 0.2f); } } }
    }
    if (stage == 12) {
        const bf16* QF = (const bf16*)(ws + WS_OVL + OV_QF); const bf16* KF = (const bf16*)(ws + WS_OVL + OV_KF); const bf16* VT = (const bf16*)(ws + WS_OVL + OV_VT);
        for (int s = gid; s < 512; s += NT) { const unsigned h = dh((s >> 3) * 104729u + 17u); const int cls = (s >> 3) % 4; const int r = cls == 0 ? (h % 4) * 4096 + (h >> 5) % 128 : cls == 1 ? (h % 4) * 4096 + 3968 + (h >> 5) % 128 : cls == 2 ? (h % 4) * 4096 + 128 + (h >> 5) % 128 : h % NTOK, hh = (h >> 14) & 3, d = ((h >> 16) & 120) + (s & 7), b = r >> 12, t = r & 4095;
            const bf16* q = QF + ((size_t)(b * 4 + hh) * SEQ + t) * 192; float mx = -1e30f;
            for (int pass = 0; pass < 2; ++pass) { float den = 0.f, num = 0.f;
                for (int sk = 0; sk <= t; ++sk) { const bf16* kk = KF + ((size_t)(b * 4 + hh) * SEQ + sk) * 192; float sc = 0.f; for (int j = 0; j < 192; ++j) sc += bf2f(q[j]) * bf2f(kk[j]); sc *= 0.07216878364870322f;
                    if (pass == 0) mx = fmaxf(mx, sc); else { const float p = expf(sc - mx); den += p; num += p * bf2f(VT[((size_t)(b * 4 + hh) * 128 + d) * SEQ + sk]); } }
                if (pass == 1) { dbg_put(ctl, 12, bf2f(MIX[(size_t)r * D + 1536 + hh * 128 + d]), num / den, 0.1f); dbg_put(ctl, t < 128 ? 19 : t >= 3968 ? 20 : t < 256 ? 21 : 22, bf2f(MIX[(size_t)r * D + 1536 + hh * 128 + d]), num / den, 0.1f); } } }
    }
    if (stage == 24) {
        const bf16* QF = (const bf16*)(ws + WS_OVL + OV_QF); const bf16* KF = (const bf16*)(ws + WS_OVL + OV_KF); const bf16* VT = (const bf16*)(ws + WS_OVL + OV_VT); const float* DB = (const float*)(ws + WS_MQ);
        const float sc2 = 0.07216878364870322f * LOG2E;
        for (int tl = gid; tl < 512; tl += NT) { const int wid = tl >> 6, lane = tl & 63, r32 = lane & 31, hi = lane >> 5, g = wid & 3, kh = wid >> 2, q = 32 * g + r32;
            float sv[32]; float mx = -1e30f;
            for (int kk = 0; kk < 32; ++kk) { const int key = 32 * kh + kk; float a = 0.f; for (int j = 0; j < 192; ++j) a += bf2f(QF[(size_t)q * 192 + j]) * bf2f(KF[(size_t)key * 192 + j]); a *= sc2; mx = fmaxf(mx, a);
                for (int r = 0; r < 16; ++r) if (crow(r, hi) == kk) dbg_put(ctl, 24, DB[(wid * 64 + lane) * 16 + r], a, 0.5f); }
            float l = 0.f; for (int kk = 0; kk < 32; ++kk) { const int key = 32 * kh + kk; float a = 0.f; for (int j = 0; j < 192; ++j) a += bf2f(QF[(size_t)q * 192 + j]) * bf2f(KF[(size_t)key * 192 + j]); a *= sc2; l += exp2f(a - mx); }
            dbg_put(ctl, 25, DB[8192 + (wid * 64 + lane) * 2], mx, 0.5f); dbg_put(ctl, 26, DB[8192 + (wid * 64 + lane) * 2 + 1], l, 0.5f);
            for (int i = 0; i < 4; ++i) for (int r = 0; r < 16; r += 5) { const int qq = 32 * g + crow(r, hi), d = 32 * i + r32; float m2 = -1e30f, acc = 0.f;
                for (int pass = 0; pass < 2; ++pass) for (int kk = 0; kk < 32; ++kk) { const int key = 32 * kh + kk; float a = 0.f; for (int j = 0; j < 192; ++j) a += bf2f(QF[(size_t)qq * 192 + j]) * bf2f(KF[(size_t)key * 192 + j]); a *= sc2;
                    if (pass == 0) m2 = fmaxf(m2, a); else acc += exp2f(a - m2) * bf2f(VT[(size_t)d * SEQ + key]); }
                dbg_put(ctl, 27, DB[16384 + ((wid * 64 + lane) * 4 + i) * 16 + r], acc, 0.3f); }
            (void)sv; }
    }
    if (stage == 13) {
        __shared__ float so[128]; const float* lb = (const float*)(ws + WS_SMALL + SM_LB) + l * 1024;
        for (int smp = blockIdx.x; smp < 64; smp += gridDim.x) { const unsigned h = dh(smp * 15485863u + 19u); const int r = smp < 4 ? ((smp & 1) ? 4096 + 63 + (smp >> 1) * 64 : (smp >> 1) * 70) : h % NTOK, hh = (h >> 14) & 7, b = r >> 12, t = r & 4095; const int v = threadIdx.x & 127;
            float o = 0.f;
            if (threadIdx.x < 128) {
                for (int k = 0; k < 128; ++k) { const float lbv = lb[hh * 128 + k]; const float q = bf2f(U[(size_t)r * UW + C_HQ + hh * 128 + k]); float dcy = 1.f, acc = 0.f;
                    for (int sk = t; sk >= 0 && dcy > 1e-12f; --sk) { const size_t rr = (size_t)(b * SEQ + sk) * UW; const float f = bf2f(U[rr + C_HF + hh * 128 + k]); const float sig = 1.f / (1.f + expf(-f)); const float fv = lbv + (1.f - lbv) * sig;
                        acc += dcy * (1.f - lbv) * (1.f - sig) * bf2f(U[rr + C_HI + hh * 128 + v]); dcy *= fv; }
                    o += q * acc; }
                so[v] = o; }
            __syncthreads();
            if (threadIdx.x < 128) { float ss = 0.f; for (int j = 0; j < 128; ++j) ss += so[j] * so[j]; const float gv = bf2f(U[(size_t)r * UW + C_HG + hh * 128 + v]);
                dbg_put(ctl, 13, bf2f(MIX[(size_t)r * D + 512 + hh * 128 + v]), o * rsqrtf(ss / 128 + EPS) * in[9][l * 128 + v] * gv / (1.f + expf(-gv)), 0.3f); }
            __syncthreads(); }
    }
    if (stage == 14) {
        for (int s = gid; s < 2048; s += NT) { const unsigned h = dh(s * 193u + 23u); const int r = h % NTOK, c = (h >> 14) % D; float a = in[0][(size_t)r * D + c];
            for (int k = 0; k < D; ++k) a += bf2f(MIX[(size_t)r * D + k]) * bf2f(((const bf16*)(wl + WL_WOUT))[(size_t)c * D + k]);
            dbg_put(ctl, 14, args.out[(size_t)r * D + c], a, 1.0f); }
    }
}
__global__ void dbg_final(Args args, float tol, int first, int count) {
    const unsigned* ctl = (const unsigned*)(args.ws + WS_CTL); float c = 1.f; int mask = 0;
    if (count > 0) { for (int k = 0; k < count; ++k) { const float e = __builtin_bit_cast(float, ctl[CW_DBG + first + k]); if (e > tol) mask |= 1 << k; } }
    else { for (int k = 0; k < -count; ++k) { const float e = __builtin_bit_cast(float, ctl[CW_DBG + first + k]);
        const int lv = e <= 0.05f ? 0 : e <= 0.2f ? 1 : e <= 1.f ? 2 : e <= 5.f ? 3 : e <= 100.f ? 4 : e <= 1e6f ? 5 : e < 1e9f ? 6 : 7; mask |= lv << (3 * k); } }
    if (mask) c = 2.f + 0.5f * mask;
    for (size_t i = (size_t)blockIdx.x * 256 + threadIdx.x; i < (size_t)NTOK * D; i += (size_t)gridDim.x * 256) args.out[i] = c * args.in[0][i];
}
#endif

#if MK_STAMP
__global__ void stamp_final(Args args, int pa, int pb) {
    const unsigned long long* st = (const unsigned long long*)((const unsigned*)(args.ws + WS_CTL) + CW_STAMPS);
    long long da = (long long)(st[pa + 1] - st[pa]) / 1000, db = (long long)(st[pb + 1] - st[pb]) / 1000;
    if (da < 0) da = 0; if (da > 99) da = 99; if (db < 0) db = 0; if (db > 99) db = 99;
    const float c = 2.f + 0.1f * (float)da, V = 100.f + 10.f * (float)db;
    for (size_t i = (size_t)blockIdx.x * 256 + threadIdx.x; i < (size_t)NTOK * D; i += (size_t)gridDim.x * 256) args.out[i] = i == 0 ? V : c * args.in[0][i];
}
#endif
extern "C" void kernel_launch(void* const* d_in, const int* in_sizes, int n_in, void* d_out, int out_size, void* d_ws, size_t ws_size, hipStream_t stream) {
    static int grid = 0;
    if (grid == 0) {
        if (n_in != 32 || out_size != NTOK * D || ws_size < WS_END) { fprintf(stderr, "kernel_launch: unexpected shapes (n_in %d out %d ws %zu need %zu)\n", n_in, out_size, ws_size, (size_t)WS_END); grid = -1; return; }
        int dev = 0, cus = 0, per_cu = 0;
        if (hipGetDevice(&dev) != hipSuccess || hipDeviceGetAttribute(&cus, hipDeviceAttributeMultiprocessorCount, dev) != hipSuccess) { grid = -1; return; }
        if (hipFuncSetAttribute((const void*)mk_fwd, hipFuncAttributeMaxDynamicSharedMemorySize, LDS_BYTES) != hipSuccess) { fprintf(stderr, "kernel_launch: hipFuncSetAttribute failed\n"); grid = -1; return; }
        if (hipOccupancyMaxActiveBlocksPerMultiprocessor(&per_cu, (const void*)mk_fwd, NTHR, LDS_BYTES) != hipSuccess || per_cu < 1) { fprintf(stderr, "kernel_launch: occupancy query says %d\n", per_cu); (void)hipGetLastError(); }
        grid = cus;
    }
    if (grid < 0) return;
    (void)hipMemsetAsync((char*)d_ws + WS_CTL, 0, CTL_BYTES, stream);
    Args a{};
    for (int i = 0; i < 32; ++i) a.in[i] = (const float*)d_in[i];
    a.out = (float*)d_out; a.ws = (unsigned char*)d_ws;
#if MK_ONE_LAUNCH
    a.ph_lo = 0; a.ph_hi = N_PHASES + MK_SANITIZE;
    hipLaunchKernelGGL(mk_fwd, dim3(grid), dim3(NTHR), LDS_BYTES, stream, a);
#if MK_STAMP
    hipLaunchKernelGGL(stamp_final, dim3(1024), dim3(256), 0, stream, a, MK_STAMP_A, MK_STAMP_B);
#endif
#else
    for (int p = 0; p < N_PHASES + MK_SANITIZE; ++p) { a.ph_lo = p; a.ph_hi = p + 1; hipLaunchKernelGGL(mk_fwd, dim3(grid), dim3(NTHR), LDS_BYTES, stream, a);
#if MK_DEBUG
        const int pb0 = PH_BASE;
        if (p == 0) { hipLaunchKernelGGL(dbg_kernel, dim3(64), dim3(256), 0, stream, a, 1, 0); hipLaunchKernelGGL(dbg_kernel, dim3(64), dim3(256), 0, stream, a, 2, 0); }
        if (p == pb0 + 0) hipLaunchKernelGGL(dbg_kernel, dim3(64), dim3(256), 0, stream, a, 3, 0);
        if (p == pb0 + 1) { hipLaunchKernelGGL(dbg_kernel, dim3(64), dim3(256), 0, stream, a, 4, 0); hipLaunchKernelGGL(dbg_kernel, dim3(64), dim3(256), 0, stream, a, 6, 0); }
        if (p == pb0 + 2) { hipLaunchKernelGGL(dbg_kernel, dim3(64), dim3(256), 0, stream, a, 8, 0); hipLaunchKernelGGL(dbg_kernel, dim3(64), dim3(256), 0, stream, a, 11, 0); }
        if (p == pb0 + 3) { hipLaunchKernelGGL(dbg_kernel, dim3(64), dim3(256), 0, stream, a, 12, 0); hipLaunchKernelGGL(dbg_kernel, dim3(64), dim3(256), 0, stream, a, 13, 0); }
        if (p == pb0 + 4) { hipLaunchKernelGGL(dbg_kernel, dim3(64), dim3(256), 0, stream, a, 14, 0); hipLaunchKernelGGL(dbg_final, dim3(1024), dim3(256), 0, stream, a, 0.05f, 11, 4); break; }
#endif
    }
#endif
}
```
